# Optimizing an MI355X kernel written in HIP

```python
import jax, jax.numpy as jnp
from jax import lax
import numpy as np

D_MODEL = 1024
BATCH = 4
SEQ = 4096
DEPTH = 1
DEC_BATCH = 32
DEC_SEQ = 32
PAST_LEN = 1024

CHUNK = 64
PLE_DIM = 256
M_HEADS = 4
M_INNER = 2 * D_MODEL
M_HD = M_INNER // M_HEADS
CONV_W = 4
H_EXPAND = 128
H_WIDTH = D_MODEL
H_HEADS = H_WIDTH // H_EXPAND
IN_SIZES = (M_INNER, M_INNER, M_INNER, M_HEADS, M_HEADS, H_WIDTH, H_WIDTH, H_WIDTH, H_WIDTH, D_MODEL, D_MODEL)
N_IN = 3 * M_INNER + 2 * M_HEADS + 4 * H_WIDTH + 2 * D_MODEL
EPS = 1e-6

kernel_name = 'mlstm_hgrn2_gated_stream_step'


def _rmsnorm(x, g):
    xf = x.astype(jnp.float32)
    y = xf * lax.rsqrt(jnp.mean(xf * xf, axis=-1, keepdims=True) + EPS)
    return (y * g.astype(jnp.float32)).astype(x.dtype)


def _head_layernorm(h, g):
    mu = jnp.mean(h, axis=-1, keepdims=True)
    d = h - mu
    y = d * lax.rsqrt(jnp.mean(d * d, axis=-1, keepdims=True) + EPS)
    return y.reshape(h.shape[0], h.shape[1], -1) * g


def _head_rmsnorm(h, g):
    y = h * lax.rsqrt(jnp.mean(h * h, axis=-1, keepdims=True) + EPS)
    return y.reshape(h.shape[0], h.shape[1], -1) * g


def _causal_conv(u, buf, w, b):
    T = u.shape[1]
    xp = jnp.concatenate([buf, u], axis=1)
    y = b + xp[:, 0:T] * w[0]
    for j in range(1, CONV_W):
        y = y + xp[:, j:j + T] * w[j]
    return y, xp[:, -(CONV_W - 1):]


def _to_chunks(a, L):
    a = a.reshape(a.shape[:2] + (a.shape[2] // L, L) + a.shape[3:])
    return jnp.moveaxis(a, 2, 0)


def _from_chunks(a):
    a = jnp.moveaxis(a, 0, 2)
    return a.reshape(a.shape[:2] + (a.shape[2] * a.shape[3],) + a.shape[4:])


def _mlstm_chunk(carry, inp):
    C, n, m = carry
    q, k, v, ig, lf = inp
    L = q.shape[2]
    causal = jnp.tril(jnp.ones((L, L), dtype=bool))
    b = jnp.cumsum(lf, axis=-1)
    logd = jnp.where(causal, b[..., :, None] - b[..., None, :] + ig[..., None, :], -jnp.inf)
    m_prev = b + m[..., None]
    m_t = jnp.maximum(m_prev, jnp.max(logd, axis=-1))
    dmat = jnp.exp(logd - m_t[..., None])
    w_inter = jnp.exp(m_prev - m_t)
    s = jnp.einsum('bhtd,bhsd->bhts', q, k) * dmat
    num = w_inter[..., None] * jnp.einsum('bhed,bhtd->bhte', C, q) + jnp.einsum('bhts,bhse->bhte', s, v)
    den = w_inter * jnp.einsum('bhd,bhtd->bht', n, q) + jnp.sum(s, axis=-1)
    h = num / jnp.maximum(jnp.abs(den), jnp.exp(-m_t))[..., None]
    m_last = m_t[..., -1]
    w_last = jnp.exp(b[..., -1:] - b + ig - m_last[..., None])
    decay = jnp.exp(m_prev[..., -1] - m_last)
    C_new = decay[..., None, None] * C + jnp.einsum('bhs,bhse,bhsd->bhed', w_last, v, k)
    n_new = decay[..., None] * n + jnp.einsum('bhs,bhsd->bhd', w_last, k)
    return (C_new, n_new, m_last), h


def _hgrn_chunk(S, inp):
    q, k, v, lf = inp
    L = q.shape[2]
    causal = jnp.tril(jnp.ones((L, L), dtype=bool))[:, :, None]
    g = jnp.cumsum(lf, axis=2)
    dec = jnp.exp(jnp.where(causal, g[:, :, :, None, :] - g[:, :, None, :, :], -jnp.inf))
    a = jnp.einsum('bhtc,bhtsc,bhsc->bhts', q, dec, k)
    o = jnp.einsum('bhtc,bhce->bhte', q * jnp.exp(g), S) + jnp.einsum('bhts,bhse->bhte', a, v)
    g_last = g[:, :, -1:, :]
    S_new = jnp.exp(g_last[:, :, 0, :])[..., None] * S + jnp.einsum('bhsc,bhse->bhce', k * jnp.exp(g_last - g), v)
    return S_new, o


def _mlstm(q, k, v, ig, lf, C, n, m):
    L = min(CHUNK, q.shape[2])
    xs = (_to_chunks(q, L), _to_chunks(k, L), _to_chunks(v, L), _to_chunks(ig, L), _to_chunks(lf, L))
    (C, n, m), h = lax.scan(_mlstm_chunk, (C, n, m), xs)
    return _from_chunks(h), C, n, m


def _hgrn(q, k, v, lf, S):
    L = min(CHUNK, q.shape[2])
    xs = (_to_chunks(q, L), _to_chunks(k, L), _to_chunks(v, L), _to_chunks(lf, L))
    S, o = lax.scan(_hgrn_chunk, S, xs)
    return _from_chunks(o), S


def _split_points():
    pts, acc = [], 0
    for s in IN_SIZES[:-1]:
        acc += s
        pts.append(acc)
    return pts


def _trunk(x, p, conv0, C0, n0, m0, S0, norm_g, w_in, b_ig, b_fg, conv_w, conv_b, w_qm, w_km,
           mnorm_g, m_skip, w_brm, hgrn_lb, hnorm_g, w_brh, w_out, w_ple, w_pg, final_g):
    f32 = jnp.float32
    B_, T, _ = x.shape
    lb_all = jnp.cumsum(jax.nn.softmax(hgrn_lb.astype(f32), axis=0), axis=0)
    h = x
    convs, Cs, ns, ms, Ss = [], [], [], [], []
    for l in range(DEPTH):
        xn = _rmsnorm(h, norm_g[l])
        proj = xn @ w_in[l]
        u, v_m, z_m, ig_pre, fg_pre, q_h, f_h, i_h, g_h, ga, gb = jnp.split(proj, _split_points(), axis=-1)
        c, conv_new = _causal_conv(u, conv0[l].astype(u.dtype), conv_w[l], conv_b[l])
        c = jax.nn.silu(c).astype(f32)
        ch = c.reshape(B_, T, M_HEADS, M_HD)
        qm = jnp.einsum('bthd,hde->bhte', ch, w_qm[l].astype(f32))
        km = jnp.einsum('bthd,hde->bhte', ch, w_km[l].astype(f32)) * (M_HD ** -0.5)
        vm = v_m.astype(f32).reshape(B_, T, M_HEADS, M_HD).transpose(0, 2, 1, 3)
        ig = (ig_pre.astype(f32) + b_ig[l].astype(f32)).transpose(0, 2, 1)
        lf = jax.nn.log_sigmoid(fg_pre.astype(f32) + b_fg[l].astype(f32)).transpose(0, 2, 1)
        hm, C_new, n_new, m_new = _mlstm(qm, km, vm, ig, lf, C0[l].astype(f32), n0[l].astype(f32), m0[l].astype(f32))
        hm = _head_layernorm(hm.transpose(0, 2, 1, 3), mnorm_g[l].astype(f32))
        hm = (hm + m_skip[l].astype(f32) * c) * jax.nn.silu(z_m.astype(f32))
        ya = hm.astype(x.dtype) @ w_brm[l]
        lb = lb_all[l]
        f_lin = f_h.astype(f32)
        lfh = jnp.log(lb + (1.0 - lb) * jax.nn.sigmoid(f_lin))
        kh = (1.0 - lb) * jax.nn.sigmoid(-f_lin)
        qh = jax.nn.silu(q_h.astype(f32))
        to_heads = lambda a: a.reshape(B_, T, H_HEADS, H_EXPAND).transpose(0, 2, 1, 3)
        oh, S_new = _hgrn(to_heads(qh), to_heads(kh), to_heads(i_h.astype(f32)), to_heads(lfh), S0[l].astype(f32))
        oh = _head_rmsnorm(oh.transpose(0, 2, 1, 3), hnorm_g[l].astype(f32)) * jax.nn.silu(g_h.astype(f32))
        yb = oh.astype(x.dtype) @ w_brh[l]
        y = jax.nn.sigmoid(ga) * ya + jax.nn.sigmoid(gb) * yb
        h = h + y @ w_out[l]
        h = h + jax.nn.sigmoid(h @ w_pg[l]) * (p[l] @ w_ple[l])
        convs.append(conv_new); Cs.append(C_new); ns.append(n_new); ms.append(m_new); Ss.append(S_new)
    out = _rmsnorm(h, final_g)
    return out, jnp.stack(convs), jnp.stack(Cs), jnp.stack(ns), jnp.stack(ms), jnp.stack(Ss)


def setup_inputs(seed: int = 0) -> dict:
    key = jax.random.key(seed)
    ks = jax.random.split(key, 32)
    nrm = lambda k, s, sc: jax.random.normal(k, s, jnp.float32) * sc
    return {
        'x_prompt': nrm(ks[0], (BATCH, SEQ, D_MODEL), 1.0),
        'x_sample': nrm(ks[1], (DEC_BATCH, DEC_SEQ, D_MODEL), 1.0),
        'state_conv': nrm(ks[2], (DEPTH, DEC_BATCH, CONV_W - 1, M_INNER), 1.0),
        'state_mlstm_C': nrm(ks[3], (DEPTH, DEC_BATCH, M_HEADS, M_HD, M_HD), 0.05),
        'state_mlstm_n': nrm(ks[4], (DEPTH, DEC_BATCH, M_HEADS, M_HD), 0.05),
        'state_mlstm_m': nrm(ks[5], (DEPTH, DEC_BATCH, M_HEADS), 1.0),
        'state_hgrn': nrm(ks[6], (DEPTH, DEC_BATCH, H_HEADS, H_EXPAND, H_EXPAND), 0.1),
        'p_prompt': nrm(ks[7], (DEPTH, BATCH, SEQ, PLE_DIM), 1.0),
        'p_sample': nrm(ks[8], (DEPTH, DEC_BATCH, DEC_SEQ, PLE_DIM), 1.0),
        'norm_g': 1.0 + nrm(ks[9], (DEPTH, D_MODEL), 0.1),
        'w_in': nrm(ks[10], (DEPTH, D_MODEL, N_IN), D_MODEL ** -0.5),
        'b_ig': nrm(ks[11], (DEPTH, M_HEADS), 0.1),
        'b_fg': jnp.linspace(3.0, 6.0, M_HEADS)[None, :] + nrm(ks[12], (DEPTH, M_HEADS), 0.1),
        'conv_w': nrm(ks[13], (DEPTH, CONV_W, M_INNER), CONV_W ** -0.5),
        'conv_b': nrm(ks[14], (DEPTH, M_INNER), 0.02),
        'w_qm': nrm(ks[15], (DEPTH, M_HEADS, M_HD, M_HD), M_HD ** -0.5),
        'w_km': nrm(ks[16], (DEPTH, M_HEADS, M_HD, M_HD), M_HD ** -0.5),
        'mnorm_g': 1.0 + nrm(ks[17], (DEPTH, M_INNER), 0.1),
        'm_skip': 1.0 + nrm(ks[18], (DEPTH, M_INNER), 0.1),
        'w_brm': nrm(ks[19], (DEPTH, M_INNER, D_MODEL), M_INNER ** -0.5),
        'hgrn_lb': nrm(ks[20], (DEPTH + 1, H_WIDTH), 0.1),
        'hnorm_g': 1.0 + nrm(ks[21], (DEPTH, H_WIDTH), 0.1),
        'w_brh': nrm(ks[22], (DEPTH, H_WIDTH, D_MODEL), H_WIDTH ** -0.5),
        'w_out': nrm(ks[23], (DEPTH, D_MODEL, D_MODEL), D_MODEL ** -0.5),
        'w_ple': nrm(ks[24], (DEPTH, PLE_DIM, D_MODEL), PLE_DIM ** -0.5),
        'w_pg': nrm(ks[25], (DEPTH, D_MODEL, D_MODEL), D_MODEL ** -0.5),
        'final_g': 1.0 + nrm(ks[26], (D_MODEL,), 0.1),
    }


def reference(x_prompt, x_sample, state_conv, state_mlstm_C, state_mlstm_n, state_mlstm_m, state_hgrn,
              p_prompt, p_sample, norm_g, w_in, b_ig, b_fg, conv_w, conv_b, w_qm, w_km, mnorm_g, m_skip,
              w_brm, hgrn_lb, hnorm_g, w_brh, w_out, w_ple, w_pg, final_g):
    f32 = jnp.float32
    B_ = x_prompt.shape[0]
    conv0 = jnp.zeros((DEPTH, B_, CONV_W - 1, M_INNER), x_prompt.dtype)
    C0 = jnp.zeros((DEPTH, B_, M_HEADS, M_HD, M_HD), f32)
    n0 = jnp.zeros((DEPTH, B_, M_HEADS, M_HD), f32)
    m0 = jnp.zeros((DEPTH, B_, M_HEADS), f32)
    S0 = jnp.zeros((DEPTH, B_, H_HEADS, H_EXPAND, H_EXPAND), f32)
    y_prompt, conv_p, C_p, n_p, m_p, S_p = _trunk(
        x_prompt, p_prompt, conv0, C0, n0, m0, S0, norm_g, w_in, b_ig, b_fg, conv_w, conv_b, w_qm, w_km,
        mnorm_g, m_skip, w_brm, hgrn_lb, hnorm_g, w_brh, w_out, w_ple, w_pg, final_g)
    y_sample, conv_s, C_s, n_s, m_s, S_s = _trunk(
        x_sample, p_sample, state_conv, state_mlstm_C, state_mlstm_n, state_mlstm_m, state_hgrn,
        norm_g, w_in, b_ig, b_fg, conv_w, conv_b, w_qm, w_km,
        mnorm_g, m_skip, w_brm, hgrn_lb, hnorm_g, w_brh, w_out, w_ple, w_pg, final_g)
    return (y_prompt, y_sample, conv_p, C_p, n_p, m_p, S_p, conv_s, C_s, n_s, m_s, S_s)
```

```cpp
#include <hip/hip_runtime.h>
#include <cstdio>
#include <cstdint>
#include <cmath>
namespace pg8 {
#define PG8_LAS __attribute__((address_space(3)))
typedef unsigned short bf16_t;
typedef short bf16x8 __attribute__((ext_vector_type(8)));
typedef float f32x4 __attribute__((ext_vector_type(4)));
typedef unsigned u32x4 __attribute__((ext_vector_type(4)));
constexpr int BM = 256, BK = 64, HALF = 128, HTB = HALF * BK * 2  , STAGE_BYTES = 8 * HTB, NXCD = 8, WGM = 8;

__host__ __device__ __forceinline__ int lds_byte(int r, int c) { const int st = (r >> 4) * 2 + (c >> 5), rr = r & 15, cc = c & 31, ob = rr * 64 + cc * 2; return st * 1024 + (ob ^ (((ob >> 9) & 1) << 5)); }
__host__ __device__ __forceinline__ void stage_rc(int b, int& R, int& C) { const int st = b / 1024, sb = b % 1024, swz = sb ^ (((sb >> 9) & 1) << 5); R = (st >> 1) * 16 + swz / 64; C = (st & 1) * 32 + (swz % 64) / 2; }
__host__ __device__ __forceinline__ int perm32(int rho) { const int n = rho >> 4, i = rho & 15; return 8 * (i >> 2) + 4 * n + (i & 3); }

struct Unit { int pm, pn; };
struct Gemm { const bf16_t* A; const bf16_t* Bt; int lda, ldb, K, amask, ashift, astride;
    __device__ __forceinline__ const char* abase(const Unit& u) const { return (const char*)(A + (size_t)u.pm * BM * lda + (size_t)(((u.pn & amask) >> ashift) * astride)); }
    __device__ __forceinline__ const char* bbase(const Unit& u) const { return (const char*)(Bt + (size_t)u.pn * BM * ldb); } };

struct StaticOrder {
    int nM, nN, nwg, G, c;
    __host__ __device__ void init(int M, int N, int G_, int c_) { nM = M / BM; nN = N / BM; nwg = nM * nN; G = G_; c = c_; }
    __host__ __device__ bool next(int i, Unit& u) const {
        const long L = (long)i * G + c; if (L >= nwg) return false;
        int wgid = (int)L; { const int q = nwg / NXCD, r = nwg % NXCD, xcd = wgid % NXCD, off = wgid / NXCD; wgid = (xcd < r ? xcd * (q + 1) : r * (q + 1) + (xcd - r) * q) + off; }
        const int nig = WGM * nN, gid = wgid / nig, fm = gid * WGM, gsz = (nM - fm) < WGM ? (nM - fm) : WGM;
        u.pm = fm + ((wgid % nig) % gsz); u.pn = (wgid % nig) / gsz; return true;
    }
    __device__ __forceinline__ void a_ready(const Unit&) const {}
    __device__ __forceinline__ void done(const Unit&) const {}
};

__device__ __forceinline__ unsigned cvt_pk_bf16(float lo, float hi) { unsigned r; asm volatile("v_cvt_pk_bf16_f32 %0, %1, %2" : "=v"(r) : "v"(lo), "v"(hi)); return r; }
template <class Epi, class Sched, bool ALIGN_EPI = false, bool SP2 = false>
__device__ __forceinline__ void gemm_phase(PG8_LAS unsigned char* lds, const Gemm g, const Sched& S, const Epi& E) {
    const int lda = g.lda, ldb = g.ldb;
    const int tid = threadIdx.x, wid = __builtin_amdgcn_readfirstlane(tid >> 6), lane = tid & 63, wr = wid >> 2, wc = wid & 3, fr = lane & 15, fq = lane >> 4;
    const int K = g.K, nt = K / BK;
    unsigned voffA[2], voffB[2];
#pragma unroll
    for (int i = 0; i < 2; ++i) { int R, C; stage_rc(tid * 16 + i * 8192, R, C); const int Rb = Epi::PERM ? ((R & ~31) + perm32(R & 31)) : R;
        voffA[i] = (unsigned)(R * lda + C) * 2u; voffB[i] = (unsigned)(Rb * ldb + C) * 2u; }
    const size_t kstep = (size_t)(BK * 2);
    const size_t hstepA = (size_t)HALF * lda * 2, hstepB = (size_t)HALF * ldb * 2;
    const unsigned ldsw = (unsigned)wid * 1024u;
    const int aoff = lds_byte(wr * 64 + fr, fq * 8), boff = lds_byte(wc * 32 + fr, fq * 8);
#define PG8_SA(b, h) (((b) * 2 + (h)) * HTB)
#define PG8_SB(b, h) ((4 + (b) * 2 + (h)) * HTB)
#define PG8_STAGE(bufoff, gbase, voff) do { _Pragma("unroll") for (int _i = 0; _i < 2; ++_i) \
        __builtin_amdgcn_global_load_lds((const unsigned*)((const char*)(gbase) + (voff)[_i]), (PG8_LAS unsigned*)(lds + (bufoff) + ldsw + _i * 8192), 16, 0, 0); } while (0)
#define PG8_LDA(dst, b, h) do { _Pragma("unroll") for (int m = 0; m < 4; ++m) _Pragma("unroll") for (int k = 0; k < 2; ++k) dst[m][k] = *(const PG8_LAS bf16x8*)(lds + PG8_SA(b, h) + aoff + m * 2048 + k * 1024); } while (0)
#define PG8_LDB(dst, b, h) do { _Pragma("unroll") for (int n = 0; n < 2; ++n) _Pragma("unroll") for (int k = 0; k < 2; ++k) dst[n][k] = *(const PG8_LAS bf16x8*)(lds + PG8_SB(b, h) + boff + n * 2048 + k * 1024); } while (0)
#define PG8_MMA(ai, bj, At, Bt) do { __builtin_amdgcn_s_setprio(1); _Pragma("unroll") for (int m = 0; m < 4; ++m) _Pragma("unroll") for (int n = 0; n < 2; ++n) _Pragma("unroll") for (int k = 0; k < 2; ++k) \
        acc[ai][bj][m][n] = __builtin_amdgcn_mfma_f32_16x16x32_bf16(Bt[n][k], At[m][k], acc[ai][bj][m][n], 0, 0, 0); __builtin_amdgcn_s_setprio(0); } while (0)
#define PG8_WAIT_V(n) asm volatile("s_waitcnt vmcnt(" #n ")" ::: "memory")
#define PG8_WAIT_L(n) asm volatile("s_waitcnt lgkmcnt(" #n ")" ::: "memory")
#define PG8_BAR __builtin_amdgcn_s_barrier()
#define PG8_SCHED __builtin_amdgcn_sched_barrier(0)
    Unit cur, nxt; int ui = 0;
    if (!S.next(0, cur)) return;
    f32x4 acc[2][2][4][2];
#pragma unroll
    for (int a = 0; a < 2; ++a)
#pragma unroll
        for (int b = 0; b < 2; ++b)
#pragma unroll
            for (int m = 0; m < 4; ++m)
#pragma unroll
                for (int n = 0; n < 2; ++n) acc[a][b][m][n] = (f32x4){0.f, 0.f, 0.f, 0.f};
    bf16x8 At[4][2], B0[2][2], B1[2][2];
    const char* cA = g.abase(cur); const char* cB = g.bbase(cur);
    S.a_ready(cur);
    if constexpr (SP2) {
        PG8_STAGE(PG8_SB(0, 0), cB, voffB); PG8_STAGE(PG8_SB(0, 1), cB + hstepB, voffB); PG8_STAGE(PG8_SA(0, 0), cA, voffA); PG8_STAGE(PG8_SA(0, 1), cA + hstepA, voffA);
        if (wr == 1) PG8_BAR;
        PG8_WAIT_V(2); PG8_BAR;
        PG8_STAGE(PG8_SB(1, 0), cB + kstep, voffB); PG8_STAGE(PG8_SA(1, 0), cA + kstep, voffA); PG8_STAGE(PG8_SB(1, 1), cB + hstepB + kstep, voffB);
        PG8_WAIT_V(6); PG8_BAR;
    } else {
        PG8_STAGE(PG8_SB(0, 0), cB, voffB); PG8_STAGE(PG8_SA(0, 0), cA, voffA); PG8_STAGE(PG8_SB(0, 1), cB + hstepB, voffB); PG8_STAGE(PG8_SA(0, 1), cA + hstepA, voffA);
        if (wr == 1) PG8_BAR;
        PG8_WAIT_V(4); PG8_BAR;
        PG8_STAGE(PG8_SB(1, 0), cB + kstep, voffB); PG8_STAGE(PG8_SA(1, 0), cA + kstep, voffA); PG8_STAGE(PG8_SB(1, 1), cB + hstepB + kstep, voffB);
        PG8_WAIT_V(6); PG8_BAR;
    }
    for (;;) {
        const bool has_next = S.next(ui + 1, nxt);
        const char* nA = has_next ? g.abase(nxt) : cA; const char* nB = has_next ? g.bbase(nxt) : cB;
        for (int t = 0; t < nt; t += 2) {
            const bool last = (t == nt - 2);
            const char* a1 = cA + (size_t)(t + 1) * kstep;
            const char* a2 = last ? nA : cA + (size_t)(t + 2) * kstep; const char* b2 = last ? nB : cB + (size_t)(t + 2) * kstep;
            const char* a3 = a2 + kstep; const char* b3 = b2 + kstep;
            if (last && has_next) S.a_ready(nxt);
            if constexpr (SP2) {
            PG8_LDB(B0, 0, 0); PG8_LDB(B1, 0, 1); PG8_SCHED; PG8_LDA(At, 0, 0); PG8_STAGE(PG8_SA(1, 1), a1 + hstepA, voffA);
            PG8_WAIT_V(8); PG8_WAIT_L(0); PG8_BAR; PG8_MMA(0, 0, At, B0); PG8_MMA(0, 1, At, B1); PG8_BAR; PG8_SCHED;
            PG8_LDA(At, 0, 1); PG8_STAGE(PG8_SB(0, 0), b2, voffB); PG8_STAGE(PG8_SB(0, 1), b2 + hstepB, voffB); PG8_STAGE(PG8_SA(0, 0), a2, voffA);
            PG8_WAIT_V(8); PG8_WAIT_L(0); PG8_BAR; PG8_MMA(1, 0, At, B0); PG8_MMA(1, 1, At, B1); PG8_BAR; PG8_SCHED;
            PG8_LDB(B0, 1, 0); PG8_LDB(B1, 1, 1); PG8_SCHED; PG8_LDA(At, 1, 0); PG8_STAGE(PG8_SA(0, 1), a2 + hstepA, voffA);
            PG8_WAIT_V(8); PG8_WAIT_L(0); PG8_BAR; PG8_MMA(0, 0, At, B0); PG8_MMA(0, 1, At, B1); PG8_BAR; PG8_SCHED;
            PG8_LDA(At, 1, 1); PG8_STAGE(PG8_SB(1, 0), b3, voffB); PG8_STAGE(PG8_SB(1, 1), b3 + hstepB, voffB); PG8_STAGE(PG8_SA(1, 0), a3, voffA);
            PG8_WAIT_V(8); PG8_WAIT_L(0); PG8_BAR; PG8_MMA(1, 0, At, B0); PG8_MMA(1, 1, At, B1); PG8_BAR; PG8_SCHED;
            } else {
            PG8_LDB(B0, 0, 0); PG8_SCHED; PG8_LDA(At, 0, 0); PG8_STAGE(PG8_SA(1, 1), a1 + hstepA, voffA);
            PG8_WAIT_L(8); PG8_BAR; PG8_WAIT_L(0); PG8_MMA(0, 0, At, B0); PG8_BAR; PG8_SCHED;
            PG8_LDB(B1, 0, 1); PG8_STAGE(PG8_SB(0, 0), b2, voffB);
            PG8_BAR; PG8_WAIT_L(0); PG8_MMA(0, 1, At, B1); PG8_BAR;
            PG8_LDA(At, 0, 1); PG8_STAGE(PG8_SA(0, 0), a2, voffA);
            PG8_BAR; PG8_WAIT_L(0); PG8_MMA(1, 0, At, B0); PG8_BAR; PG8_SCHED;
            PG8_STAGE(PG8_SB(0, 1), b2 + hstepB, voffB);
            PG8_WAIT_V(6); PG8_BAR; PG8_MMA(1, 1, At, B1); PG8_BAR;
            PG8_LDB(B0, 1, 0); PG8_SCHED; PG8_LDA(At, 1, 0); PG8_STAGE(PG8_SA(0, 1), a2 + hstepA, voffA);
            PG8_WAIT_L(8); PG8_BAR; PG8_WAIT_L(0); PG8_MMA(0, 0, At, B0); PG8_BAR; PG8_SCHED;
            PG8_LDB(B1, 1, 1); PG8_STAGE(PG8_SB(1, 0), b3, voffB);
            PG8_BAR; PG8_WAIT_L(0); PG8_MMA(0, 1, At, B1); PG8_BAR;
            PG8_LDA(At, 1, 1); PG8_STAGE(PG8_SA(1, 0), a3, voffA);
            PG8_BAR; PG8_WAIT_L(0); PG8_MMA(1, 0, At, B0); PG8_BAR; PG8_SCHED;
            PG8_STAGE(PG8_SB(1, 1), b3 + hstepB, voffB);
            PG8_WAIT_V(6); PG8_BAR; PG8_MMA(1, 1, At, B1); PG8_BAR;
            }
        }
        if constexpr (ALIGN_EPI) { if (wr == 0) PG8_BAR; }
        if constexpr (!Epi::AFTER_DRAIN) { E(acc, cur, wr, wc, fr, fq); S.done(cur); }
        if (!has_next) break;
#pragma unroll
        for (int a = 0; a < 2; ++a)
#pragma unroll
            for (int b = 0; b < 2; ++b)
#pragma unroll
                for (int m = 0; m < 4; ++m)
#pragma unroll
                    for (int n = 0; n < 2; ++n) acc[a][b][m][n] = (f32x4){0.f, 0.f, 0.f, 0.f};
        cur = nxt; cA = nA; cB = nB; ++ui;
        if constexpr (ALIGN_EPI) { if (wr == 1) PG8_BAR; }
    }
    PG8_WAIT_V(0);
    if constexpr (!ALIGN_EPI) { if (wr == 0) PG8_BAR; }
    PG8_BAR;
    if constexpr (Epi::AFTER_DRAIN) { E.fused(acc, cur, wr, wc, fr, fq, lds, wid, lane); S.done(cur); }
#undef PG8_SA
#undef PG8_SB
#undef PG8_STAGE
#undef PG8_LDA
#undef PG8_LDB
#undef PG8_MMA
#undef PG8_WAIT_V
#undef PG8_WAIT_L
#undef PG8_BAR
#undef PG8_SCHED
}

template <class Fn> struct EpiF {
    static constexpr bool PERM = true, AFTER_DRAIN = false;
    Fn f;
    __device__ __forceinline__ void operator()(const f32x4 (&acc)[2][2][4][2], const Unit& u, int wr, int wc, int fr, int fq) const {
        const int row0 = u.pm * BM + wr * 64 + fr, ct0 = wc * 32 + 8 * fq;
#pragma unroll
        for (int ai = 0; ai < 2; ++ai)
#pragma unroll
            for (int m = 0; m < 4; ++m)
#pragma unroll
                for (int bj = 0; bj < 2; ++bj) f(row0 + ai * HALF + m * 16, u.pn, ct0 + bj * HALF, acc[ai][bj][m][0], acc[ai][bj][m][1]);
    }
};
}

constexpr int NWAVES = 8, NTHREADS = 512;
constexpr int DM = 1024, MI = 2048, NSRC = 12296, PLE = 256;
constexpr int TP = 4096, TS = 32, BP = 4, BS = 32;
constexpr int NTOK_P = BP * TP, NTOK_S = BS * TS, NTOK = NTOK_P + NTOK_S;
constexpr int MH = 4, MHD = 512, HH = 8, HE = 128;
constexpr float EPS = 1e-6f;
constexpr size_t O_Y = 0, O_CONVP = 17825792, O_CP = 17850368, O_NP = 22044672, O_MP = 22052864, O_SP = 22052880,
                 O_CONVS = 22577168, O_CS = 22773776, O_NS = 56328208, O_MS = 56393744, O_SS = 56393872, O_END = 60588176;
constexpr size_t MiB = 1u << 20;
constexpr size_t WS_CTL = 0, CTL_ZERO_BYTES = 1 * MiB;
constexpr size_t WS_GATES = 1 * MiB, WS_PB = 2 * MiB;
constexpr size_t WS_WIN = 12 * MiB, WS_WQK = 36 * MiB, WS_WBRM = 40 * MiB, WS_WBRH = 44 * MiB, WS_WOUT = 46 * MiB, WS_WPG = 48 * MiB, WS_WPLE = 50 * MiB;
constexpr size_t WS_XN = 52 * MiB, WS_U = 86 * MiB, WS_V = 154 * MiB, WS_QH = 222 * MiB, WS_FH = 256 * MiB, WS_IH = 290 * MiB, WS_C = 324 * MiB, WS_K = 392 * MiB, WS_HO = 460 * MiB;
constexpr size_t WS_END = 494 * MiB;
constexpr size_t WS_Q = WS_U, WS_ZP = WS_V, WS_GHP = WS_QH, WS_GAP = WS_FH, WS_GBP = WS_IH, WS_HMN = WS_U, WS_OH = WS_K, WS_YA = WS_K + 34 * MiB, WS_Y = WS_C, WS_H1B = WS_C + 34 * MiB, WS_G2 = WS_HO;
constexpr int CW_BAR = 4096;
constexpr int RING_OFF = 0, RING_BYTES = 131072, LDSCTL_OFF = RING_BYTES, MISC_OFF = LDSCTL_OFF + 320, LDS_BYTES = 147456;

#define GAS __attribute__((address_space(1)))
#define LAS __attribute__((address_space(3)))
typedef unsigned short bf16;
typedef unsigned v4u __attribute__((ext_vector_type(4)));
typedef unsigned v2u __attribute__((ext_vector_type(2)));
typedef float f32x4 __attribute__((ext_vector_type(4)));
typedef GAS unsigned gu32;
#define RLX_AGENT __ATOMIC_RELAXED, __HIP_MEMORY_SCOPE_AGENT
#define LDS_WAIT() asm volatile("s_waitcnt lgkmcnt(0)" ::: "memory")
#define VM_WAIT() asm volatile("s_waitcnt vmcnt(0)" ::: "memory")
__device__ __forceinline__ unsigned f2bf(float f) { unsigned u = __builtin_bit_cast(unsigned, f); return (u + 0x7fffu + ((u >> 16) & 1u)) >> 16; }
__device__ __forceinline__ unsigned pk2(float lo, float hi) { return f2bf(lo) | (f2bf(hi) << 16); }
__device__ __forceinline__ float bflo(unsigned w) { return __builtin_bit_cast(float, w << 16); }
__device__ __forceinline__ float bfhi(unsigned w) { return __builtin_bit_cast(float, w & 0xffff0000u); }
__device__ __forceinline__ float bf2f(bf16 h) { return __builtin_bit_cast(float, (unsigned)h << 16); }
__device__ __forceinline__ void unpack8(v4u w, float (&o)[8]) { o[0] = bflo(w.x); o[1] = bfhi(w.x); o[2] = bflo(w.y); o[3] = bfhi(w.y); o[4] = bflo(w.z); o[5] = bfhi(w.z); o[6] = bflo(w.w); o[7] = bfhi(w.w); }
__device__ __forceinline__ v4u pack8(const float (&o)[8]) { v4u w; w.x = pk2(o[0], o[1]); w.y = pk2(o[2], o[3]); w.z = pk2(o[4], o[5]); w.w = pk2(o[6], o[7]); return w; }
__device__ __forceinline__ float sigmoidf_(float x) { return __builtin_amdgcn_rcpf(1.0f + __expf(-x)); }
__device__ __forceinline__ float siluf_(float x) { return x * sigmoidf_(x); }
__device__ __forceinline__ float logsigmoidf_(float x) { return fminf(x, 0.f) - log1pf(__expf(-fabsf(x))); }

#define XB_TMO      128
#define XB_XCNT(j)  (256  + 64 * (j))
#define XB_XSUB(j)  (1280 + 64 * (j))
#define XB_XGEN(j)  (2304 + 64 * (j))
#define XB_TOP      3328
#define XB_TOPGEN   3392
#define XCD_BAR_WORDS 3456
#define XB_SPIN_CAP (1u << 18)
__device__ __forceinline__ unsigned xb_ld(unsigned* p)              { return __hip_atomic_load(p, __ATOMIC_RELAXED, __HIP_MEMORY_SCOPE_AGENT); }
__device__ __forceinline__ unsigned xb_add(unsigned* p, unsigned v) { return __hip_atomic_fetch_add(p, v, __ATOMIC_RELAXED, __HIP_MEMORY_SCOPE_AGENT); }
__device__ __forceinline__ unsigned xb_xcc_id() { return (unsigned)__builtin_amdgcn_s_getreg((3 << 11) | 20) & 0xFu; }
#define XB_SPIN(cond, bar) do { unsigned _sp = 0; while (cond) { __builtin_amdgcn_s_sleep(1); \
    if ((++_sp & 255u) == 0u) { if (xb_ld(&(bar)[XB_TMO])) break; if (_sp > XB_SPIN_CAP) { atomicAdd(&(bar)[XB_TMO], 1u); break; } } } } while (0)
struct XcdBarrier { unsigned* bar; unsigned x; volatile LAS unsigned* st; };
__device__ __forceinline__ XcdBarrier xcd_barrier_post(unsigned* bar, volatile LAS unsigned* st) {
    XcdBarrier b; b.bar = bar; b.x = xb_xcc_id(); b.st = st;
    if (threadIdx.x == 0) (void)xb_add(&bar[XB_XCNT(b.x)], 1u);
    return b;
}
__device__ __forceinline__ void xcd_barrier_complete(unsigned* bar, unsigned x, unsigned& nloc, unsigned& nx) {
    const unsigned G = gridDim.x * gridDim.y * gridDim.z;
    unsigned sum, cnt, mine, sp = 0u;
    for (;;) {
        sum = 0u; cnt = 0u; mine = 0u;
#pragma unroll
        for (unsigned j = 0; j < 16; ++j) { const unsigned c = xb_ld(&bar[XB_XCNT(j)]); sum += c; cnt += (c > 0u) ? 1u : 0u; mine = (j == x) ? c : mine; }
        if (sum == G) break;
        __builtin_amdgcn_s_sleep(1);
        if ((++sp & 255u) == 0u) { if (xb_ld(&bar[XB_TMO])) break; if (sp > XB_SPIN_CAP) { atomicAdd(&bar[XB_TMO], 1u); break; } }
    }
    nloc = mine > 0u ? mine : 1u; nx = cnt > 0u ? cnt : 1u;
}
__device__ __forceinline__ void xcd_barrier(const XcdBarrier& b) {
    asm volatile("s_waitcnt vmcnt(0)" ::: "memory");
    __syncthreads();
    if (threadIdx.x == 0) {
        unsigned* bar = b.bar;
        __builtin_amdgcn_s_waitcnt(0);
        unsigned nloc = b.st[0], nx = b.st[1];
        if (nloc == 0u) { xcd_barrier_complete(bar, b.x, nloc, nx); b.st[0] = nloc; b.st[1] = nx; }
        const unsigned old = xb_add(&bar[XB_XSUB(b.x)], 1u);
        const unsigned gen = old / nloc;
        if (old + 1u == (gen + 1u) * nloc) {
            __builtin_amdgcn_fence(__ATOMIC_RELEASE, "agent");
            asm volatile("s_waitcnt vmcnt(0)" ::: "memory");
            const unsigned og = xb_add(&bar[XB_TOP], 1u);
            const unsigned tg = og / nx;
            if (og + 1u == (tg + 1u) * nx) xb_add(&bar[XB_TOPGEN], 1u);
            else XB_SPIN(xb_ld(&bar[XB_TOPGEN]) == tg, bar);
            __builtin_amdgcn_fence(__ATOMIC_ACQUIRE, "agent");
            xb_add(&bar[XB_XGEN(b.x)], 1u);
            asm volatile("s_waitcnt vmcnt(0)" ::: "memory");
        } else {
            XB_SPIN(xb_ld(&bar[XB_XGEN(b.x)]) == gen, bar);
            __builtin_amdgcn_fence(__ATOMIC_ACQUIRE, "agent");
            asm volatile("s_waitcnt vmcnt(0)" ::: "memory");
        }
    }
    __syncthreads();
}

struct Args { const float* in[27]; float* out; unsigned char* ws; int ph_lo, ph_hi, li, pad; };
enum { I_XP = 0, I_XS, I_SCONV, I_SC, I_SN, I_SM, I_SH, I_PP, I_PS, I_NORMG, I_WIN, I_BIG, I_BFG, I_CONVW, I_CONVB, I_WQM, I_WKM, I_MNORMG, I_MSKIP, I_WBRM, I_LB, I_HNORMG, I_WBRH, I_WOUT, I_WPLE, I_WPG, I_FINALG };
struct Frame { LAS unsigned char* lds; int tid, lane, wave, vcu, G; };

__device__ __forceinline__ float wave_sum(float v) {
#pragma unroll
    for (int o = 1; o < 64; o <<= 1) v += __shfl_xor(v, o);
    return v;
}
__device__ __forceinline__ const float* xrow(const Args& a, int m) { return m < NTOK_P ? a.in[I_XP] + (size_t)m * DM : a.in[I_XS] + (size_t)(m - NTOK_P) * DM; }

__device__ __forceinline__ void p0_transpose_item(const float* W, int pitch, int K, int ncols, bf16* WT, int row_off, LAS float* scr, int item, int lane) {
    const int nblk = ncols / 32, kb = item / nblk, nb = item % nblk, k0 = 64 * kb, n0 = 32 * nb;
#pragma unroll 8
    for (int i = 0; i < 32; ++i) { const int kk = 2 * i + (lane >> 5); scr[kk * 33 + (lane & 31)] = W[(size_t)(k0 + kk) * pitch + n0 + (lane & 31)]; }
    LDS_WAIT(); asm volatile("" ::: "memory");
    const int c = lane & 7;
#pragma unroll
    for (int j = 0; j < 4; ++j) { const int n = (lane >> 3) + 8 * j; const LAS float* s = scr + (8 * c) * 33 + n;
        v4u o; o.x = pk2(s[0 * 33], s[1 * 33]); o.y = pk2(s[2 * 33], s[3 * 33]); o.z = pk2(s[4 * 33], s[5 * 33]); o.w = pk2(s[6 * 33], s[7 * 33]);
        *(GAS v4u*)(WT + (size_t)(row_off + n0 + n) * K + k0 + 8 * c) = o; }
    LDS_WAIT(); asm volatile("" ::: "memory");
}
struct Seg { const float* W; int pitch, K, ncols; bf16* WT; int row_off, items; };
__device__ __forceinline__ Seg seg_info(int s, const Args& a) {
    Seg g; unsigned char* ws = a.ws;
    switch (s) {
    case 0: g = Seg{a.in[I_WIN] + 0,    NSRC, 1024, 4096, (bf16*)(ws + WS_WIN), 0,    0}; break;
    case 1: g = Seg{a.in[I_WIN] + 6152, NSRC, 1024, 3072, (bf16*)(ws + WS_WIN), 4096, 0}; break;
    case 2: g = Seg{a.in[I_WIN] + 4096, NSRC, 1024, 2048, (bf16*)(ws + WS_WIN), 7168, 0}; break;
    case 3: g = Seg{a.in[I_WIN] + 9224, NSRC, 1024, 3072, (bf16*)(ws + WS_WIN), 9216, 0}; break;
    case 4: case 5: case 6: case 7: g = Seg{a.in[I_WQM] + (size_t)(s - 4) * 262144, 512, 512, 512, (bf16*)(ws + WS_WQK), (s - 4) * 512, 0}; break;
    case 8: case 9: case 10: case 11: g = Seg{a.in[I_WKM] + (size_t)(s - 8) * 262144, 512, 512, 512, (bf16*)(ws + WS_WQK), 2048 + (s - 8) * 512, 0}; break;
    case 12: g = Seg{a.in[I_WBRM], 1024, 2048, 1024, (bf16*)(ws + WS_WBRM), 0, 0}; break;
    case 13: g = Seg{a.in[I_WBRH], 1024, 1024, 1024, (bf16*)(ws + WS_WBRH), 0, 0}; break;
    case 14: g = Seg{a.in[I_WOUT], 1024, 1024, 1024, (bf16*)(ws + WS_WOUT), 0, 0}; break;
    case 15: g = Seg{a.in[I_WPG],  1024, 1024, 1024, (bf16*)(ws + WS_WPG),  0, 0}; break;
    default: g = Seg{a.in[I_WPLE], 1024, 256,  1024, (bf16*)(ws + WS_WPLE), 0, 0}; break;
    }
    g.items = (g.K / 64) * (g.ncols / 32);
    return g;
}
__device__ __forceinline__ void p0_prep(Frame& F, const Args& a) {
    LAS float* scr = (LAS float*)(F.lds + RING_OFF + F.wave * 16384);
    const int gw = F.vcu * NWAVES + F.wave, NGW = F.G * NWAVES;
    for (int s = 0; s < 17; ++s) {
        const Seg g = seg_info(s, a);
        for (int it = gw; it < g.items; it += NGW) p0_transpose_item(g.W, g.pitch, g.K, g.ncols, g.WT, g.row_off, scr, it, F.lane);
    }
    __syncthreads();
    LAS float* wg = (LAS float*)(F.lds + RING_OFF);
    for (int i = F.tid; i < 8192; i += NTHREADS) { const int k = i >> 3, q = i & 7; wg[q * 1024 + k] = a.in[I_WIN][(size_t)k * NSRC + 6144 + q]; }
    __syncthreads();
    bf16* XN = (bf16*)(a.ws + WS_XN); float* GATES = (float*)(a.ws + WS_GATES);
    const float* ng = a.in[I_NORMG];
    for (int m = gw; m < NTOK; m += NGW) {
        const GAS f32x4* xr = (const GAS f32x4*)xrow(a, m) + F.lane;
        f32x4 v[4]; float ss = 0.f;
#pragma unroll
        for (int j = 0; j < 4; ++j) { v[j] = xr[64 * j]; ss += (v[j].x * v[j].x + v[j].y * v[j].y) + (v[j].z * v[j].z + v[j].w * v[j].w); }
        const float rstd = 1.0f / sqrtf(wave_sum(ss) * (1.f / DM) + EPS);
        GAS v2u* o8 = (GAS v2u*)(XN + (size_t)m * DM) + F.lane;
        float gacc[8];
#pragma unroll
        for (int q = 0; q < 8; ++q) gacc[q] = 0.f;
#pragma unroll
        for (int j = 0; j < 4; ++j) {
            const f32x4 gg = *(const GAS f32x4*)(ng + 4 * F.lane + 256 * j);
            v[j] = v[j] * rstd * gg;
            v2u w; w.x = pk2(v[j].x, v[j].y); w.y = pk2(v[j].z, v[j].w); o8[64 * j] = w;
#pragma unroll
            for (int q = 0; q < 8; ++q) { const f32x4 ww = *(const LAS f32x4*)(wg + q * 1024 + 4 * F.lane + 256 * j); gacc[q] += (v[j].x * ww.x + v[j].y * ww.y) + (v[j].z * ww.z + v[j].w * ww.w); }
        }
#pragma unroll
        for (int q = 0; q < 8; ++q) gacc[q] = wave_sum(gacc[q]);
        if (F.lane == 0) {
#pragma unroll
            for (int q = 0; q < 4; ++q) { GATES[(size_t)m * 8 + q] = gacc[q] + a.in[I_BIG][q]; GATES[(size_t)m * 8 + 4 + q] = logsigmoidf_(gacc[4 + q] + a.in[I_BFG][q]); }
        }
    }
    bf16* PB = (bf16*)(a.ws + WS_PB);
    for (int i = F.vcu * NTHREADS + F.tid; i < NTOK * 32; i += F.G * NTHREADS) {
        const int m = i >> 5, c8 = (i & 31) * 8;
        const float* src = (m < NTOK_P ? a.in[I_PP] + (size_t)m * PLE : a.in[I_PS] + (size_t)(m - NTOK_P) * PLE) + c8;
        const f32x4 p0 = *(const GAS f32x4*)src, p1 = *(const GAS f32x4*)(src + 4);
        v4u w; w.x = pk2(p0.x, p0.y); w.y = pk2(p0.z, p0.w); w.z = pk2(p1.x, p1.y); w.w = pk2(p1.z, p1.w);
        *(GAS v4u*)(PB + (size_t)m * PLE + c8) = w;
    }
}

__device__ __forceinline__ void p2_conv(Frame& F, const Args& a) {
    const bf16* U = (const bf16*)(a.ws + WS_U); bf16* C = (bf16*)(a.ws + WS_C);
    const float* cw = a.in[I_CONVW]; const float* cb = a.in[I_CONVB]; const float* sconv = a.in[I_SCONV];
    for (int i = F.vcu * NTHREADS + F.tid; i < NTOK * 256; i += F.G * NTHREADS) {
        const int tok = i >> 8, ch = (i & 255) * 8;
        const bool smp = tok >= NTOK_P;
        const int b = smp ? (tok - NTOK_P) >> 5 : tok >> 12, t = smp ? (tok - NTOK_P) & 31 : tok & 4095;
        float acc[8];
        { const f32x4 b0 = *(const GAS f32x4*)(cb + ch), b1 = *(const GAS f32x4*)(cb + ch + 4); acc[0] = b0.x; acc[1] = b0.y; acc[2] = b0.z; acc[3] = b0.w; acc[4] = b1.x; acc[5] = b1.y; acc[6] = b1.z; acc[7] = b1.w; }
        float ucur[8];
#pragma unroll
        for (int j = 0; j < 4; ++j) {
            const int tp = t - 3 + j;
            float val[8];
            if (tp >= 0) { unpack8(*(const GAS v4u*)(U + (size_t)(tok - 3 + j) * MI + ch), val); }
            else if (smp) { const float* s = sconv + (size_t)(b * 3 + (3 + tp)) * MI + ch; const f32x4 s0 = *(const GAS f32x4*)s, s1 = *(const GAS f32x4*)(s + 4);
                val[0] = s0.x; val[1] = s0.y; val[2] = s0.z; val[3] = s0.w; val[4] = s1.x; val[5] = s1.y; val[6] = s1.z; val[7] = s1.w; }
            else {
#pragma unroll
                for (int e = 0; e < 8; ++e) val[e] = 0.f; }
            const f32x4 w0 = *(const GAS f32x4*)(cw + (size_t)j * MI + ch), w1 = *(const GAS f32x4*)(cw + (size_t)j * MI + ch + 4);
            acc[0] += val[0] * w0.x; acc[1] += val[1] * w0.y; acc[2] += val[2] * w0.z; acc[3] += val[3] * w0.w;
            acc[4] += val[4] * w1.x; acc[5] += val[5] * w1.y; acc[6] += val[6] * w1.z; acc[7] += val[7] * w1.w;
            if (j == 3) {
#pragma unroll
                for (int e = 0; e < 8; ++e) ucur[e] = val[e]; }
        }
#pragma unroll
        for (int e = 0; e < 8; ++e) acc[e] = siluf_(acc[e]);
        *(GAS v4u*)(C + (size_t)tok * MI + ch) = pack8(acc);
        const int tl = smp ? TS : TP;
        if (t >= tl - 3) {
            float* dst = a.out + (smp ? O_CONVS : O_CONVP) + (size_t)(b * 3 + (t - (tl - 3))) * MI + ch;
            *(GAS f32x4*)dst = (f32x4){ucur[0], ucur[1], ucur[2], ucur[3]}; *(GAS f32x4*)(dst + 4) = (f32x4){ucur[4], ucur[5], ucur[6], ucur[7]};
        }
    }
}

__device__ __forceinline__ void rec_mlstm_naive(Frame& F, const Args& a, int unit) {
    const int seq = unit >> 6, h = (unit >> 4) & 3, es = unit & 15;
    const bool smp = seq >= BP; const int b = smp ? seq - BP : seq;
    const int T = smp ? TS : TP, tok0 = smp ? NTOK_P + b * TS : b * TP;
    const int dp = F.tid & 15, el = F.tid >> 4, e = es * 32 + el;
    const bf16* Q = (const bf16*)(a.ws + WS_Q); const bf16* K = (const bf16*)(a.ws + WS_K); const bf16* V = (const bf16*)(a.ws + WS_V);
    const float* GATES = (const float*)(a.ws + WS_GATES);
    bf16* HM = (bf16*)a.out;
    float Cs[32], ns[32]; float m;
    if (smp) {
        const float* c0 = a.in[I_SC] + ((size_t)(b * MH + h) * MHD + e) * MHD; const float* n0 = a.in[I_SN] + (size_t)(b * MH + h) * MHD;
#pragma unroll
        for (int j = 0; j < 32; ++j) { Cs[j] = c0[dp + 16 * j]; ns[j] = n0[dp + 16 * j]; }
        m = a.in[I_SM][b * MH + h];
    } else {
#pragma unroll
        for (int j = 0; j < 32; ++j) { Cs[j] = 0.f; ns[j] = 0.f; }
        m = 0.f;
    }
    LAS float* qs = (LAS float*)(F.lds + RING_OFF);
    LAS float* ks = qs + 16 * 512;
    LAS float* vs = ks + 16 * 512;
    LAS float* gs = vs + 16 * 32;
    for (int t0 = 0; t0 < T; t0 += 16) {
        __syncthreads();
        for (int i = F.tid; i < 16 * 512; i += NTHREADS) { const int tt = i >> 9, d = i & 511; const size_t off = (size_t)(tok0 + t0 + tt) * MI + h * MHD + d; qs[i] = bf2f(Q[off]); ks[i] = bf2f(K[off]); }
        { const int tt = F.tid >> 5, ee = F.tid & 31; vs[F.tid] = bf2f(V[(size_t)(tok0 + t0 + tt) * MI + h * MHD + es * 32 + ee]); }
        if (F.tid < 32) { const int tt = F.tid >> 1; gs[F.tid] = GATES[(size_t)(tok0 + t0 + tt) * 8 + (F.tid & 1) * 4 + h]; }
        __syncthreads();
        for (int tt = 0; tt < 16; ++tt) {
            const float ig = gs[tt * 2], lf = gs[tt * 2 + 1];
            const float mn = fmaxf(lf + m, ig), fp = __expf(lf + m - mn), ip = __expf(ig - mn); m = mn;
            const float vv = ip * vs[tt * 32 + el];
            float dot = 0.f, nd = 0.f;
#pragma unroll
            for (int j = 0; j < 32; ++j) { const float kk = ks[tt * 512 + dp + 16 * j], qq = qs[tt * 512 + dp + 16 * j];
                Cs[j] = fp * Cs[j] + vv * kk; ns[j] = fp * ns[j] + ip * kk; dot += Cs[j] * qq; nd += ns[j] * qq; }
#pragma unroll
            for (int o = 1; o < 16; o <<= 1) { dot += __shfl_xor(dot, o); nd += __shfl_xor(nd, o); }
            const float hv = dot / fmaxf(fabsf(nd), __expf(-m));
            if (dp == 0) HM[(size_t)(tok0 + t0 + tt) * MI + h * MHD + e] = (bf16)f2bf(hv);
        }
    }
    float* co = a.out + (smp ? O_CS : O_CP) + ((size_t)(b * MH + h) * MHD + e) * MHD;
#pragma unroll
    for (int j = 0; j < 32; ++j) co[dp + 16 * j] = Cs[j];
    if (es == 0 && el == 0) { float* no = a.out + (smp ? O_NS : O_NP) + (size_t)(b * MH + h) * MHD;
#pragma unroll
        for (int j = 0; j < 32; ++j) no[dp + 16 * j] = ns[j];
        if (dp == 0) a.out[(smp ? O_MS : O_MP) + b * MH + h] = m; }
}
__device__ __forceinline__ void rec_hgrn_naive(Frame& F, const Args& a, int unit) {
    const int seq = unit >> 5, hd = (unit >> 2) & 7, es = unit & 3;
    const bool smp = seq >= BP; const int b = smp ? seq - BP : seq;
    const int T = smp ? TS : TP, tok0 = smp ? NTOK_P + b * TS : b * TP;
    const int cp = F.tid & 15, el = F.tid >> 4, e = es * 32 + el;
    const bf16* QH = (const bf16*)(a.ws + WS_QH); const bf16* FH = (const bf16*)(a.ws + WS_FH); const bf16* IH = (const bf16*)(a.ws + WS_IH);
    bf16* HO = (bf16*)(a.ws + WS_HO);
    float S[8];
    if (smp) {
#pragma unroll
        for (int j = 0; j < 8; ++j) S[j] = a.in[I_SH][((size_t)(b * HH + hd) * HE + cp + 16 * j) * HE + e];
    } else {
#pragma unroll
        for (int j = 0; j < 8; ++j) S[j] = 0.f;
    }
    LAS float* qs = (LAS float*)(F.lds + RING_OFF);
    LAS float* fs = qs + 2048; LAS float* ks = fs + 2048; LAS float* vs = ks + 2048;
    for (int t0 = 0; t0 < T; t0 += 16) {
        __syncthreads();
        for (int i = F.tid; i < 2048; i += NTHREADS) { const int tt = i >> 7, c = i & 127, col = hd * HE + c; const size_t off = (size_t)(tok0 + t0 + tt) * DM + col;
            const float l0 = a.in[I_LB][col], l1 = a.in[I_LB][DM + col]; const float lb = 1.0f / (1.0f + __expf(l1 - l0));
            const float sg = sigmoidf_(bf2f(FH[off]));
            qs[i] = siluf_(bf2f(QH[off])); fs[i] = lb + (1.0f - lb) * sg; ks[i] = (1.0f - lb) * (1.0f - sg); }
        { const int tt = F.tid >> 5, ee = F.tid & 31; vs[F.tid] = bf2f(IH[(size_t)(tok0 + t0 + tt) * DM + hd * HE + es * 32 + ee]); }
        __syncthreads();
        for (int tt = 0; tt < 16; ++tt) {
            const float vv = vs[tt * 32 + el]; float o = 0.f;
#pragma unroll
            for (int j = 0; j < 8; ++j) { const int c = cp + 16 * j; S[j] = fs[tt * 128 + c] * S[j] + ks[tt * 128 + c] * vv; o += qs[tt * 128 + c] * S[j]; }
#pragma unroll
            for (int s = 1; s < 16; s <<= 1) o += __shfl_xor(o, s);
            if (cp == 0) HO[(size_t)(tok0 + t0 + tt) * DM + hd * HE + e] = (bf16)f2bf(o);
        }
    }
    float* so = a.out + (smp ? O_SS : O_SP);
#pragma unroll
    for (int j = 0; j < 8; ++j) so[((size_t)(b * HH + hd) * HE + cp + 16 * j) * HE + e] = S[j];
}
__device__ __forceinline__ void p4_rec(Frame& F, const Args& a) {
    for (int u = blockIdx.x; u < 36 * 64; u += F.G) rec_mlstm_naive(F, a, u);
    for (int u = blockIdx.x; u < 36 * 32; u += F.G) rec_hgrn_naive(F, a, u);
}

__device__ __forceinline__ void p6_norm(Frame& F, const Args& a) {
    const int gw = F.vcu * NWAVES + F.wave, NGW = F.G * NWAVES;
    const bf16* HM = (const bf16*)a.out; const bf16* C = (const bf16*)(a.ws + WS_C); const bf16* ZP = (const bf16*)(a.ws + WS_ZP);
    const bf16* HO = (const bf16*)(a.ws + WS_HO); const bf16* GHP = (const bf16*)(a.ws + WS_GHP);
    bf16* HMN = (bf16*)(a.ws + WS_HMN); bf16* OH = (bf16*)(a.ws + WS_OH);
    for (int m = gw; m < NTOK; m += NGW) {
#pragma unroll 1
        for (int h = 0; h < MH; ++h) {
            const int col = h * MHD + F.lane * 8; const size_t off = (size_t)m * MI + col;
            float x[8], c[8], z[8];
            unpack8(*(const GAS v4u*)(HM + off), x); unpack8(*(const GAS v4u*)(C + off), c); unpack8(*(const GAS v4u*)(ZP + off), z);
            float s = 0.f;
#pragma unroll
            for (int e = 0; e < 8; ++e) s += x[e];
            const float mu = wave_sum(s) * (1.f / MHD); float q = 0.f;
#pragma unroll
            for (int e = 0; e < 8; ++e) { x[e] -= mu; q += x[e] * x[e]; }
            const float rstd = 1.0f / sqrtf(wave_sum(q) * (1.f / MHD) + EPS);
            float o[8];
#pragma unroll
            for (int e = 0; e < 8; ++e) o[e] = (x[e] * rstd * a.in[I_MNORMG][col + e] + a.in[I_MSKIP][col + e] * c[e]) * z[e];
            *(GAS v4u*)(HMN + off) = pack8(o);
        }
        {
            const int col = F.lane * 16; const size_t off = (size_t)m * DM + col;
            float x[16], g[16];
            { float t0[8], t1[8]; unpack8(*(const GAS v4u*)(HO + off), t0); unpack8(*(const GAS v4u*)(HO + off + 8), t1);
#pragma unroll
              for (int e = 0; e < 8; ++e) { x[e] = t0[e]; x[8 + e] = t1[e]; } }
            { float t0[8], t1[8]; unpack8(*(const GAS v4u*)(GHP + off), t0); unpack8(*(const GAS v4u*)(GHP + off + 8), t1);
#pragma unroll
              for (int e = 0; e < 8; ++e) { g[e] = t0[e]; g[8 + e] = t1[e]; } }
            float q = 0.f;
#pragma unroll
            for (int e = 0; e < 16; ++e) q += x[e] * x[e];
            q += __shfl_xor(q, 1); q += __shfl_xor(q, 2); q += __shfl_xor(q, 4);
            const float rstd = 1.0f / sqrtf(q * (1.f / HE) + EPS);
            float o0[8], o1[8];
#pragma unroll
            for (int e = 0; e < 8; ++e) { o0[e] = x[e] * rstd * a.in[I_HNORMG][col + e] * g[e]; o1[e] = x[8 + e] * rstd * a.in[I_HNORMG][col + 8 + e] * g[8 + e]; }
            *(GAS v4u*)(OH + off) = pack8(o0); *(GAS v4u*)(OH + off + 8) = pack8(o1);
        }
    }
}

__device__ __forceinline__ void p12_final(Frame& F, const Args& a) {
    const int gw = F.vcu * NWAVES + F.wave, NGW = F.G * NWAVES;
    const float* fg = a.in[I_FINALG];
    for (int m = gw; m < NTOK; m += NGW) {
        GAS f32x4* xr = (GAS f32x4*)(a.out + (size_t)m * DM) + F.lane;
        f32x4 v[4]; float ss = 0.f;
#pragma unroll
        for (int j = 0; j < 4; ++j) { v[j] = xr[64 * j]; ss += (v[j].x * v[j].x + v[j].y * v[j].y) + (v[j].z * v[j].z + v[j].w * v[j].w); }
        const float rstd = 1.0f / sqrtf(wave_sum(ss) * (1.f / DM) + EPS);
#pragma unroll
        for (int j = 0; j < 4; ++j) { const f32x4 gg = *(const GAS f32x4*)(fg + 4 * F.lane + 256 * j); xr[64 * j] = v[j] * rstd * gg; }
    }
}

__device__ __forceinline__ void st8bf(bf16* p, f32x4 v0, f32x4 v1) {
    v4u w; w.x = pg8::cvt_pk_bf16(v0[0], v0[1]); w.y = pg8::cvt_pk_bf16(v0[2], v0[3]); w.z = pg8::cvt_pk_bf16(v1[0], v1[1]); w.w = pg8::cvt_pk_bf16(v1[2], v1[3]);
    *(GAS v4u*)p = w;
}
__device__ __forceinline__ void ld8bf(const bf16* p, f32x4& v0, f32x4& v1) {
    const v4u w = *(const GAS v4u*)p; v0 = (f32x4){bflo(w.x), bfhi(w.x), bflo(w.y), bfhi(w.y)}; v1 = (f32x4){bflo(w.z), bfhi(w.z), bflo(w.w), bfhi(w.w)};
}
__device__ __forceinline__ f32x4 sig4(f32x4 v) { return (f32x4){sigmoidf_(v[0]), sigmoidf_(v[1]), sigmoidf_(v[2]), sigmoidf_(v[3])}; }
struct Fn1a { unsigned char* ws;
    __device__ __forceinline__ void operator()(int row, int pn, int ct, f32x4 v0, f32x4 v1) const {
        bf16* base; int ld, col;
        if (pn < 8) { base = (bf16*)(ws + WS_U); ld = MI; col = pn * 256; } else if (pn < 16) { base = (bf16*)(ws + WS_V); ld = MI; col = (pn - 8) * 256; }
        else if (pn < 20) { base = (bf16*)(ws + WS_QH); ld = DM; col = (pn - 16) * 256; } else if (pn < 24) { base = (bf16*)(ws + WS_FH); ld = DM; col = (pn - 20) * 256; }
        else { base = (bf16*)(ws + WS_IH); ld = DM; col = (pn - 24) * 256; }
        st8bf(base + (size_t)row * ld + col + ct, v0, v1);
    } };
struct Fn3 { unsigned char* ws;
    __device__ __forceinline__ void operator()(int row, int pn, int ct, f32x4 v0, f32x4 v1) const {
        if (pn < 8) st8bf((bf16*)(ws + WS_Q) + (size_t)row * MI + pn * 256 + ct, v0, v1);
        else { const float s = 0.044194173824159216f; st8bf((bf16*)(ws + WS_K) + (size_t)row * MI + (pn - 8) * 256 + ct, v0 * s, v1 * s); }
    } };
struct Fn5 { unsigned char* ws;
    __device__ __forceinline__ void operator()(int row, int pn, int ct, f32x4 v0, f32x4 v1) const {
        bf16* base; int ld, col; bool sil;
        if (pn < 8) { base = (bf16*)(ws + WS_ZP); ld = MI; col = pn * 256; sil = true; } else if (pn < 12) { base = (bf16*)(ws + WS_GHP); ld = DM; col = (pn - 8) * 256; sil = true; }
        else if (pn < 16) { base = (bf16*)(ws + WS_GAP); ld = DM; col = (pn - 12) * 256; sil = false; } else { base = (bf16*)(ws + WS_GBP); ld = DM; col = (pn - 16) * 256; sil = false; }
        f32x4 s0 = sig4(v0), s1 = sig4(v1);
        if (sil) { s0 = s0 * v0; s1 = s1 * v1; }
        st8bf(base + (size_t)row * ld + col + ct, s0, s1);
    } };
struct Fn7 { unsigned char* ws;
    __device__ __forceinline__ void operator()(int row, int pn, int ct, f32x4 v0, f32x4 v1) const {
        const size_t off = (size_t)row * DM + pn * 256 + ct; f32x4 g0, g1; ld8bf((const bf16*)(ws + WS_GAP) + off, g0, g1);
        st8bf((bf16*)(ws + WS_YA) + off, v0 * g0, v1 * g1);
    } };
struct Fn8 { unsigned char* ws;
    __device__ __forceinline__ void operator()(int row, int pn, int ct, f32x4 v0, f32x4 v1) const {
        const size_t off = (size_t)row * DM + pn * 256 + ct; f32x4 g0, g1, y0, y1; ld8bf((const bf16*)(ws + WS_GBP) + off, g0, g1); ld8bf((const bf16*)(ws + WS_YA) + off, y0, y1);
        st8bf((bf16*)(ws + WS_Y) + off, y0 + v0 * g0, y1 + v1 * g1);
    } };
struct Fn9 { unsigned char* ws; const float* xp; const float* xs; float* out;
    __device__ __forceinline__ void operator()(int row, int pn, int ct, f32x4 v0, f32x4 v1) const {
        const int col = pn * 256 + ct; const float* xr = (row < NTOK_P ? xp + (size_t)row * DM : xs + (size_t)(row - NTOK_P) * DM) + col;
        const f32x4 h0 = *(const GAS f32x4*)xr + v0, h1 = *(const GAS f32x4*)(xr + 4) + v1;
        float* o = out + (size_t)row * DM + col; *(GAS f32x4*)o = h0; *(GAS f32x4*)(o + 4) = h1;
        st8bf((bf16*)(ws + WS_H1B) + (size_t)row * DM + col, h0, h1);
    } };
struct Fn10 { unsigned char* ws;
    __device__ __forceinline__ void operator()(int row, int pn, int ct, f32x4 v0, f32x4 v1) const { st8bf((bf16*)(ws + WS_G2) + (size_t)row * DM + pn * 256 + ct, v0, v1); } };
struct Fn11 { unsigned char* ws; float* out;
    __device__ __forceinline__ void operator()(int row, int pn, int ct, f32x4 v0, f32x4 v1) const {
        const size_t off = (size_t)row * DM + pn * 256 + ct; f32x4 g0, g1; ld8bf((const bf16*)(ws + WS_G2) + off, g0, g1);
        float* o = out + off; const f32x4 h0 = *(const GAS f32x4*)o, h1 = *(const GAS f32x4*)(o + 4);
        *(GAS f32x4*)o = h0 + sig4(v0) * g0; *(GAS f32x4*)(o + 4) = h1 + sig4(v1) * g1;
    } };

constexpr int N_PHASES = 13;
#ifndef MK_PER_PHASE
#define MK_PER_PHASE 0
#endif
template <class Fn>
__device__ __forceinline__ void run_gemm(Frame& F, const bf16* A, int lda, const bf16* Bt, int ldb, int K, int N, int amask, int ashift, int astride, const Fn& fn) {
    asm volatile("" : "+s"(K));
    pg8::Gemm g{A, Bt, lda, ldb, K, amask, ashift, astride}; pg8::StaticOrder S; S.init(NTOK, N, F.G, (int)blockIdx.x);
    pg8::EpiF<Fn> E{fn};
    pg8::gemm_phase<pg8::EpiF<Fn>, pg8::StaticOrder, true, true>(F.lds + RING_OFF, g, S, E);
}
__global__ void __launch_bounds__(NTHREADS, 2) mk_fwd(Args args) {
    extern __shared__ __attribute__((aligned(16))) unsigned char lds[];
    Frame F;
    F.lds = (LAS unsigned char*)lds;
    F.tid = threadIdx.x; F.lane = F.tid & 63; F.wave = __builtin_amdgcn_readfirstlane(F.tid >> 6);
    F.G = gridDim.x; { const int bx = blockIdx.x; F.vcu = (F.G % 8 == 0) ? (bx % 8) * (F.G / 8) + bx / 8 : bx; }
    volatile LAS unsigned* MISC = (volatile LAS unsigned*)(F.lds + MISC_OFF);
    for (int u = F.tid; u < (LDS_BYTES - LDSCTL_OFF) / 4; u += NTHREADS) ((LAS unsigned*)(F.lds + LDSCTL_OFF))[u] = 0u;
    __syncthreads();
    unsigned char* ws = args.ws;
    XcdBarrier bar; bar.bar = (unsigned*)(ws + WS_CTL) + CW_BAR; bar.x = 0; bar.st = nullptr;
    if (!MK_PER_PHASE) bar = xcd_barrier_post((unsigned*)(ws + WS_CTL) + CW_BAR, MISC + 8);
    const int lo = args.ph_lo, hi = args.ph_hi;
#ifndef PHMASK
#define PHMASK 0x1fff
#endif
#define IN(k) (((PHMASK >> (k)) & 1) && lo <= (k) && (k) < hi)
#define SEAM(k) do { if (IN(k) && IN((k) + 1)) xcd_barrier(bar); } while (0)
    if (IN(0)) { p0_prep(F, args); } SEAM(0);
    if (IN(1)) { run_gemm(F, (const bf16*)(ws + WS_XN), DM, (const bf16*)(ws + WS_WIN), DM, DM, 7168, 0, 0, 0, Fn1a{ws}); } SEAM(1);
    if (IN(2)) { p2_conv(F, args); } SEAM(2);
    if (IN(3)) { run_gemm(F, (const bf16*)(ws + WS_C), MI, (const bf16*)(ws + WS_WQK), MHD, MHD, 4096, 7, 1, MHD, Fn3{ws}); } SEAM(3);
    if (IN(4)) { p4_rec(F, args); } SEAM(4);
    if (IN(5)) { run_gemm(F, (const bf16*)(ws + WS_XN), DM, (const bf16*)(ws + WS_WIN) + (size_t)7168 * DM, DM, DM, 5120, 0, 0, 0, Fn5{ws}); } SEAM(5);
    if (IN(6)) { p6_norm(F, args); } SEAM(6);
    if (IN(7)) { run_gemm(F, (const bf16*)(ws + WS_HMN), MI, (const bf16*)(ws + WS_WBRM), MI, MI, DM, 0, 0, 0, Fn7{ws}); } SEAM(7);
    if (IN(8)) { run_gemm(F, (const bf16*)(ws + WS_OH), DM, (const bf16*)(ws + WS_WBRH), DM, DM, DM, 0, 0, 0, Fn8{ws}); } SEAM(8);
    if (IN(9)) { run_gemm(F, (const bf16*)(ws + WS_Y), DM, (const bf16*)(ws + WS_WOUT), DM, DM, DM, 0, 0, 0, Fn9{ws, args.in[I_XP], args.in[I_XS], args.out}); } SEAM(9);
    if (IN(10)) { run_gemm(F, (const bf16*)(ws + WS_PB), PLE, (const bf16*)(ws + WS_WPLE), PLE, PLE, DM, 0, 0, 0, Fn10{ws}); } SEAM(10);
    if (IN(11)) { run_gemm(F, (const bf16*)(ws + WS_H1B), DM, (const bf16*)(ws + WS_WPG), DM, DM, DM, 0, 0, 0, Fn11{ws, args.out}); } SEAM(11);
    if (IN(12)) { p12_final(F, args); }
#undef IN
#undef SEAM
}

extern "C" void kernel_launch(void* const* d_in, const int* in_sizes, int n_in, void* d_out, int out_size, void* d_ws, size_t ws_size, hipStream_t stream) {
    static int grid = 0;
    if (grid == 0) {
        if (n_in != 27 || out_size != (int)O_END || ws_size < WS_END) { fprintf(stderr, "kernel_launch: unexpected shapes (n_in %d out %d ws %zu)\n", n_in, out_size, ws_size); grid = -1; return; }
        int dev = 0, cus = 0, per_cu = 0;
        if (hipGetDevice(&dev) != hipSuccess || hipDeviceGetAttribute(&cus, hipDeviceAttributeMultiprocessorCount, dev) != hipSuccess) { grid = -1; return; }
        if (hipFuncSetAttribute((const void*)mk_fwd, hipFuncAttributeMaxDynamicSharedMemorySize, LDS_BYTES) != hipSuccess) { grid = -1; return; }
        if (hipOccupancyMaxActiveBlocksPerMultiprocessor(&per_cu, (const void*)mk_fwd, NTHREADS, LDS_BYTES) != hipSuccess || per_cu < 1) { fprintf(stderr, "kernel_launch: occupancy query says %d\n", per_cu); grid = -1; (void)hipGetLastError(); return; }
        grid = cus;
    }
    if (grid < 0) return;
    if (hipMemsetAsync((char*)d_ws + WS_CTL, 0, CTL_ZERO_BYTES, stream) != hipSuccess) return;
    Args a{};
    for (int i = 0; i < 27; ++i) a.in[i] = (const float*)d_in[i];
    a.out = (float*)d_out; a.ws = (unsigned char*)d_ws;
#if MK_PER_PHASE
    for (int p = 0; p < N_PHASES; ++p) { a.ph_lo = p; a.ph_hi = p + 1; a.li = p; hipLaunchKernelGGL(mk_fwd, dim3(grid), dim3(NTHREADS), LDS_BYTES, stream, a); }
#else
    a.ph_lo = 0; a.ph_hi = N_PHASES; a.li = 0;
    hipLaunchKernelGGL(mk_fwd, dim3(grid), dim3(NTHREADS), LDS_BYTES, stream, a);
#endif
}
```

```cpp
#include <hip/hip_runtime.h>
#include <cstdio>
#include <cstdint>
#include <cmath>
namespace pg8 {
#define PG8_LAS __attribute__((address_space(3)))
typedef unsigned short bf16_t;
typedef short bf16x8 __attribute__((ext_vector_type(8)));
typedef float f32x4 __attribute__((ext_vector_type(4)));
typedef unsigned u32x4 __attribute__((ext_vector_type(4)));
constexpr int BM = 256, BK = 64, HALF = 128, HTB = HALF * BK * 2  , STAGE_BYTES = 8 * HTB, NXCD = 8, WGM = 8;

__host__ __device__ __forceinline__ int lds_byte(int r, int c) { const int st = (r >> 4) * 2 + (c >> 5), rr = r & 15, cc = c & 31, ob = rr * 64 + cc * 2; return st * 1024 + (ob ^ (((ob >> 9) & 1) << 5)); }
__host__ __device__ __forceinline__ void stage_rc(int b, int& R, int& C) { const int st = b / 1024, sb = b % 1024, swz = sb ^ (((sb >> 9) & 1) << 5); R = (st >> 1) * 16 + swz / 64; C = (st & 1) * 32 + (swz % 64) / 2; }
__host__ __device__ __forceinline__ int perm32(int rho) { const int n = rho >> 4, i = rho & 15; return 8 * (i >> 2) + 4 * n + (i & 3); }

struct Unit { int pm, pn; };
struct Gemm { const bf16_t* A; const bf16_t* Bt; int lda, ldb, K, amask, ashift, astride;
    __device__ __forceinline__ const char* abase(const Unit& u) const { return (const char*)(A + (size_t)u.pm * BM * lda + (size_t)(((u.pn & amask) >> ashift) * astride)); }
    __device__ __forceinline__ const char* bbase(const Unit& u) const { return (const char*)(Bt + (size_t)u.pn * BM * ldb); } };

struct StaticOrder {
    int nM, nN, nwg, G, c;
    __host__ __device__ void init(int M, int N, int G_, int c_) { nM = M / BM; nN = N / BM; nwg = nM * nN; G = G_; c = c_; }
    __host__ __device__ bool next(int i, Unit& u) const {
        const long L = (long)i * G + c; if (L >= nwg) return false;
        int wgid = (int)L; { const int q = nwg / NXCD, r = nwg % NXCD, xcd = wgid % NXCD, off = wgid / NXCD; wgid = (xcd < r ? xcd * (q + 1) : r * (q + 1) + (xcd - r) * q) + off; }
        const int nig = WGM * nN, gid = wgid / nig, fm = gid * WGM, gsz = (nM - fm) < WGM ? (nM - fm) : WGM;
        u.pm = fm + ((wgid % nig) % gsz); u.pn = (wgid % nig) / gsz; return true;
    }
    __device__ __forceinline__ void a_ready(const Unit&) const {}
    __device__ __forceinline__ void done(const Unit&) const {}
};

__device__ __forceinline__ unsigned cvt_pk_bf16(float lo, float hi) { unsigned r; asm volatile("v_cvt_pk_bf16_f32 %0, %1, %2" : "=v"(r) : "v"(lo), "v"(hi)); return r; }
template <class Epi, class Sched, bool ALIGN_EPI = false, bool SP2 = false>
__device__ __forceinline__ void gemm_phase(PG8_LAS unsigned char* lds, const Gemm g, const Sched& S, const Epi& E) {
    const int lda = g.lda, ldb = g.ldb;
    const int tid = threadIdx.x, wid = __builtin_amdgcn_readfirstlane(tid >> 6), lane = tid & 63, wr = wid >> 2, wc = wid & 3, fr = lane & 15, fq = lane >> 4;
    const int K = g.K, nt = K / BK;
    unsigned voffA[2], voffB[2];
#pragma unroll
    for (int i = 0; i < 2; ++i) { int R, C; stage_rc(tid * 16 + i * 8192, R, C); const int Rb = Epi::PERM ? ((R & ~31) + perm32(R & 31)) : R;
        voffA[i] = (unsigned)(R * lda + C) * 2u; voffB[i] = (unsigned)(Rb * ldb + C) * 2u; }
    const size_t kstep = (size_t)(BK * 2);
    const size_t hstepA = (size_t)HALF * lda * 2, hstepB = (size_t)HALF * ldb * 2;
    const unsigned ldsw = (unsigned)wid * 1024u;
    const int aoff = lds_byte(wr * 64 + fr, fq * 8), boff = lds_byte(wc * 32 + fr, fq * 8);
#define PG8_SA(b, h) (((b) * 2 + (h)) * HTB)
#define PG8_SB(b, h) ((4 + (b) * 2 + (h)) * HTB)
#define PG8_STAGE(bufoff, gbase, voff) do { _Pragma("unroll") for (int _i = 0; _i < 2; ++_i) \
        __builtin_amdgcn_global_load_lds((const unsigned*)((const char*)(gbase) + (voff)[_i]), (PG8_LAS unsigned*)(lds + (bufoff) + ldsw + _i * 8192), 16, 0, 0); } while (0)
#define PG8_LDA(dst, b, h) do { _Pragma("unroll") for (int m = 0; m < 4; ++m) _Pragma("unroll") for (int k = 0; k < 2; ++k) dst[m][k] = *(const PG8_LAS bf16x8*)(lds + PG8_SA(b, h) + aoff + m * 2048 + k * 1024); } while (0)
#define PG8_LDB(dst, b, h) do { _Pragma("unroll") for (int n = 0; n < 2; ++n) _Pragma("unroll") for (int k = 0; k < 2; ++k) dst[n][k] = *(const PG8_LAS bf16x8*)(lds + PG8_SB(b, h) + boff + n * 2048 + k * 1024); } while (0)
#define PG8_MMA(ai, bj, At, Bt) do { __builtin_amdgcn_s_setprio(1); _Pragma("unroll") for (int m = 0; m < 4; ++m) _Pragma("unroll") for (int n = 0; n < 2; ++n) _Pragma("unroll") for (int k = 0; k < 2; ++k) \
        acc[ai][bj][m][n] = __builtin_amdgcn_mfma_f32_16x16x32_bf16(Bt[n][k], At[m][k], acc[ai][bj][m][n], 0, 0, 0); __builtin_amdgcn_s_setprio(0); } while (0)
#define PG8_WAIT_V(n) asm volatile("s_waitcnt vmcnt(" #n ")" ::: "memory")
#define PG8_WAIT_L(n) asm volatile("s_waitcnt lgkmcnt(" #n ")" ::: "memory")
#define PG8_BAR __builtin_amdgcn_s_barrier()
#define PG8_SCHED __builtin_amdgcn_sched_barrier(0)
    Unit cur, nxt; int ui = 0;
    if (!S.next(0, cur)) return;
    f32x4 acc[2][2][4][2];
#pragma unroll
    for (int a = 0; a < 2; ++a)
#pragma unroll
        for (int b = 0; b < 2; ++b)
#pragma unroll
            for (int m = 0; m < 4; ++m)
#pragma unroll
                for (int n = 0; n < 2; ++n) acc[a][b][m][n] = (f32x4){0.f, 0.f, 0.f, 0.f};
    bf16x8 At[4][2], B0[2][2], B1[2][2];
    const char* cA = g.abase(cur); const char* cB = g.bbase(cur);
    S.a_ready(cur);
    if constexpr (SP2) {
        PG8_STAGE(PG8_SB(0, 0), cB, voffB); PG8_STAGE(PG8_SB(0, 1), cB + hstepB, voffB); PG8_STAGE(PG8_SA(0, 0), cA, voffA); PG8_STAGE(PG8_SA(0, 1), cA + hstepA, voffA);
        if (wr == 1) PG8_BAR;
        PG8_WAIT_V(2); PG8_BAR;
        PG8_STAGE(PG8_SB(1, 0), cB + kstep, voffB); PG8_STAGE(PG8_SA(1, 0), cA + kstep, voffA); PG8_STAGE(PG8_SB(1, 1), cB + hstepB + kstep, voffB);
        PG8_WAIT_V(6); PG8_BAR;
    } else {
        PG8_STAGE(PG8_SB(0, 0), cB, voffB); PG8_STAGE(PG8_SA(0, 0), cA, voffA); PG8_STAGE(PG8_SB(0, 1), cB + hstepB, voffB); PG8_STAGE(PG8_SA(0, 1), cA + hstepA, voffA);
        if (wr == 1) PG8_BAR;
        PG8_WAIT_V(4); PG8_BAR;
        PG8_STAGE(PG8_SB(1, 0), cB + kstep, voffB); PG8_STAGE(PG8_SA(1, 0), cA + kstep, voffA); PG8_STAGE(PG8_SB(1, 1), cB + hstepB + kstep, voffB);
        PG8_WAIT_V(6); PG8_BAR;
    }
    for (;;) {
        const bool has_next = S.next(ui + 1, nxt);
        const char* nA = has_next ? g.abase(nxt) : cA; const char* nB = has_next ? g.bbase(nxt) : cB;
        for (int t = 0; t < nt; t += 2) {
            const bool last = (t == nt - 2);
            const char* a1 = cA + (size_t)(t + 1) * kstep;
            const char* a2 = last ? nA : cA + (size_t)(t + 2) * kstep; const char* b2 = last ? nB : cB + (size_t)(t + 2) * kstep;
            const char* a3 = a2 + kstep; const char* b3 = b2 + kstep;
            if (last && has_next) S.a_ready(nxt);
            if constexpr (SP2) {
            PG8_LDB(B0, 0, 0); PG8_LDB(B1, 0, 1); PG8_SCHED; PG8_LDA(At, 0, 0); PG8_STAGE(PG8_SA(1, 1), a1 + hstepA, voffA);
            PG8_WAIT_V(8); PG8_WAIT_L(0); PG8_BAR; PG8_MMA(0, 0, At, B0); PG8_MMA(0, 1, At, B1); PG8_BAR; PG8_SCHED;
            PG8_LDA(At, 0, 1); PG8_STAGE(PG8_SB(0, 0), b2, voffB); PG8_STAGE(PG8_SB(0, 1), b2 + hstepB, voffB); PG8_STAGE(PG8_SA(0, 0), a2, voffA);
            PG8_WAIT_V(8); PG8_WAIT_L(0); PG8_BAR; PG8_MMA(1, 0, At, B0); PG8_MMA(1, 1, At, B1); PG8_BAR; PG8_SCHED;
            PG8_LDB(B0, 1, 0); PG8_LDB(B1, 1, 1); PG8_SCHED; PG8_LDA(At, 1, 0); PG8_STAGE(PG8_SA(0, 1), a2 + hstepA, voffA);
            PG8_WAIT_V(8); PG8_WAIT_L(0); PG8_BAR; PG8_MMA(0, 0, At, B0); PG8_MMA(0, 1, At, B1); PG8_BAR; PG8_SCHED;
            PG8_LDA(At, 1, 1); PG8_STAGE(PG8_SB(1, 0), b3, voffB); PG8_STAGE(PG8_SB(1, 1), b3 + hstepB, voffB); PG8_STAGE(PG8_SA(1, 0), a3, voffA);
            PG8_WAIT_V(8); PG8_WAIT_L(0); PG8_BAR; PG8_MMA(1, 0, At, B0); PG8_MMA(1, 1, At, B1); PG8_BAR; PG8_SCHED;
            } else {
            PG8_LDB(B0, 0, 0); PG8_SCHED; PG8_LDA(At, 0, 0); PG8_STAGE(PG8_SA(1, 1), a1 + hstepA, voffA);
            PG8_WAIT_L(8); PG8_BAR; PG8_WAIT_L(0); PG8_MMA(0, 0, At, B0); PG8_BAR; PG8_SCHED;
            PG8_LDB(B1, 0, 1); PG8_STAGE(PG8_SB(0, 0), b2, voffB);
            PG8_BAR; PG8_WAIT_L(0); PG8_MMA(0, 1, At, B1); PG8_BAR;
            PG8_LDA(At, 0, 1); PG8_STAGE(PG8_SA(0, 0), a2, voffA);
            PG8_BAR; PG8_WAIT_L(0); PG8_MMA(1, 0, At, B0); PG8_BAR; PG8_SCHED;
            PG8_STAGE(PG8_SB(0, 1), b2 + hstepB, voffB);
            PG8_WAIT_V(6); PG8_BAR; PG8_MMA(1, 1, At, B1); PG8_BAR;
            PG8_LDB(B0, 1, 0); PG8_SCHED; PG8_LDA(At, 1, 0); PG8_STAGE(PG8_SA(0, 1), a2 + hstepA, voffA);
            PG8_WAIT_L(8); PG8_BAR; PG8_WAIT_L(0); PG8_MMA(0, 0, At, B0); PG8_BAR; PG8_SCHED;
            PG8_LDB(B1, 1, 1); PG8_STAGE(PG8_SB(1, 0), b3, voffB);
            PG8_BAR; PG8_WAIT_L(0); PG8_MMA(0, 1, At, B1); PG8_BAR;
            PG8_LDA(At, 1, 1); PG8_STAGE(PG8_SA(1, 0), a3, voffA);
            PG8_BAR; PG8_WAIT_L(0); PG8_MMA(1, 0, At, B0); PG8_BAR; PG8_SCHED;
            PG8_STAGE(PG8_SB(1, 1), b3 + hstepB, voffB);
            PG8_WAIT_V(6); PG8_BAR; PG8_MMA(1, 1, At, B1); PG8_BAR;
            }
        }
        if constexpr (ALIGN_EPI) { if (wr == 0) PG8_BAR; }
        if constexpr (!Epi::AFTER_DRAIN) { E(acc, cur, wr, wc, fr, fq); S.done(cur); }
        if (!has_next) break;
#pragma unroll
        for (int a = 0; a < 2; ++a)
#pragma unroll
            for (int b = 0; b < 2; ++b)
#pragma unroll
                for (int m = 0; m < 4; ++m)
#pragma unroll
                    for (int n = 0; n < 2; ++n) acc[a][b][m][n] = (f32x4){0.f, 0.f, 0.f, 0.f};
        cur = nxt; cA = nA; cB = nB; ++ui;
        if constexpr (ALIGN_EPI) { if (wr == 1) PG8_BAR; }
    }
    PG8_WAIT_V(0);
    if constexpr (!ALIGN_EPI) { if (wr == 0) PG8_BAR; }
    PG8_BAR;
    if constexpr (Epi::AFTER_DRAIN) { E.fused(acc, cur, wr, wc, fr, fq, lds, wid, lane); S.done(cur); }
#undef PG8_SA
#undef PG8_SB
#undef PG8_STAGE
#undef PG8_LDA
#undef PG8_LDB
#undef PG8_MMA
#undef PG8_WAIT_V
#undef PG8_WAIT_L
#undef PG8_BAR
#undef PG8_SCHED
}

template <class Fn> struct EpiF {
    static constexpr bool PERM = true, AFTER_DRAIN = false;
    Fn f;
    __device__ __forceinline__ void operator()(const f32x4 (&acc)[2][2][4][2], const Unit& u, int wr, int wc, int fr, int fq) const {
        const int row0 = u.pm * BM + wr * 64 + fr, ct0 = wc * 32 + 8 * fq;
#pragma unroll
        for (int ai = 0; ai < 2; ++ai)
#pragma unroll
            for (int m = 0; m < 4; ++m)
#pragma unroll
                for (int bj = 0; bj < 2; ++bj) f(row0 + ai * HALF + m * 16, u.pn, ct0 + bj * HALF, acc[ai][bj][m][0], acc[ai][bj][m][1]);
    }
};
}

constexpr int NWAVES = 8, NTHREADS = 512;
constexpr int DM = 1024, MI = 2048, NSRC = 12296, PLE = 256;
constexpr int TP = 4096, TS = 32, BP = 4, BS = 32;
constexpr int NTOK_P = BP * TP, NTOK_S = BS * TS, NTOK = NTOK_P + NTOK_S;
constexpr int MH = 4, MHD = 512, HH = 8, HE = 128;
constexpr float EPS = 1e-6f;
constexpr size_t O_Y = 0, O_CONVP = 17825792, O_CP = 17850368, O_NP = 22044672, O_MP = 22052864, O_SP = 22052880,
                 O_CONVS = 22577168, O_CS = 22773776, O_NS = 56328208, O_MS = 56393744, O_SS = 56393872, O_END = 60588176;
constexpr size_t MiB = 1u << 20;
constexpr size_t WS_CTL = 0, CTL_ZERO_BYTES = 1 * MiB;
constexpr size_t WS_GATES = 1 * MiB, WS_PB = 2 * MiB;
constexpr size_t WS_WIN = 12 * MiB, WS_WQK = 36 * MiB, WS_WBRM = 40 * MiB, WS_WBRH = 44 * MiB, WS_WOUT = 46 * MiB, WS_WPG = 48 * MiB, WS_WPLE = 50 * MiB;
constexpr size_t WS_XN = 52 * MiB, WS_U = 86 * MiB, WS_V = 154 * MiB, WS_QH = 222 * MiB, WS_FH = 256 * MiB, WS_IH = 290 * MiB, WS_C = 324 * MiB, WS_K = 392 * MiB, WS_HO = 460 * MiB;
constexpr size_t WS_END = 501 * MiB;
constexpr size_t WS_Q = WS_U, WS_ZP = WS_V, WS_GHP = WS_QH, WS_GAP = WS_FH, WS_GBP = WS_IH, WS_HMN = WS_U, WS_OH = WS_K, WS_YA = WS_K + 34 * MiB, WS_Y = WS_C, WS_H1B = WS_C + 34 * MiB, WS_G2 = WS_HO;
constexpr int CW_BAR = 4096;
constexpr int RING_OFF = 0, RING_BYTES = 131072, LDSCTL_OFF = RING_BYTES, MISC_OFF = LDSCTL_OFF + 320, LDS_BYTES = 147456;

#define GAS __attribute__((address_space(1)))
#define LAS __attribute__((address_space(3)))
typedef unsigned short bf16;
typedef unsigned v4u __attribute__((ext_vector_type(4)));
typedef unsigned v2u __attribute__((ext_vector_type(2)));
typedef float f32x4 __attribute__((ext_vector_type(4)));
typedef GAS unsigned gu32;
#define RLX_AGENT __ATOMIC_RELAXED, __HIP_MEMORY_SCOPE_AGENT
#define LDS_WAIT() asm volatile("s_waitcnt lgkmcnt(0)" ::: "memory")
#define VM_WAIT() asm volatile("s_waitcnt vmcnt(0)" ::: "memory")
__device__ __forceinline__ unsigned f2bf(float f) { unsigned u = __builtin_bit_cast(unsigned, f); return (u + 0x7fffu + ((u >> 16) & 1u)) >> 16; }
__device__ __forceinline__ unsigned pk2(float lo, float hi) { return f2bf(lo) | (f2bf(hi) << 16); }
__device__ __forceinline__ float bflo(unsigned w) { return __builtin_bit_cast(float, w << 16); }
__device__ __forceinline__ float bfhi(unsigned w) { return __builtin_bit_cast(float, w & 0xffff0000u); }
__device__ __forceinline__ float bf2f(bf16 h) { return __builtin_bit_cast(float, (unsigned)h << 16); }
__device__ __forceinline__ void unpack8(v4u w, float (&o)[8]) { o[0] = bflo(w.x); o[1] = bfhi(w.x); o[2] = bflo(w.y); o[3] = bfhi(w.y); o[4] = bflo(w.z); o[5] = bfhi(w.z); o[6] = bflo(w.w); o[7] = bfhi(w.w); }
__device__ __forceinline__ v4u pack8(const float (&o)[8]) { v4u w; w.x = pk2(o[0], o[1]); w.y = pk2(o[2], o[3]); w.z = pk2(o[4], o[5]); w.w = pk2(o[6], o[7]); return w; }
__device__ __forceinline__ float sigmoidf_(float x) { return __builtin_amdgcn_rcpf(1.0f + __expf(-x)); }
__device__ __forceinline__ float siluf_(float x) { return x * sigmoidf_(x); }
__device__ __forceinline__ float logsigmoidf_(float x) { return fminf(x, 0.f) - log1pf(__expf(-fabsf(x))); }

#define XB_TMO      128
#define XB_XCNT(j)  (256  + 64 * (j))
#define XB_XSUB(j)  (1280 + 64 * (j))
#define XB_XGEN(j)  (2304 + 64 * (j))
#define XB_TOP      3328
#define XB_TOPGEN   3392
#define XCD_BAR_WORDS 3456
#define XB_SPIN_CAP (1u << 18)
__device__ __forceinline__ unsigned xb_ld(unsigned* p)              { return __hip_atomic_load(p, __ATOMIC_RELAXED, __HIP_MEMORY_SCOPE_AGENT); }
__device__ __forceinline__ unsigned xb_add(unsigned* p, unsigned v) { return __hip_atomic_fetch_add(p, v, __ATOMIC_RELAXED, __HIP_MEMORY_SCOPE_AGENT); }
__device__ __forceinline__ unsigned xb_xcc_id() { return (unsigned)__builtin_amdgcn_s_getreg((3 << 11) | 20) & 0xFu; }
#define XB_SPIN(cond, bar) do { unsigned _sp = 0; while (cond) { __builtin_amdgcn_s_sleep(1); \
    if ((++_sp & 255u) == 0u) { if (xb_ld(&(bar)[XB_TMO])) break; if (_sp > XB_SPIN_CAP) { atomicAdd(&(bar)[XB_TMO], 1u); break; } } } } while (0)
struct XcdBarrier { unsigned* bar; unsigned x; volatile LAS unsigned* st; };
__device__ __forceinline__ XcdBarrier xcd_barrier_post(unsigned* bar, volatile LAS unsigned* st) {
    XcdBarrier b; b.bar = bar; b.x = xb_xcc_id(); b.st = st;
    if (threadIdx.x == 0) (void)xb_add(&bar[XB_XCNT(b.x)], 1u);
    return b;
}
__device__ __forceinline__ void xcd_barrier_complete(unsigned* bar, unsigned x, unsigned& nloc, unsigned& nx) {
    const unsigned G = gridDim.x * gridDim.y * gridDim.z;
    unsigned sum, cnt, mine, sp = 0u;
    for (;;) {
        sum = 0u; cnt = 0u; mine = 0u;
#pragma unroll
        for (unsigned j = 0; j < 16; ++j) { const unsigned c = xb_ld(&bar[XB_XCNT(j)]); sum += c; cnt += (c > 0u) ? 1u : 0u; mine = (j == x) ? c : mine; }
        if (sum == G) break;
        __builtin_amdgcn_s_sleep(1);
        if ((++sp & 255u) == 0u) { if (xb_ld(&bar[XB_TMO])) break; if (sp > XB_SPIN_CAP) { atomicAdd(&bar[XB_TMO], 1u); break; } }
    }
    nloc = mine > 0u ? mine : 1u; nx = cnt > 0u ? cnt : 1u;
}
__device__ __forceinline__ void xcd_barrier(const XcdBarrier& b) {
    asm volatile("s_waitcnt vmcnt(0)" ::: "memory");
    __syncthreads();
    if (threadIdx.x == 0) {
        unsigned* bar = b.bar;
        __builtin_amdgcn_s_waitcnt(0);
        unsigned nloc = b.st[0], nx = b.st[1];
        if (nloc == 0u) { xcd_barrier_complete(bar, b.x, nloc, nx); b.st[0] = nloc; b.st[1] = nx; }
        const unsigned old = xb_add(&bar[XB_XSUB(b.x)], 1u);
        const unsigned gen = old / nloc;
        if (old + 1u == (gen + 1u) * nloc) {
            __builtin_amdgcn_fence(__ATOMIC_RELEASE, "agent");
            asm volatile("s_waitcnt vmcnt(0)" ::: "memory");
            const unsigned og = xb_add(&bar[XB_TOP], 1u);
            const unsigned tg = og / nx;
            if (og + 1u == (tg + 1u) * nx) xb_add(&bar[XB_TOPGEN], 1u);
            else XB_SPIN(xb_ld(&bar[XB_TOPGEN]) == tg, bar);
            __builtin_amdgcn_fence(__ATOMIC_ACQUIRE, "agent");
            xb_add(&bar[XB_XGEN(b.x)], 1u);
            asm volatile("s_waitcnt vmcnt(0)" ::: "memory");
        } else {
            XB_SPIN(xb_ld(&bar[XB_XGEN(b.x)]) == gen, bar);
            __builtin_amdgcn_fence(__ATOMIC_ACQUIRE, "agent");
            asm volatile("s_waitcnt vmcnt(0)" ::: "memory");
        }
    }
    __syncthreads();
}

struct Args { const float* in[27]; float* out; unsigned char* ws; int ph_lo, ph_hi, li, pad; };
enum { I_XP = 0, I_XS, I_SCONV, I_SC, I_SN, I_SM, I_SH, I_PP, I_PS, I_NORMG, I_WIN, I_BIG, I_BFG, I_CONVW, I_CONVB, I_WQM, I_WKM, I_MNORMG, I_MSKIP, I_WBRM, I_LB, I_HNORMG, I_WBRH, I_WOUT, I_WPLE, I_WPG, I_FINALG };
struct Frame { LAS unsigned char* lds; int tid, lane, wave, vcu, G; };

__device__ __forceinline__ float wave_sum(float v) {
#pragma unroll
    for (int o = 1; o < 64; o <<= 1) v += __shfl_xor(v, o);
    return v;
}
__device__ __forceinline__ const float* xrow(const Args& a, int m) { return m < NTOK_P ? a.in[I_XP] + (size_t)m * DM : a.in[I_XS] + (size_t)(m - NTOK_P) * DM; }

__device__ __forceinline__ void p0_transpose_item(const float* W, int pitch, int K, int ncols, bf16* WT, int row_off, LAS float* scr, int item, int lane) {
    const int nblk = ncols / 32, kb = item / nblk, nb = item % nblk, k0 = 64 * kb, n0 = 32 * nb;
#pragma unroll 8
    for (int i = 0; i < 32; ++i) { const int kk = 2 * i + (lane >> 5); scr[kk * 33 + (lane & 31)] = W[(size_t)(k0 + kk) * pitch + n0 + (lane & 31)]; }
    LDS_WAIT(); asm volatile("" ::: "memory");
    const int c = lane & 7;
#pragma unroll
    for (int j = 0; j < 4; ++j) { const int n = (lane >> 3) + 8 * j; const LAS float* s = scr + (8 * c) * 33 + n;
        v4u o; o.x = pk2(s[0 * 33], s[1 * 33]); o.y = pk2(s[2 * 33], s[3 * 33]); o.z = pk2(s[4 * 33], s[5 * 33]); o.w = pk2(s[6 * 33], s[7 * 33]);
        *(GAS v4u*)(WT + (size_t)(row_off + n0 + n) * K + k0 + 8 * c) = o; }
    LDS_WAIT(); asm volatile("" ::: "memory");
}
struct Seg { const float* W; int pitch, K, ncols; bf16* WT; int row_off, items; };
__device__ __forceinline__ Seg seg_info(int s, const Args& a) {
    Seg g; unsigned char* ws = a.ws;
    switch (s) {
    case 0: g = Seg{a.in[I_WIN] + 0,    NSRC, 1024, 4096, (bf16*)(ws + WS_WIN), 0,    0}; break;
    case 1: g = Seg{a.in[I_WIN] + 6152, NSRC, 1024, 3072, (bf16*)(ws + WS_WIN), 4096, 0}; break;
    case 2: g = Seg{a.in[I_WIN] + 4096, NSRC, 1024, 2048, (bf16*)(ws + WS_WIN), 7168, 0}; break;
    case 3: g = Seg{a.in[I_WIN] + 9224, NSRC, 1024, 3072, (bf16*)(ws + WS_WIN), 9216, 0}; break;
    case 4: case 5: case 6: case 7: g = Seg{a.in[I_WQM] + (size_t)(s - 4) * 262144, 512, 512, 512, (bf16*)(ws + WS_WQK), (s - 4) * 512, 0}; break;
    case 8: case 9: case 10: case 11: g = Seg{a.in[I_WKM] + (size_t)(s - 8) * 262144, 512, 512, 512, (bf16*)(ws + WS_WQK), 2048 + (s - 8) * 512, 0}; break;
    case 12: g = Seg{a.in[I_WBRM], 1024, 2048, 1024, (bf16*)(ws + WS_WBRM), 0, 0}; break;
    case 13: g = Seg{a.in[I_WBRH], 1024, 1024, 1024, (bf16*)(ws + WS_WBRH), 0, 0}; break;
    case 14: g = Seg{a.in[I_WOUT], 1024, 1024, 1024, (bf16*)(ws + WS_WOUT), 0, 0}; break;
    case 15: g = Seg{a.in[I_WPG],  1024, 1024, 1024, (bf16*)(ws + WS_WPG),  0, 0}; break;
    default: g = Seg{a.in[I_WPLE], 1024, 256,  1024, (bf16*)(ws + WS_WPLE), 0, 0}; break;
    }
    g.items = (g.K / 64) * (g.ncols / 32);
    return g;
}
__device__ __forceinline__ void p0_prep(Frame& F, const Args& a) {
    LAS float* scr = (LAS float*)(F.lds + RING_OFF + F.wave * 16384);
    const int gw = F.vcu * NWAVES + F.wave, NGW = F.G * NWAVES;
    for (int s = 0; s < 17; ++s) {
        const Seg g = seg_info(s, a);
        for (int it = gw; it < g.items; it += NGW) p0_transpose_item(g.W, g.pitch, g.K, g.ncols, g.WT, g.row_off, scr, it, F.lane);
    }
    __syncthreads();
    LAS float* wg = (LAS float*)(F.lds + RING_OFF);
    for (int i = F.tid; i < 8192; i += NTHREADS) { const int k = i >> 3, q = i & 7; wg[q * 1024 + k] = a.in[I_WIN][(size_t)k * NSRC + 6144 + q]; }
    __syncthreads();
    bf16* XN = (bf16*)(a.ws + WS_XN); float* GATES = (float*)(a.ws + WS_GATES);
    const float* ng = a.in[I_NORMG];
    for (int m = gw; m < NTOK; m += NGW) {
        const GAS f32x4* xr = (const GAS f32x4*)xrow(a, m) + F.lane;
        f32x4 v[4]; float ss = 0.f;
#pragma unroll
        for (int j = 0; j < 4; ++j) { v[j] = xr[64 * j]; ss += (v[j].x * v[j].x + v[j].y * v[j].y) + (v[j].z * v[j].z + v[j].w * v[j].w); }
        const float rstd = 1.0f / sqrtf(wave_sum(ss) * (1.f / DM) + EPS);
        GAS v2u* o8 = (GAS v2u*)(XN + (size_t)m * DM) + F.lane;
        float gacc[8];
#pragma unroll
        for (int q = 0; q < 8; ++q) gacc[q] = 0.f;
#pragma unroll
        for (int j = 0; j < 4; ++j) {
            const f32x4 gg = *(const GAS f32x4*)(ng + 4 * F.lane + 256 * j);
            v[j] = v[j] * rstd * gg;
            v2u w; w.x = pk2(v[j].x, v[j].y); w.y = pk2(v[j].z, v[j].w); o8[64 * j] = w;
#pragma unroll
            for (int q = 0; q < 8; ++q) { const f32x4 ww = *(const LAS f32x4*)(wg + q * 1024 + 4 * F.lane + 256 * j); gacc[q] += (v[j].x * ww.x + v[j].y * ww.y) + (v[j].z * ww.z + v[j].w * ww.w); }
        }
#pragma unroll
        for (int q = 0; q < 8; ++q) gacc[q] = wave_sum(gacc[q]);
        if (F.lane == 0) {
#pragma unroll
            for (int q = 0; q < 4; ++q) { GATES[(size_t)m * 8 + q] = gacc[q] + a.in[I_BIG][q]; GATES[(size_t)m * 8 + 4 + q] = logsigmoidf_(gacc[4 + q] + a.in[I_BFG][q]); }
        }
    }
    bf16* PB = (bf16*)(a.ws + WS_PB);
    for (int i = F.vcu * NTHREADS + F.tid; i < NTOK * 32; i += F.G * NTHREADS) {
        const int m = i >> 5, c8 = (i & 31) * 8;
        const float* src = (m < NTOK_P ? a.in[I_PP] + (size_t)m * PLE : a.in[I_PS] + (size_t)(m - NTOK_P) * PLE) + c8;
        const f32x4 p0 = *(const GAS f32x4*)src, p1 = *(const GAS f32x4*)(src + 4);
        v4u w; w.x = pk2(p0.x, p0.y); w.y = pk2(p0.z, p0.w); w.z = pk2(p1.x, p1.y); w.w = pk2(p1.z, p1.w);
        *(GAS v4u*)(PB + (size_t)m * PLE + c8) = w;
    }
}

__device__ __forceinline__ void p2_conv(Frame& F, const Args& a) {
    const bf16* U = (const bf16*)(a.ws + WS_U); bf16* C = (bf16*)(a.ws + WS_C);
    const float* cw = a.in[I_CONVW]; const float* cb = a.in[I_CONVB]; const float* sconv = a.in[I_SCONV];
    for (int i = F.vcu * NTHREADS + F.tid; i < NTOK * 256; i += F.G * NTHREADS) {
        const int tok = i >> 8, ch = (i & 255) * 8;
        const bool smp = tok >= NTOK_P;
        const int b = smp ? (tok - NTOK_P) >> 5 : tok >> 12, t = smp ? (tok - NTOK_P) & 31 : tok & 4095;
        float acc[8];
        { const f32x4 b0 = *(const GAS f32x4*)(cb + ch), b1 = *(const GAS f32x4*)(cb + ch + 4); acc[0] = b0.x; acc[1] = b0.y; acc[2] = b0.z; acc[3] = b0.w; acc[4] = b1.x; acc[5] = b1.y; acc[6] = b1.z; acc[7] = b1.w; }
        float ucur[8];
#pragma unroll
        for (int j = 0; j < 4; ++j) {
            const int tp = t - 3 + j;
            float val[8];
            if (tp >= 0) { unpack8(*(const GAS v4u*)(U + (size_t)(tok - 3 + j) * MI + ch), val); }
            else if (smp) { const float* s = sconv + (size_t)(b * 3 + (3 + tp)) * MI + ch; const f32x4 s0 = *(const GAS f32x4*)s, s1 = *(const GAS f32x4*)(s + 4);
                val[0] = s0.x; val[1] = s0.y; val[2] = s0.z; val[3] = s0.w; val[4] = s1.x; val[5] = s1.y; val[6] = s1.z; val[7] = s1.w; }
            else {
#pragma unroll
                for (int e = 0; e < 8; ++e) val[e] = 0.f; }
            const f32x4 w0 = *(const GAS f32x4*)(cw + (size_t)j * MI + ch), w1 = *(const GAS f32x4*)(cw + (size_t)j * MI + ch + 4);
            acc[0] += val[0] * w0.x; acc[1] += val[1] * w0.y; acc[2] += val[2] * w0.z; acc[3] += val[3] * w0.w;
            acc[4] += val[4] * w1.x; acc[5] += val[5] * w1.y; acc[6] += val[6] * w1.z; acc[7] += val[7] * w1.w;
            if (j == 3) {
#pragma unroll
                for (int e = 0; e < 8; ++e) ucur[e] = val[e]; }
        }
#pragma unroll
        for (int e = 0; e < 8; ++e) acc[e] = siluf_(acc[e]);
        *(GAS v4u*)(C + (size_t)tok * MI + ch) = pack8(acc);
        const int tl = smp ? TS : TP;
        if (t >= tl - 3) {
            float* dst = a.out + (smp ? O_CONVS : O_CONVP) + (size_t)(b * 3 + (t - (tl - 3))) * MI + ch;
            *(GAS f32x4*)dst = (f32x4){ucur[0], ucur[1], ucur[2], ucur[3]}; *(GAS f32x4*)(dst + 4) = (f32x4){ucur[4], ucur[5], ucur[6], ucur[7]};
        }
    }
}

typedef short s16x4 __attribute__((ext_vector_type(4)));
typedef short bf16x8 __attribute__((ext_vector_type(8)));
typedef float f32x16 __attribute__((ext_vector_type(16)));
typedef float f32x2 __attribute__((ext_vector_type(2)));
typedef __bf16 bf16x2v __attribute__((ext_vector_type(2)));
#define MFMA32(a, b, c) __builtin_amdgcn_mfma_f32_32x32x16_bf16((a), (b), (c), 0, 0, 0)
__device__ __forceinline__ unsigned pkc(float lo, float hi) { f32x2 f = {lo, hi}; bf16x2v h = __builtin_convertvector(f, bf16x2v); return __builtin_bit_cast(unsigned, h); }
__device__ __forceinline__ int crow(int reg, int hh) { return (reg & 3) + 8 * (reg >> 2) + 4 * hh; }
__device__ __forceinline__ bf16x8 pack_step(const f32x16& x, int s) {
    v4u p; p.x = pkc(x[8 * s], x[8 * s + 1]); p.y = pkc(x[8 * s + 2], x[8 * s + 3]); p.z = pkc(x[8 * s + 4], x[8 * s + 5]); p.w = pkc(x[8 * s + 6], x[8 * s + 7]);
    return __builtin_bit_cast(bf16x8, p);
}
__device__ __forceinline__ s16x4 trr(LAS unsigned char* p) { return __builtin_amdgcn_ds_read_tr16_b64_v4i16((LAS s16x4*)p); }
__device__ __forceinline__ bf16x8 tr_frag(LAS unsigned char* img, int pitch, int k0, int c0, int lane) {
    const int hh = lane >> 5, blk = (lane >> 4) & 1, qq = (lane & 15) >> 2, pp = lane & 3;
    LAS unsigned char* p = img + (k0 + 8 * hh + qq) * pitch + (c0 + 16 * blk + 4 * pp) * 2;
    const s16x4 lo = trr(p), hi = trr(p + 4 * pitch);
    return __builtin_shufflevector(lo, hi, 0, 1, 2, 3, 4, 5, 6, 7);
}

constexpr size_t WS_PT = 494 * MiB, WS_SC = 499 * MiB, WS_DENI = 500 * MiB;

__device__ __forceinline__ void p2_scan(Frame& F, const Args& a) {
    const int gw = F.vcu * NWAVES + F.wave, NGW = F.G * NWAVES, lane = F.lane;
    const float* GATES = (const float*)(a.ws + WS_GATES); float* SC = (float*)(a.ws + WS_SC);
    for (int sh = gw; sh < 36 * MH; sh += NGW) {
        const int seq = sh >> 2, h = sh & 3; const bool smp = seq >= BP; const int b = smp ? seq - BP : seq;
        const int tok0 = smp ? NTOK_P + b * TS : b * TP;
        const float minit = smp ? a.in[I_SM][b * MH + h] : 0.f;
        const float NEG = -3.0e38f;
        if (!smp) {
            const float* G = GATES + (size_t)(tok0 + lane * 64) * 8;
            float s = 0.f;
            for (int j = 0; j < 64; ++j) s += G[j * 8 + 4 + h];
            float incl = s;
#pragma unroll
            for (int o = 1; o < 64; o <<= 1) { const float v = __shfl_up(incl, o); if (lane >= o) incl += v; }
            const float base = incl - s;
            float bg = base, mx = NEG;
            for (int j = 0; j < 64; ++j) { bg += G[j * 8 + 4 + h]; mx = fmaxf(mx, G[j * 8 + h] - bg); }
            float pm = mx;
#pragma unroll
            for (int o = 1; o < 64; o <<= 1) { const float v = __shfl_up(pm, o); if (lane >= o) pm = fmaxf(pm, v); }
            float ex = __shfl_up(pm, 1); if (lane == 0) ex = NEG;
            float run = fmaxf(minit, ex);
            bg = base;
            float* o = SC + (size_t)(tok0 + lane * 64) * 8 + h * 2;
            for (int j = 0; j < 64; ++j) { bg += G[j * 8 + 4 + h]; run = fmaxf(run, G[j * 8 + h] - bg); o[j * 8] = bg; o[j * 8 + 1] = bg + run; }
        } else {
            const int t = lane & 31; const float* G = GATES + (size_t)(tok0 + t) * 8;
            const float lf = G[4 + h], ig = G[h];
            float incl = lf;
#pragma unroll
            for (int o = 1; o < 32; o <<= 1) { const float v = __shfl_up(incl, o); if (t >= o) incl += v; }
            float pm = ig - incl;
#pragma unroll
            for (int o = 1; o < 32; o <<= 1) { const float v = __shfl_up(pm, o); if (t >= o) pm = fmaxf(pm, v); }
            if (lane < 32) { float* o = SC + (size_t)(tok0 + t) * 8 + h * 2; o[0] = incl; o[1] = incl + fmaxf(minit, pm); }
        }
    }
}

__device__ __forceinline__ void p4_ptiles(Frame& F, const Args& a) {
    const int gw = F.vcu * NWAVES + F.wave, NGW = F.G * NWAVES, lane = F.lane, r = lane & 31, hh = lane >> 5;
    const bf16* Q = (const bf16*)(a.ws + WS_Q); const bf16* K = (const bf16*)(a.ws + WS_K);
    const float* GATES = (const float*)(a.ws + WS_GATES); const float* SC = (const float*)(a.ws + WS_SC);
    bf16* PT = (bf16*)(a.ws + WS_PT); float* DENI = (float*)(a.ws + WS_DENI);
    for (int u = gw; u < 2176; u += NGW) {
        int b, h, tok0;
        if (u < 2048) { const int bh = u >> 7, c = u & 127; b = bh >> 2; h = bh & 3; tok0 = b * TP + c * 32; }
        else { const int bh = u - 2048; b = bh >> 2; h = bh & 3; tok0 = NTOK_P + b * TS; }
        const bf16* qp = Q + (size_t)(tok0 + r) * MI + h * MHD + 8 * hh;
        const bf16* kp = K + (size_t)(tok0 + r) * MI + h * MHD + 8 * hh;
        f32x16 acc;
#pragma unroll
        for (int i = 0; i < 16; ++i) acc[i] = 0.f;
#pragma unroll 8
        for (int ks = 0; ks < 32; ++ks) {
            const bf16x8 af = *(const GAS bf16x8*)(qp + 16 * ks), bfr = *(const GAS bf16x8*)(kp + 16 * ks);
            acc = MFMA32(af, bfr, acc);
        }
        const float* sc = SC + (size_t)(tok0 + r) * 8 + h * 2;
        const float Bg = sc[0], m = sc[1], ig = GATES[(size_t)(tok0 + r) * 8 + h];
        const float cs = ig - Bg, rt = Bg - m;
#pragma unroll
        for (int reg = 0; reg < 16; ++reg) {
            const int t = crow(reg, hh);
            const float rtt = __shfl(rt, t);
            const float p = (r <= t) ? acc[reg] * __expf(rtt + cs) : 0.f;
            float sum = p;
#pragma unroll
            for (int o = 1; o < 32; o <<= 1) sum += __shfl_xor(sum, o);
            PT[(size_t)u * 1024 + t * 32 + r] = (bf16)(pkc(p, 0.f) & 0xffffu);
            if (r == 0) DENI[(size_t)(tok0 + t) * 4 + h] = sum;
        }
    }
}

namespace mr {
constexpr int QP = 1032, KP = 1088, VP = 192, PPI = 80, HP = 144;
constexpr int L_Q = 0, L_K = 33024, L_V = 67840, L_P = 73984, L_RED = 76544, L_N = 101120, L_SC = 103168, L_H = 104192, L_END = 108800;
}
__device__ __forceinline__ void rec_mlstm(Frame& F, const Args& a, int unit) {
    using namespace mr;
    const bool smp = unit >= 128; const int uu = smp ? unit - 128 : unit;
    const int bh = uu >> 3, es = uu & 7, b = bh >> 2, h = bh & 3;
    const int T = smp ? TS : TP, tok0 = smp ? NTOK_P + b * TS : b * TP, nsteps = T / 32;
    const int tid = F.tid, lane = F.lane, w = F.wave, we = w & 1, wd = w >> 1, r = lane & 31, hh = lane >> 5;
    const int el0 = we * 32, dt0 = wd * 128;
    LAS unsigned char* lds = F.lds + RING_OFF;
    LAS float* LN = (LAS float*)(lds + L_N); LAS float* LS = (LAS float*)(lds + L_SC);
    const bf16* Q = (const bf16*)(a.ws + WS_Q); const bf16* K = (const bf16*)(a.ws + WS_K); const bf16* V = (const bf16*)(a.ws + WS_V);
    const float* GATES = (const float*)(a.ws + WS_GATES); const float* SC = (const float*)(a.ws + WS_SC);
    const float* DENI = (const float*)(a.ws + WS_DENI);
    const bf16* PT = (const bf16*)(a.ws + WS_PT) + (size_t)(smp ? 2048 + bh : bh * 128) * 1024;
    bf16* HM = (bf16*)a.out;
    __syncthreads();
    f32x16 Ct[4];
    if (smp) {
        const float* c0 = a.in[I_SC] + ((size_t)bh * MHD + es * 64 + el0 + r) * MHD + dt0 + 4 * hh;
#pragma unroll
        for (int i = 0; i < 4; ++i)
#pragma unroll
            for (int g = 0; g < 4; ++g) { const f32x4 v = *(const GAS f32x4*)(c0 + 32 * i + 8 * g); Ct[i][4 * g] = v.x; Ct[i][4 * g + 1] = v.y; Ct[i][4 * g + 2] = v.z; Ct[i][4 * g + 3] = v.w; }
        LN[tid] = a.in[I_SN][(size_t)bh * MHD + tid];
    } else {
#pragma unroll
        for (int i = 0; i < 4; ++i)
#pragma unroll
            for (int g = 0; g < 16; ++g) Ct[i][g] = 0.f;
        LN[tid] = 0.f;
    }
    float Bprev = 0.f, mprev = smp ? a.in[I_SM][bh] : 0.f;
    v4u rq[4], rk[4], rv = {0u, 0u, 0u, 0u}, rp = {0u, 0u, 0u, 0u}; float sBg = 0.f, sm = 0.f, sig = 0.f, sde = 0.f;
    const size_t colq = (size_t)h * MHD;
#define MR_LOAD(c0) do { \
        _Pragma("unroll") for (int i = 0; i < 4; ++i) { const int piece = tid + 512 * i, row = piece >> 6, c16 = piece & 63; const size_t off = (size_t)(tok0 + (c0) + row) * MI + colq + c16 * 8; \
            rq[i] = *(const GAS v4u*)(Q + off); rk[i] = *(const GAS v4u*)(K + off); } \
        if (tid < 256) { const int row = tid >> 3, c16 = tid & 7; rv = *(const GAS v4u*)(V + (size_t)(tok0 + (c0) + row) * MI + colq + es * 64 + c16 * 8); } \
        if (tid < 128) { const int row = tid >> 2, c16 = tid & 3; rp = *(const GAS v4u*)(PT + (size_t)((c0) >> 5) * 1024 + row * 32 + c16 * 8); } \
        if (tid < 32) { const size_t tk = (size_t)(tok0 + (c0) + tid); sBg = SC[tk * 8 + h * 2]; sm = SC[tk * 8 + h * 2 + 1]; sig = GATES[tk * 8 + h]; sde = DENI[tk * 4 + h]; } } while (0)
    MR_LOAD(0);
    for (int step = 0; step < nsteps; ++step) {
        const int c0 = step * 32;
        if (tid < 32) { LS[tid] = sBg; LS[32 + tid] = sm; LS[64 + tid] = sig; LS[96 + tid] = __expf(sBg - Bprev + mprev - sm); LS[128 + tid] = __expf(-sm); LS[160 + tid] = sde; }
        __syncthreads();
        const float BL = LS[31], mL = LS[63];
        const float dec = __expf(BL - Bprev + mprev - mL);
#pragma unroll
        for (int i = 0; i < 4; ++i) {
            const int piece = tid + 512 * i, row = piece >> 6, c16 = piece & 63;
            const float wi = LS[96 + row], wl = __expf(BL - LS[row] + LS[64 + row] - mL);
            float x[8]; unpack8(rq[i], x);
            v2u q0, q1; q0.x = pkc(x[0] * wi, x[1] * wi); q0.y = pkc(x[2] * wi, x[3] * wi); q1.x = pkc(x[4] * wi, x[5] * wi); q1.y = pkc(x[6] * wi, x[7] * wi);
            *(LAS v2u*)(lds + L_Q + row * QP + c16 * 16) = q0; *(LAS v2u*)(lds + L_Q + row * QP + c16 * 16 + 8) = q1;
            unpack8(rk[i], x);
            v4u kk; kk.x = pkc(x[0] * wl, x[1] * wl); kk.y = pkc(x[2] * wl, x[3] * wl); kk.z = pkc(x[4] * wl, x[5] * wl); kk.w = pkc(x[6] * wl, x[7] * wl);
            *(LAS v4u*)(lds + L_K + row * KP + c16 * 16) = kk;
        }
        if (tid < 256) { const int row = tid >> 3, c16 = tid & 7; *(LAS v4u*)(lds + L_V + row * VP + c16 * 16) = rv; }
        if (tid < 128) { const int row = tid >> 2, c16 = tid & 3; *(LAS v4u*)(lds + L_P + row * PPI + c16 * 16) = rp; }
        __syncthreads();
        if (step + 1 < nsteps) MR_LOAD(c0 + 32);
        {
            const int t = tid >> 4, dp = tid & 15; float dot = 0.f;
#pragma unroll
            for (int j = 0; j < 4; ++j) {
                const v2u qa = *(const LAS v2u*)(lds + L_Q + t * QP + (dp * 32 + j * 8) * 2), qb = *(const LAS v2u*)(lds + L_Q + t * QP + (dp * 32 + j * 8) * 2 + 8);
                const f32x4 n0 = *(const LAS f32x4*)(LN + dp * 32 + j * 8), n1 = *(const LAS f32x4*)(LN + dp * 32 + j * 8 + 4);
                dot += bflo(qa.x) * n0.x + bfhi(qa.x) * n0.y + bflo(qa.y) * n0.z + bfhi(qa.y) * n0.w + bflo(qb.x) * n1.x + bfhi(qb.x) * n1.y + bflo(qb.y) * n1.z + bfhi(qb.y) * n1.w;
            }
#pragma unroll
            for (int o = 1; o < 16; o <<= 1) dot += __shfl_xor(dot, o);
            if (dp == 0) LS[192 + t] = __builtin_amdgcn_rcpf(fmaxf(fabsf(dot + LS[160 + t]), LS[128 + t]));
        }
        f32x16 acc;
#pragma unroll
        for (int i = 0; i < 16; ++i) acc[i] = 0.f;
        const bf16x8 vb0 = tr_frag(lds + L_V, VP, 0, el0, lane), vb1 = tr_frag(lds + L_V, VP, 16, el0, lane);
#pragma unroll
        for (int i = 0; i < 4; ++i) {
#pragma unroll
            for (int s = 0; s < 2; ++s) {
                const bf16x8 xs = pack_step(Ct[i], s);
                LAS unsigned char* qa = lds + L_Q + r * QP + (dt0 + 32 * i + 16 * s + 4 * hh) * 2;
                const s16x4 lo = *(const LAS s16x4*)qa, hi = *(const LAS s16x4*)(qa + 16);
                const bf16x8 pa = __builtin_shufflevector(lo, hi, 0, 1, 2, 3, 4, 5, 6, 7);
                acc = MFMA32(pa, xs, acc);
            }
            Ct[i] = Ct[i] * dec;
            const bf16x8 ka0 = tr_frag(lds + L_K, KP, 0, dt0 + 32 * i, lane), ka1 = tr_frag(lds + L_K, KP, 16, dt0 + 32 * i, lane);
            Ct[i] = MFMA32(ka0, vb0, Ct[i]);
            Ct[i] = MFMA32(ka1, vb1, Ct[i]);
        }
        if (wd == 0) {
            const bf16x8 p0 = *(const LAS bf16x8*)(lds + L_P + r * PPI + (8 * hh) * 2), p1 = *(const LAS bf16x8*)(lds + L_P + r * PPI + (16 + 8 * hh) * 2);
            acc = MFMA32(p0, vb0, acc); acc = MFMA32(p1, vb1, acc);
        } else {
            LAS float* red = (LAS float*)(lds + L_RED) + ((wd - 1) * 2 + we) * 1024;
#pragma unroll
            for (int g = 0; g < 16; ++g) red[g * 64 + lane] = acc[g];
        }
        __syncthreads();
        if (wd == 0) {
#pragma unroll
            for (int k = 0; k < 3; ++k) { const LAS float* red = (const LAS float*)(lds + L_RED) + (k * 2 + we) * 1024;
#pragma unroll
                for (int g = 0; g < 16; ++g) acc[g] += red[g * 64 + lane]; }
#pragma unroll
            for (int g = 0; g < 16; ++g) { const int t = crow(g, hh); const float hv = acc[g] * LS[192 + t];
                *(LAS bf16*)(lds + L_H + t * HP + (el0 + r) * 2) = (bf16)(pkc(hv, 0.f) & 0xffffu); }
        }
        { float s = 0.f;
#pragma unroll 8
          for (int j = 0; j < 32; ++j) s += bf2f(*(const LAS bf16*)(lds + L_K + j * KP + tid * 2));
          LN[tid] = dec * LN[tid] + s; }
        __syncthreads();
        if (tid < 256) { const int row = tid >> 3, c16 = tid & 7;
            *(GAS v4u*)(HM + (size_t)(tok0 + c0 + row) * MI + colq + es * 64 + c16 * 8) = *(const LAS v4u*)(lds + L_H + row * HP + c16 * 16); }
        Bprev = BL; mprev = mL;
        __syncthreads();
    }
#undef MR_LOAD
    { float* co = a.out + (smp ? O_CS : O_CP) + ((size_t)bh * MHD + es * 64 + el0 + r) * MHD + dt0 + 4 * hh;
#pragma unroll
      for (int i = 0; i < 4; ++i)
#pragma unroll
          for (int g = 0; g < 4; ++g) *(GAS f32x4*)(co + 32 * i + 8 * g) = (f32x4){Ct[i][4 * g], Ct[i][4 * g + 1], Ct[i][4 * g + 2], Ct[i][4 * g + 3]}; }
    if (es == 0) { a.out[(smp ? O_NS : O_NP) + (size_t)bh * MHD + tid] = LN[tid]; if (tid == 0) a.out[(smp ? O_MS : O_MP) + bh] = mprev; }
}

__device__ __forceinline__ void rec_mlstm_naive(Frame& F, const Args& a, int unit) {
    const int seq = unit >> 6, h = (unit >> 4) & 3, es = unit & 15;
    const bool smp = seq >= BP; const int b = smp ? seq - BP : seq;
    const int T = smp ? TS : TP, tok0 = smp ? NTOK_P + b * TS : b * TP;
    const int dp = F.tid & 15, el = F.tid >> 4, e = es * 32 + el;
    const bf16* Q = (const bf16*)(a.ws + WS_Q); const bf16* K = (const bf16*)(a.ws + WS_K); const bf16* V = (const bf16*)(a.ws + WS_V);
    const float* GATES = (const float*)(a.ws + WS_GATES);
    bf16* HM = (bf16*)a.out;
    float Cs[32], ns[32]; float m;
    if (smp) {
        const float* c0 = a.in[I_SC] + ((size_t)(b * MH + h) * MHD + e) * MHD; const float* n0 = a.in[I_SN] + (size_t)(b * MH + h) * MHD;
#pragma unroll
        for (int j = 0; j < 32; ++j) { Cs[j] = c0[dp + 16 * j]; ns[j] = n0[dp + 16 * j]; }
        m = a.in[I_SM][b * MH + h];
    } else {
#pragma unroll
        for (int j = 0; j < 32; ++j) { Cs[j] = 0.f; ns[j] = 0.f; }
        m = 0.f;
    }
    LAS float* qs = (LAS float*)(F.lds + RING_OFF);
    LAS float* ks = qs + 16 * 512;
    LAS float* vs = ks + 16 * 512;
    LAS float* gs = vs + 16 * 32;
    for (int t0 = 0; t0 < T; t0 += 16) {
        __syncthreads();
        for (int i = F.tid; i < 16 * 512; i += NTHREADS) { const int tt = i >> 9, d = i & 511; const size_t off = (size_t)(tok0 + t0 + tt) * MI + h * MHD + d; qs[i] = bf2f(Q[off]); ks[i] = bf2f(K[off]); }
        { const int tt = F.tid >> 5, ee = F.tid & 31; vs[F.tid] = bf2f(V[(size_t)(tok0 + t0 + tt) * MI + h * MHD + es * 32 + ee]); }
        if (F.tid < 32) { const int tt = F.tid >> 1; gs[F.tid] = GATES[(size_t)(tok0 + t0 + tt) * 8 + (F.tid & 1) * 4 + h]; }
        __syncthreads();
        for (int tt = 0; tt < 16; ++tt) {
            const float ig = gs[tt * 2], lf = gs[tt * 2 + 1];
            const float mn = fmaxf(lf + m, ig), fp = __expf(lf + m - mn), ip = __expf(ig - mn); m = mn;
            const float vv = ip * vs[tt * 32 + el];
            float dot = 0.f, nd = 0.f;
#pragma unroll
            for (int j = 0; j < 32; ++j) { const float kk = ks[tt * 512 + dp + 16 * j], qq = qs[tt * 512 + dp + 16 * j];
                Cs[j] = fp * Cs[j] + vv * kk; ns[j] = fp * ns[j] + ip * kk; dot += Cs[j] * qq; nd += ns[j] * qq; }
#pragma unroll
            for (int o = 1; o < 16; o <<= 1) { dot += __shfl_xor(dot, o); nd += __shfl_xor(nd, o); }
            const float hv = dot / fmaxf(fabsf(nd), __expf(-m));
            if (dp == 0) HM[(size_t)(tok0 + t0 + tt) * MI + h * MHD + e] = (bf16)f2bf(hv);
        }
    }
    float* co = a.out + (smp ? O_CS : O_CP) + ((size_t)(b * MH + h) * MHD + e) * MHD;
#pragma unroll
    for (int j = 0; j < 32; ++j) co[dp + 16 * j] = Cs[j];
    if (es == 0 && el == 0) { float* no = a.out + (smp ? O_NS : O_NP) + (size_t)(b * MH + h) * MHD;
#pragma unroll
        for (int j = 0; j < 32; ++j) no[dp + 16 * j] = ns[j];
        if (dp == 0) a.out[(smp ? O_MS : O_MP) + b * MH + h] = m; }
}
__device__ __forceinline__ void rec_hgrn_naive(Frame& F, const Args& a, int unit) {
    const int seq = unit >> 5, hd = (unit >> 2) & 7, es = unit & 3;
    const bool smp = seq >= BP; const int b = smp ? seq - BP : seq;
    const int T = smp ? TS : TP, tok0 = smp ? NTOK_P + b * TS : b * TP;
    const int cp = F.tid & 15, el = F.tid >> 4, e = es * 32 + el;
    const bf16* QH = (const bf16*)(a.ws + WS_QH); const bf16* FH = (const bf16*)(a.ws + WS_FH); const bf16* IH = (const bf16*)(a.ws + WS_IH);
    bf16* HO = (bf16*)(a.ws + WS_HO);
    float S[8];
    if (smp) {
#pragma unroll
        for (int j = 0; j < 8; ++j) S[j] = a.in[I_SH][((size_t)(b * HH + hd) * HE + cp + 16 * j) * HE + e];
    } else {
#pragma unroll
        for (int j = 0; j < 8; ++j) S[j] = 0.f;
    }
    LAS float* qs = (LAS float*)(F.lds + RING_OFF);
    LAS float* fs = qs + 2048; LAS float* ks = fs + 2048; LAS float* vs = ks + 2048;
    for (int t0 = 0; t0 < T; t0 += 16) {
        __syncthreads();
        for (int i = F.tid; i < 2048; i += NTHREADS) { const int tt = i >> 7, c = i & 127, col = hd * HE + c; const size_t off = (size_t)(tok0 + t0 + tt) * DM + col;
            const float l0 = a.in[I_LB][col], l1 = a.in[I_LB][DM + col]; const float lb = 1.0f / (1.0f + __expf(l1 - l0));
            const float sg = sigmoidf_(bf2f(FH[off]));
            qs[i] = siluf_(bf2f(QH[off])); fs[i] = lb + (1.0f - lb) * sg; ks[i] = (1.0f - lb) * (1.0f - sg); }
        { const int tt = F.tid >> 5, ee = F.tid & 31; vs[F.tid] = bf2f(IH[(size_t)(tok0 + t0 + tt) * DM + hd * HE + es * 32 + ee]); }
        __syncthreads();
        for (int tt = 0; tt < 16; ++tt) {
            const float vv = vs[tt * 32 + el]; float o = 0.f;
#pragma unroll
            for (int j = 0; j < 8; ++j) { const int c = cp + 16 * j; S[j] = fs[tt * 128 + c] * S[j] + ks[tt * 128 + c] * vv; o += qs[tt * 128 + c] * S[j]; }
#pragma unroll
            for (int s = 1; s < 16; s <<= 1) o += __shfl_xor(o, s);
            if (cp == 0) HO[(size_t)(tok0 + t0 + tt) * DM + hd * HE + e] = (bf16)f2bf(o);
        }
    }
    float* so = a.out + (smp ? O_SS : O_SP);
#pragma unroll
    for (int j = 0; j < 8; ++j) so[((size_t)(b * HH + hd) * HE + cp + 16 * j) * HE + e] = S[j];
}
__device__ __forceinline__ void p5_rec(Frame& F, const Args& a) {
    const int bx = blockIdx.x;
    if (F.G == 256) {
        if (bx < 128) { const int x = bx & 7, y = bx >> 3; rec_mlstm(F, a, (x * 2 + (y >> 3)) * 8 + (y & 7)); }
        else for (int u = bx; u < 128 + 1024; u += 128) rec_mlstm(F, a, u);
    } else for (int u = bx; u < 128 + 1024; u += F.G) rec_mlstm(F, a, u);
    __syncthreads();
    for (int u = blockIdx.x; u < 36 * 32; u += F.G) rec_hgrn_naive(F, a, u);
}

__device__ __forceinline__ void p6_norm(Frame& F, const Args& a) {
    const int gw = F.vcu * NWAVES + F.wave, NGW = F.G * NWAVES;
    const bf16* HM = (const bf16*)a.out; const bf16* C = (const bf16*)(a.ws + WS_C); const bf16* ZP = (const bf16*)(a.ws + WS_ZP);
    const bf16* HO = (const bf16*)(a.ws + WS_HO); const bf16* GHP = (const bf16*)(a.ws + WS_GHP);
    bf16* HMN = (bf16*)(a.ws + WS_HMN); bf16* OH = (bf16*)(a.ws + WS_OH);
    for (int m = gw; m < NTOK; m += NGW) {
#pragma unroll 1
        for (int h = 0; h < MH; ++h) {
            const int col = h * MHD + F.lane * 8; const size_t off = (size_t)m * MI + col;
            float x[8], c[8], z[8];
            unpack8(*(const GAS v4u*)(HM + off), x); unpack8(*(const GAS v4u*)(C + off), c); unpack8(*(const GAS v4u*)(ZP + off), z);
            float s = 0.f;
#pragma unroll
            for (int e = 0; e < 8; ++e) s += x[e];
            const float mu = wave_sum(s) * (1.f / MHD); float q = 0.f;
#pragma unroll
            for (int e = 0; e < 8; ++e) { x[e] -= mu; q += x[e] * x[e]; }
            const float rstd = 1.0f / sqrtf(wave_sum(q) * (1.f / MHD) + EPS);
            float o[8];
#pragma unroll
            for (int e = 0; e < 8; ++e) o[e] = (x[e] * rstd * a.in[I_MNORMG][col + e] + a.in[I_MSKIP][col + e] * c[e]) * z[e];
            *(GAS v4u*)(HMN + off) = pack8(o);
        }
        {
            const int col = F.lane * 16; const size_t off = (size_t)m * DM + col;
            float x[16], g[16];
            { float t0[8], t1[8]; unpack8(*(const GAS v4u*)(HO + off), t0); unpack8(*(const GAS v4u*)(HO + off + 8), t1);
#pragma unroll
              for (int e = 0; e < 8; ++e) { x[e] = t0[e]; x[8 + e] = t1[e]; } }
            { float t0[8], t1[8]; unpack8(*(const GAS v4u*)(GHP + off), t0); unpack8(*(const GAS v4u*)(GHP + off + 8), t1);
#pragma unroll
              for (int e = 0; e < 8; ++e) { g[e] = t0[e]; g[8 + e] = t1[e]; } }
            float q = 0.f;
#pragma unroll
            for (int e = 0; e < 16; ++e) q += x[e] * x[e];
            q += __shfl_xor(q, 1); q += __shfl_xor(q, 2); q += __shfl_xor(q, 4);
            const float rstd = 1.0f / sqrtf(q * (1.f / HE) + EPS);
            float o0[8], o1[8];
#pragma unroll
            for (int e = 0; e < 8; ++e) { o0[e] = x[e] * rstd * a.in[I_HNORMG][col + e] * g[e]; o1[e] = x[8 + e] * rstd * a.in[I_HNORMG][col + 8 + e] * g[8 + e]; }
            *(GAS v4u*)(OH + off) = pack8(o0); *(GAS v4u*)(OH + off + 8) = pack8(o1);
        }
    }
}

__device__ __forceinline__ void p12_final(Frame& F, const Args& a) {
    const int gw = F.vcu * NWAVES + F.wave, NGW = F.G * NWAVES;
    const float* fg = a.in[I_FINALG];
    for (int m = gw; m < NTOK; m += NGW) {
        GAS f32x4* xr = (GAS f32x4*)(a.out + (size_t)m * DM) + F.lane;
        f32x4 v[4]; float ss = 0.f;
#pragma unroll
        for (int j = 0; j < 4; ++j) { v[j] = xr[64 * j]; ss += (v[j].x * v[j].x + v[j].y * v[j].y) + (v[j].z * v[j].z + v[j].w * v[j].w); }
        const float rstd = 1.0f / sqrtf(wave_sum(ss) * (1.f / DM) + EPS);
#pragma unroll
        for (int j = 0; j < 4; ++j) { const f32x4 gg = *(const GAS f32x4*)(fg + 4 * F.lane + 256 * j); xr[64 * j] = v[j] * rstd * gg; }
    }
}

__device__ __forceinline__ void st8bf(bf16* p, f32x4 v0, f32x4 v1) {
    v4u w; w.x = pg8::cvt_pk_bf16(v0[0], v0[1]); w.y = pg8::cvt_pk_bf16(v0[2], v0[3]); w.z = pg8::cvt_pk_bf16(v1[0], v1[1]); w.w = pg8::cvt_pk_bf16(v1[2], v1[3]);
    *(GAS v4u*)p = w;
}
__device__ __forceinline__ void ld8bf(const bf16* p, f32x4& v0, f32x4& v1) {
    const v4u w = *(const GAS v4u*)p; v0 = (f32x4){bflo(w.x), bfhi(w.x), bflo(w.y), bfhi(w.y)}; v1 = (f32x4){bflo(w.z), bfhi(w.z), bflo(w.w), bfhi(w.w)};
}
__device__ __forceinline__ f32x4 sig4(f32x4 v) { return (f32x4){sigmoidf_(v[0]), sigmoidf_(v[1]), sigmoidf_(v[2]), sigmoidf_(v[3])}; }
struct Fn1a { unsigned char* ws;
    __device__ __forceinline__ void operator()(int row, int pn, int ct, f32x4 v0, f32x4 v1) const {
        bf16* base; int ld, col;
        if (pn < 8) { base = (bf16*)(ws + WS_U); ld = MI; col = pn * 256; } else if (pn < 16) { base = (bf16*)(ws + WS_V); ld = MI; col = (pn - 8) * 256; }
        else if (pn < 20) { base = (bf16*)(ws + WS_QH); ld = DM; col = (pn - 16) * 256; } else if (pn < 24) { base = (bf16*)(ws + WS_FH); ld = DM; col = (pn - 20) * 256; }
        else { base = (bf16*)(ws + WS_IH); ld = DM; col = (pn - 24) * 256; }
        st8bf(base + (size_t)row * ld + col + ct, v0, v1);
    } };
struct Fn3 { unsigned char* ws;
    __device__ __forceinline__ void operator()(int row, int pn, int ct, f32x4 v0, f32x4 v1) const {
        if (pn < 8) st8bf((bf16*)(ws + WS_Q) + (size_t)row * MI + pn * 256 + ct, v0, v1);
        else { const float s = 0.044194173824159216f; st8bf((bf16*)(ws + WS_K) + (size_t)row * MI + (pn - 8) * 256 + ct, v0 * s, v1 * s); }
    } };
struct Fn5 { unsigned char* ws;
    __device__ __forceinline__ void operator()(int row, int pn, int ct, f32x4 v0, f32x4 v1) const {
        bf16* base; int ld, col; bool sil;
        if (pn < 8) { base = (bf16*)(ws + WS_ZP); ld = MI; col = pn * 256; sil = true; } else if (pn < 12) { base = (bf16*)(ws + WS_GHP); ld = DM; col = (pn - 8) * 256; sil = true; }
        else if (pn < 16) { base = (bf16*)(ws + WS_GAP); ld = DM; col = (pn - 12) * 256; sil = false; } else { base = (bf16*)(ws + WS_GBP); ld = DM; col = (pn - 16) * 256; sil = false; }
        f32x4 s0 = sig4(v0), s1 = sig4(v1);
        if (sil) { s0 = s0 * v0; s1 = s1 * v1; }
        st8bf(base + (size_t)row * ld + col + ct, s0, s1);
    } };
struct Fn7 { unsigned char* ws;
    __device__ __forceinline__ void operator()(int row, int pn, int ct, f32x4 v0, f32x4 v1) const {
        const size_t off = (size_t)row * DM + pn * 256 + ct; f32x4 g0, g1; ld8bf((const bf16*)(ws + WS_GAP) + off, g0, g1);
        st8bf((bf16*)(ws + WS_YA) + off, v0 * g0, v1 * g1);
    } };
struct Fn8 { unsigned char* ws;
    __device__ __forceinline__ void operator()(int row, int pn, int ct, f32x4 v0, f32x4 v1) const {
        const size_t off = (size_t)row * DM + pn * 256 + ct; f32x4 g0, g1, y0, y1; ld8bf((const bf16*)(ws + WS_GBP) + off, g0, g1); ld8bf((const bf16*)(ws + WS_YA) + off, y0, y1);
        st8bf((bf16*)(ws + WS_Y) + off, y0 + v0 * g0, y1 + v1 * g1);
    } };
struct Fn9 { unsigned char* ws; const float* xp; const float* xs; float* out;
    __device__ __forceinline__ void operator()(int row, int pn, int ct, f32x4 v0, f32x4 v1) const {
        const int col = pn * 256 + ct; const float* xr = (row < NTOK_P ? xp + (size_t)row * DM : xs + (size_t)(row - NTOK_P) * DM) + col;
        const f32x4 h0 = *(const GAS f32x4*)xr + v0, h1 = *(const GAS f32x4*)(xr + 4) + v1;
        float* o = out + (size_t)row * DM + col; *(GAS f32x4*)o = h0; *(GAS f32x4*)(o + 4) = h1;
        st8bf((bf16*)(ws + WS_H1B) + (size_t)row * DM + col, h0, h1);
    } };
struct Fn10 { unsigned char* ws;
    __device__ __forceinline__ void operator()(int row, int pn, int ct, f32x4 v0, f32x4 v1) const { st8bf((bf16*)(ws + WS_G2) + (size_t)row * DM + pn * 256 + ct, v0, v1); } };
struct Fn11 { unsigned char* ws; float* out;
    __device__ __forceinline__ void operator()(int row, int pn, int ct, f32x4 v0, f32x4 v1) const {
        const size_t off = (size_t)row * DM + pn * 256 + ct; f32x4 g0, g1; ld8bf((const bf16*)(ws + WS_G2) + off, g0, g1);
        float* o = out + off; const f32x4 h0 = *(const GAS f32x4*)o, h1 = *(const GAS f32x4*)(o + 4);
        *(GAS f32x4*)o = h0 + sig4(v0) * g0; *(GAS f32x4*)(o + 4) = h1 + sig4(v1) * g1;
    } };

constexpr int N_PHASES = 14;
#ifndef MK_PER_PHASE
#define MK_PER_PHASE 0
#endif
template <class Fn>
__device__ __forceinline__ void run_gemm(Frame& F, const bf16* A, int lda, const bf16* Bt, int ldb, int K, int N, int amask, int ashift, int astride, const Fn& fn) {
    asm volatile("" : "+s"(K));
    pg8::Gemm g{A, Bt, lda, ldb, K, amask, ashift, astride}; pg8::StaticOrder S; S.init(NTOK, N, F.G, (int)blockIdx.x);
    pg8::EpiF<Fn> E{fn};
    pg8::gemm_phase<pg8::EpiF<Fn>, pg8::StaticOrder, true, true>(F.lds + RING_OFF, g, S, E);
}
__global__ void __launch_bounds__(NTHREADS, 2) mk_fwd(Args args) {
    extern __shared__ __attribute__((aligned(16))) unsigned char lds[];
    Frame F;
    F.lds = (LAS unsigned char*)lds;
    F.tid = threadIdx.x; F.lane = F.tid & 63; F.wave = __builtin_amdgcn_readfirstlane(F.tid >> 6);
    F.G = gridDim.x; { const int bx = blockIdx.x; F.vcu = (F.G % 8 == 0) ? (bx % 8) * (F.G / 8) + bx / 8 : bx; }
    volatile LAS unsigned* MISC = (volatile LAS unsigned*)(F.lds + MISC_OFF);
    for (int u = F.tid; u < (LDS_BYTES - LDSCTL_OFF) / 4; u += NTHREADS) ((LAS unsigned*)(F.lds + LDSCTL_OFF))[u] = 0u;
    __syncthreads();
    unsigned char* ws = args.ws;
    XcdBarrier bar; bar.bar = (unsigned*)(ws + WS_CTL) + CW_BAR; bar.x = 0; bar.st = nullptr;
    if (!MK_PER_PHASE) bar = xcd_barrier_post((unsigned*)(ws + WS_CTL) + CW_BAR, MISC + 8);
    const int lo = args.ph_lo, hi = args.ph_hi;
#ifndef PHMASK
#define PHMASK 0x3fff
#endif
#define IN(k) (((PHMASK >> (k)) & 1) && lo <= (k) && (k) < hi)
#define SEAM(k) do { if (IN(k) && IN((k) + 1)) xcd_barrier(bar); } while (0)
    if (IN(0)) { p0_prep(F, args); } SEAM(0);
    if (IN(1)) { run_gemm(F, (const bf16*)(ws + WS_XN), DM, (const bf16*)(ws + WS_WIN), DM, DM, 7168, 0, 0, 0, Fn1a{ws}); } SEAM(1);
    if (IN(2)) { p2_conv(F, args); p2_scan(F, args); } SEAM(2);
    if (IN(3)) { run_gemm(F, (const bf16*)(ws + WS_C), MI, (const bf16*)(ws + WS_WQK), MHD, MHD, 4096, 7, 1, MHD, Fn3{ws}); } SEAM(3);
    if (IN(4)) { p4_ptiles(F, args); } SEAM(4);
    if (IN(5)) { p5_rec(F, args); } SEAM(5);
    if (IN(6)) { run_gemm(F, (const bf16*)(ws + WS_XN), DM, (const bf16*)(ws + WS_WIN) + (size_t)7168 * DM, DM, DM, 5120, 0, 0, 0, Fn5{ws}); } SEAM(6);
    if (IN(7)) { p6_norm(F, args); } SEAM(7);
    if (IN(8)) { run_gemm(F, (const bf16*)(ws + WS_HMN), MI, (const bf16*)(ws + WS_WBRM), MI, MI, DM, 0, 0, 0, Fn7{ws}); } SEAM(8);
    if (IN(9)) { run_gemm(F, (const bf16*)(ws + WS_OH), DM, (const bf16*)(ws + WS_WBRH), DM, DM, DM, 0, 0, 0, Fn8{ws}); } SEAM(9);
    if (IN(10)) { run_gemm(F, (const bf16*)(ws + WS_Y), DM, (const bf16*)(ws + WS_WOUT), DM, DM, DM, 0, 0, 0, Fn9{ws, args.in[I_XP], args.in[I_XS], args.out}); } SEAM(10);
    if (IN(11)) { run_gemm(F, (const bf16*)(ws + WS_PB), PLE, (const bf16*)(ws + WS_WPLE), PLE, PLE, DM, 0, 0, 0, Fn10{ws}); } SEAM(11);
    if (IN(12)) { run_gemm(F, (const bf16*)(ws + WS_H1B), DM, (const bf16*)(ws + WS_WPG), DM, DM, DM, 0, 0, 0, Fn11{ws, args.out}); } SEAM(12);
    if (IN(13)) { p12_final(F, args); }
#undef IN
#undef SEAM
}

extern "C" void kernel_launch(void* const* d_in, const int* in_sizes, int n_in, void* d_out, int out_size, void* d_ws, size_t ws_size, hipStream_t stream) {
    static int grid = 0;
    if (grid == 0) {
        if (n_in != 27 || out_size != (int)O_END || ws_size < WS_END) { fprintf(stderr, "kernel_launch: unexpected shapes (n_in %d out %d ws %zu)\n", n_in, out_size, ws_size); grid = -1; return; }
        int dev = 0, cus = 0, per_cu = 0;
        if (hipGetDevice(&dev) != hipSuccess || hipDeviceGetAttribute(&cus, hipDeviceAttributeMultiprocessorCount, dev) != hipSuccess) { grid = -1; return; }
        if (hipFuncSetAttribute((const void*)mk_fwd, hipFuncAttributeMaxDynamicSharedMemorySize, LDS_BYTES) != hipSuccess) { grid = -1; return; }
        if (hipOccupancyMaxActiveBlocksPerMultiprocessor(&per_cu, (const void*)mk_fwd, NTHREADS, LDS_BYTES) != hipSuccess || per_cu < 1) { fprintf(stderr, "kernel_launch: occupancy query says %d\n", per_cu); grid = -1; (void)hipGetLastError(); return; }
        grid = cus;
    }
    if (grid < 0) return;
    if (hipMemsetAsync((char*)d_ws + WS_CTL, 0, CTL_ZERO_BYTES, stream) != hipSuccess) return;
    Args a{};
    for (int i = 0; i < 27; ++i) a.in[i] = (const float*)d_in[i];
    a.out = (float*)d_out; a.ws = (unsigned char*)d_ws;
#if MK_PER_PHASE
    for (int p = 0; p < N_PHASES; ++p) { a.ph_lo = p; a.ph_hi = p + 1; a.li = p; hipLaunchKernelGGL(mk_fwd, dim3(grid), dim3(NTHREADS), LDS_BYTES, stream, a); }
#else
    a.ph_lo = 0; a.ph_hi = N_PHASES; a.li = 0;
    hipLaunchKernelGGL(mk_fwd, dim3(grid), dim3(NTHREADS), LDS_BYTES, stream, a);
#endif
}
```

```cpp
#include <hip/hip_runtime.h>
#include <cstdio>
#include <cstdint>
#include <cmath>
namespace pg8 {
#define PG8_LAS __attribute__((address_space(3)))
typedef unsigned short bf16_t;
typedef short bf16x8 __attribute__((ext_vector_type(8)));
typedef float f32x4 __attribute__((ext_vector_type(4)));
typedef unsigned u32x4 __attribute__((ext_vector_type(4)));
constexpr int BM = 256, BK = 64, HALF = 128, HTB = HALF * BK * 2  , STAGE_BYTES = 8 * HTB, NXCD = 8, WGM = 8;

__host__ __device__ __forceinline__ int lds_byte(int r, int c) { const int st = (r >> 4) * 2 + (c >> 5), rr = r & 15, cc = c & 31, ob = rr * 64 + cc * 2; return st * 1024 + (ob ^ (((ob >> 9) & 1) << 5)); }
__host__ __device__ __forceinline__ void stage_rc(int b, int& R, int& C) { const int st = b / 1024, sb = b % 1024, swz = sb ^ (((sb >> 9) & 1) << 5); R = (st >> 1) * 16 + swz / 64; C = (st & 1) * 32 + (swz % 64) / 2; }
__host__ __device__ __forceinline__ int perm32(int rho) { const int n = rho >> 4, i = rho & 15; return 8 * (i >> 2) + 4 * n + (i & 3); }

struct Unit { int pm, pn; };
struct Gemm { const bf16_t* A; const bf16_t* Bt; int lda, ldb, K, amask, ashift, astride;
    __device__ __forceinline__ const char* abase(const Unit& u) const { return (const char*)(A + (size_t)u.pm * BM * lda + (size_t)(((u.pn & amask) >> ashift) * astride)); }
    __device__ __forceinline__ const char* bbase(const Unit& u) const { return (const char*)(Bt + (size_t)u.pn * BM * ldb); } };

struct StaticOrder {
    int nM, nN, nwg, G, c;
    __host__ __device__ void init(int M, int N, int G_, int c_) { nM = M / BM; nN = N / BM; nwg = nM * nN; G = G_; c = c_; }
    __host__ __device__ bool next(int i, Unit& u) const {
        const long L = (long)i * G + c; if (L >= nwg) return false;
        int wgid = (int)L; { const int q = nwg / NXCD, r = nwg % NXCD, xcd = wgid % NXCD, off = wgid / NXCD; wgid = (xcd < r ? xcd * (q + 1) : r * (q + 1) + (xcd - r) * q) + off; }
        const int nig = WGM * nN, gid = wgid / nig, fm = gid * WGM, gsz = (nM - fm) < WGM ? (nM - fm) : WGM;
        u.pm = fm + ((wgid % nig) % gsz); u.pn = (wgid % nig) / gsz; return true;
    }
    __device__ __forceinline__ void a_ready(const Unit&) const {}
    __device__ __forceinline__ void done(const Unit&) const {}
};

__device__ __forceinline__ unsigned cvt_pk_bf16(float lo, float hi) { unsigned r; asm volatile("v_cvt_pk_bf16_f32 %0, %1, %2" : "=v"(r) : "v"(lo), "v"(hi)); return r; }
template <class Epi, class Sched, bool ALIGN_EPI = false, bool SP2 = false>
__device__ __forceinline__ void gemm_phase(PG8_LAS unsigned char* lds, const Gemm g, const Sched& S, const Epi& E) {
    const int lda = g.lda, ldb = g.ldb;
    const int tid = threadIdx.x, wid = __builtin_amdgcn_readfirstlane(tid >> 6), lane = tid & 63, wr = wid >> 2, wc = wid & 3, fr = lane & 15, fq = lane >> 4;
    const int K = g.K, nt = K / BK;
    unsigned voffA[2], voffB[2];
#pragma unroll
    for (int i = 0; i < 2; ++i) { int R, C; stage_rc(tid * 16 + i * 8192, R, C); const int Rb = Epi::PERM ? ((R & ~31) + perm32(R & 31)) : R;
        voffA[i] = (unsigned)(R * lda + C) * 2u; voffB[i] = (unsigned)(Rb * ldb + C) * 2u; }
    const size_t kstep = (size_t)(BK * 2);
    const size_t hstepA = (size_t)HALF * lda * 2, hstepB = (size_t)HALF * ldb * 2;
    const unsigned ldsw = (unsigned)wid * 1024u;
    const int aoff = lds_byte(wr * 64 + fr, fq * 8), boff = lds_byte(wc * 32 + fr, fq * 8);
#define PG8_SA(b, h) (((b) * 2 + (h)) * HTB)
#define PG8_SB(b, h) ((4 + (b) * 2 + (h)) * HTB)
#define PG8_STAGE(bufoff, gbase, voff) do { _Pragma("unroll") for (int _i = 0; _i < 2; ++_i) \
        __builtin_amdgcn_global_load_lds((const unsigned*)((const char*)(gbase) + (voff)[_i]), (PG8_LAS unsigned*)(lds + (bufoff) + ldsw + _i * 8192), 16, 0, 0); } while (0)
#define PG8_LDA(dst, b, h) do { _Pragma("unroll") for (int m = 0; m < 4; ++m) _Pragma("unroll") for (int k = 0; k < 2; ++k) dst[m][k] = *(const PG8_LAS bf16x8*)(lds + PG8_SA(b, h) + aoff + m * 2048 + k * 1024); } while (0)
#define PG8_LDB(dst, b, h) do { _Pragma("unroll") for (int n = 0; n < 2; ++n) _Pragma("unroll") for (int k = 0; k < 2; ++k) dst[n][k] = *(const PG8_LAS bf16x8*)(lds + PG8_SB(b, h) + boff + n * 2048 + k * 1024); } while (0)
#define PG8_MMA(ai, bj, At, Bt) do { __builtin_amdgcn_s_setprio(1); _Pragma("unroll") for (int m = 0; m < 4; ++m) _Pragma("unroll") for (int n = 0; n < 2; ++n) _Pragma("unroll") for (int k = 0; k < 2; ++k) \
        acc[ai][bj][m][n] = __builtin_amdgcn_mfma_f32_16x16x32_bf16(Bt[n][k], At[m][k], acc[ai][bj][m][n], 0, 0, 0); __builtin_amdgcn_s_setprio(0); } while (0)
#define PG8_WAIT_V(n) asm volatile("s_waitcnt vmcnt(" #n ")" ::: "memory")
#define PG8_WAIT_L(n) asm volatile("s_waitcnt lgkmcnt(" #n ")" ::: "memory")
#define PG8_BAR __builtin_amdgcn_s_barrier()
#define PG8_SCHED __builtin_amdgcn_sched_barrier(0)
    Unit cur, nxt; int ui = 0;
    if (!S.next(0, cur)) return;
    f32x4 acc[2][2][4][2];
#pragma unroll
    for (int a = 0; a < 2; ++a)
#pragma unroll
        for (int b = 0; b < 2; ++b)
#pragma unroll
            for (int m = 0; m < 4; ++m)
#pragma unroll
                for (int n = 0; n < 2; ++n) acc[a][b][m][n] = (f32x4){0.f, 0.f, 0.f, 0.f};
    bf16x8 At[4][2], B0[2][2], B1[2][2];
    const char* cA = g.abase(cur); const char* cB = g.bbase(cur);
    S.a_ready(cur);
    if constexpr (SP2) {
        PG8_STAGE(PG8_SB(0, 0), cB, voffB); PG8_STAGE(PG8_SB(0, 1), cB + hstepB, voffB); PG8_STAGE(PG8_SA(0, 0), cA, voffA); PG8_STAGE(PG8_SA(0, 1), cA + hstepA, voffA);
        if (wr == 1) PG8_BAR;
        PG8_WAIT_V(2); PG8_BAR;
        PG8_STAGE(PG8_SB(1, 0), cB + kstep, voffB); PG8_STAGE(PG8_SA(1, 0), cA + kstep, voffA); PG8_STAGE(PG8_SB(1, 1), cB + hstepB + kstep, voffB);
        PG8_WAIT_V(6); PG8_BAR;
    } else {
        PG8_STAGE(PG8_SB(0, 0), cB, voffB); PG8_STAGE(PG8_SA(0, 0), cA, voffA); PG8_STAGE(PG8_SB(0, 1), cB + hstepB, voffB); PG8_STAGE(PG8_SA(0, 1), cA + hstepA, voffA);
        if (wr == 1) PG8_BAR;
        PG8_WAIT_V(4); PG8_BAR;
        PG8_STAGE(PG8_SB(1, 0), cB + kstep, voffB); PG8_STAGE(PG8_SA(1, 0), cA + kstep, voffA); PG8_STAGE(PG8_SB(1, 1), cB + hstepB + kstep, voffB);
        PG8_WAIT_V(6); PG8_BAR;
    }
    for (;;) {
        const bool has_next = S.next(ui + 1, nxt);
        const char* nA = has_next ? g.abase(nxt) : cA; const char* nB = has_next ? g.bbase(nxt) : cB;
        for (int t = 0; t < nt; t += 2) {
            const bool last = (t == nt - 2);
            const char* a1 = cA + (size_t)(t + 1) * kstep;
            const char* a2 = last ? nA : cA + (size_t)(t + 2) * kstep; const char* b2 = last ? nB : cB + (size_t)(t + 2) * kstep;
            const char* a3 = a2 + kstep; const char* b3 = b2 + kstep;
            if (last && has_next) S.a_ready(nxt);
            if constexpr (SP2) {
            PG8_LDB(B0, 0, 0); PG8_LDB(B1, 0, 1); PG8_SCHED; PG8_LDA(At, 0, 0); PG8_STAGE(PG8_SA(1, 1), a1 + hstepA, voffA);
            PG8_WAIT_V(8); PG8_WAIT_L(0); PG8_BAR; PG8_MMA(0, 0, At, B0); PG8_MMA(0, 1, At, B1); PG8_BAR; PG8_SCHED;
            PG8_LDA(At, 0, 1); PG8_STAGE(PG8_SB(0, 0), b2, voffB); PG8_STAGE(PG8_SB(0, 1), b2 + hstepB, voffB); PG8_STAGE(PG8_SA(0, 0), a2, voffA);
            PG8_WAIT_V(8); PG8_WAIT_L(0); PG8_BAR; PG8_MMA(1, 0, At, B0); PG8_MMA(1, 1, At, B1); PG8_BAR; PG8_SCHED;
            PG8_LDB(B0, 1, 0); PG8_LDB(B1, 1, 1); PG8_SCHED; PG8_LDA(At, 1, 0); PG8_STAGE(PG8_SA(0, 1), a2 + hstepA, voffA);
            PG8_WAIT_V(8); PG8_WAIT_L(0); PG8_BAR; PG8_MMA(0, 0, At, B0); PG8_MMA(0, 1, At, B1); PG8_BAR; PG8_SCHED;
            PG8_LDA(At, 1, 1); PG8_STAGE(PG8_SB(1, 0), b3, voffB); PG8_STAGE(PG8_SB(1, 1), b3 + hstepB, voffB); PG8_STAGE(PG8_SA(1, 0), a3, voffA);
            PG8_WAIT_V(8); PG8_WAIT_L(0); PG8_BAR; PG8_MMA(1, 0, At, B0); PG8_MMA(1, 1, At, B1); PG8_BAR; PG8_SCHED;
            } else {
            PG8_LDB(B0, 0, 0); PG8_SCHED; PG8_LDA(At, 0, 0); PG8_STAGE(PG8_SA(1, 1), a1 + hstepA, voffA);
            PG8_WAIT_L(8); PG8_BAR; PG8_WAIT_L(0); PG8_MMA(0, 0, At, B0); PG8_BAR; PG8_SCHED;
            PG8_LDB(B1, 0, 1); PG8_STAGE(PG8_SB(0, 0), b2, voffB);
            PG8_BAR; PG8_WAIT_L(0); PG8_MMA(0, 1, At, B1); PG8_BAR;
            PG8_LDA(At, 0, 1); PG8_STAGE(PG8_SA(0, 0), a2, voffA);
            PG8_BAR; PG8_WAIT_L(0); PG8_MMA(1, 0, At, B0); PG8_BAR; PG8_SCHED;
            PG8_STAGE(PG8_SB(0, 1), b2 + hstepB, voffB);
            PG8_WAIT_V(6); PG8_BAR; PG8_MMA(1, 1, At, B1); PG8_BAR;
            PG8_LDB(B0, 1, 0); PG8_SCHED; PG8_LDA(At, 1, 0); PG8_STAGE(PG8_SA(0, 1), a2 + hstepA, voffA);
            PG8_WAIT_L(8); PG8_BAR; PG8_WAIT_L(0); PG8_MMA(0, 0, At, B0); PG8_BAR; PG8_SCHED;
            PG8_LDB(B1, 1, 1); PG8_STAGE(PG8_SB(1, 0), b3, voffB);
            PG8_BAR; PG8_WAIT_L(0); PG8_MMA(0, 1, At, B1); PG8_BAR;
            PG8_LDA(At, 1, 1); PG8_STAGE(PG8_SA(1, 0), a3, voffA);
            PG8_BAR; PG8_WAIT_L(0); PG8_MMA(1, 0, At, B0); PG8_BAR; PG8_SCHED;
            PG8_STAGE(PG8_SB(1, 1), b3 + hstepB, voffB);
            PG8_WAIT_V(6); PG8_BAR; PG8_MMA(1, 1, At, B1); PG8_BAR;
            }
        }
        if constexpr (ALIGN_EPI) { if (wr == 0) PG8_BAR; }
        if constexpr (!Epi::AFTER_DRAIN) { E(acc, cur, wr, wc, fr, fq); S.done(cur); }
        if (!has_next) break;
#pragma unroll
        for (int a = 0; a < 2; ++a)
#pragma unroll
            for (int b = 0; b < 2; ++b)
#pragma unroll
                for (int m = 0; m < 4; ++m)
#pragma unroll
                    for (int n = 0; n < 2; ++n) acc[a][b][m][n] = (f32x4){0.f, 0.f, 0.f, 0.f};
        cur = nxt; cA = nA; cB = nB; ++ui;
        if constexpr (ALIGN_EPI) { if (wr == 1) PG8_BAR; }
    }
    PG8_WAIT_V(0);
    if constexpr (!ALIGN_EPI) { if (wr == 0) PG8_BAR; }
    PG8_BAR;
    if constexpr (Epi::AFTER_DRAIN) { E.fused(acc, cur, wr, wc, fr, fq, lds, wid, lane); S.done(cur); }
#undef PG8_SA
#undef PG8_SB
#undef PG8_STAGE
#undef PG8_LDA
#undef PG8_LDB
#undef PG8_MMA
#undef PG8_WAIT_V
#undef PG8_WAIT_L
#undef PG8_BAR
#undef PG8_SCHED
}

template <class Fn> struct EpiF {
    static constexpr bool PERM = true, AFTER_DRAIN = false;
    Fn f;
    __device__ __forceinline__ void operator()(const f32x4 (&acc)[2][2][4][2], const Unit& u, int wr, int wc, int fr, int fq) const {
        const int row0 = u.pm * BM + wr * 64 + fr, ct0 = wc * 32 + 8 * fq;
#pragma unroll
        for (int ai = 0; ai < 2; ++ai)
#pragma unroll
            for (int m = 0; m < 4; ++m)
#pragma unroll
                for (int bj = 0; bj < 2; ++bj) f(row0 + ai * HALF + m * 16, u.pn, ct0 + bj * HALF, acc[ai][bj][m][0], acc[ai][bj][m][1]);
    }
};
}

constexpr int NWAVES = 8, NTHREADS = 512;
constexpr int DM = 1024, MI = 2048, NSRC = 12296, PLE = 256;
constexpr int TP = 4096, TS = 32, BP = 4, BS = 32;
constexpr int NTOK_P = BP * TP, NTOK_S = BS * TS, NTOK = NTOK_P + NTOK_S;
constexpr int MH = 4, MHD = 512, HH = 8, HE = 128;
constexpr float EPS = 1e-6f;
constexpr size_t O_Y = 0, O_CONVP = 17825792, O_CP = 17850368, O_NP = 22044672, O_MP = 22052864, O_SP = 22052880,
                 O_CONVS = 22577168, O_CS = 22773776, O_NS = 56328208, O_MS = 56393744, O_SS = 56393872, O_END = 60588176;
constexpr size_t MiB = 1u << 20;
constexpr size_t WS_CTL = 0, CTL_ZERO_BYTES = 1 * MiB;
constexpr size_t WS_GATES = 1 * MiB, WS_PB = 2 * MiB;
constexpr size_t WS_WIN = 12 * MiB, WS_WQK = 36 * MiB, WS_WBRM = 40 * MiB, WS_WBRH = 44 * MiB, WS_WOUT = 46 * MiB, WS_WPG = 48 * MiB, WS_WPLE = 50 * MiB;
constexpr size_t WS_XN = 52 * MiB, WS_U = 86 * MiB, WS_V = 154 * MiB, WS_QH = 222 * MiB, WS_FH = 256 * MiB, WS_IH = 290 * MiB, WS_C = 324 * MiB, WS_K = 392 * MiB, WS_HO = 460 * MiB;
constexpr size_t WS_END = 510 * MiB;
constexpr size_t WS_Q = WS_U, WS_ZP = WS_V, WS_GHP = WS_QH, WS_GAP = WS_FH, WS_GBP = WS_IH, WS_HMN = WS_U, WS_OH = WS_K, WS_YA = WS_K + 34 * MiB, WS_Y = WS_C, WS_H1B = WS_C + 34 * MiB, WS_G2 = WS_HO;
constexpr int CW_BAR = 4096;
constexpr int RING_OFF = 0, RING_BYTES = 131072, LDSCTL_OFF = RING_BYTES, MISC_OFF = LDSCTL_OFF + 320, LDS_BYTES = 147456;

#define GAS __attribute__((address_space(1)))
#define LAS __attribute__((address_space(3)))
typedef unsigned short bf16;
typedef unsigned v4u __attribute__((ext_vector_type(4)));
typedef unsigned v2u __attribute__((ext_vector_type(2)));
typedef float f32x4 __attribute__((ext_vector_type(4)));
typedef GAS unsigned gu32;
#define RLX_AGENT __ATOMIC_RELAXED, __HIP_MEMORY_SCOPE_AGENT
#define LDS_WAIT() asm volatile("s_waitcnt lgkmcnt(0)" ::: "memory")
#define VM_WAIT() asm volatile("s_waitcnt vmcnt(0)" ::: "memory")
__device__ __forceinline__ unsigned f2bf(float f) { unsigned u = __builtin_bit_cast(unsigned, f); return (u + 0x7fffu + ((u >> 16) & 1u)) >> 16; }
__device__ __forceinline__ unsigned pk2(float lo, float hi) { return f2bf(lo) | (f2bf(hi) << 16); }
__device__ __forceinline__ float bflo(unsigned w) { return __builtin_bit_cast(float, w << 16); }
__device__ __forceinline__ float bfhi(unsigned w) { return __builtin_bit_cast(float, w & 0xffff0000u); }
__device__ __forceinline__ float bf2f(bf16 h) { return __builtin_bit_cast(float, (unsigned)h << 16); }
__device__ __forceinline__ void unpack8(v4u w, float (&o)[8]) { o[0] = bflo(w.x); o[1] = bfhi(w.x); o[2] = bflo(w.y); o[3] = bfhi(w.y); o[4] = bflo(w.z); o[5] = bfhi(w.z); o[6] = bflo(w.w); o[7] = bfhi(w.w); }
__device__ __forceinline__ v4u pack8(const float (&o)[8]) { v4u w; w.x = pk2(o[0], o[1]); w.y = pk2(o[2], o[3]); w.z = pk2(o[4], o[5]); w.w = pk2(o[6], o[7]); return w; }
__device__ __forceinline__ float sigmoidf_(float x) { return __builtin_amdgcn_rcpf(1.0f + __expf(-x)); }
__device__ __forceinline__ float siluf_(float x) { return x * sigmoidf_(x); }
__device__ __forceinline__ float logsigmoidf_(float x) { return fminf(x, 0.f) - log1pf(__expf(-fabsf(x))); }

#define XB_TMO      128
#define XB_XCNT(j)  (256  + 64 * (j))
#define XB_XSUB(j)  (1280 + 64 * (j))
#define XB_XGEN(j)  (2304 + 64 * (j))
#define XB_TOP      3328
#define XB_TOPGEN   3392
#define XCD_BAR_WORDS 3456
#define XB_SPIN_CAP (1u << 18)
__device__ __forceinline__ unsigned xb_ld(unsigned* p)              { return __hip_atomic_load(p, __ATOMIC_RELAXED, __HIP_MEMORY_SCOPE_AGENT); }
__device__ __forceinline__ unsigned xb_add(unsigned* p, unsigned v) { return __hip_atomic_fetch_add(p, v, __ATOMIC_RELAXED, __HIP_MEMORY_SCOPE_AGENT); }
__device__ __forceinline__ unsigned xb_xcc_id() { return (unsigned)__builtin_amdgcn_s_getreg((3 << 11) | 20) & 0xFu; }
#define XB_SPIN(cond, bar) do { unsigned _sp = 0; while (cond) { __builtin_amdgcn_s_sleep(1); \
    if ((++_sp & 255u) == 0u) { if (xb_ld(&(bar)[XB_TMO])) break; if (_sp > XB_SPIN_CAP) { atomicAdd(&(bar)[XB_TMO], 1u); break; } } } } while (0)
struct XcdBarrier { unsigned* bar; unsigned x; volatile LAS unsigned* st; };
__device__ __forceinline__ XcdBarrier xcd_barrier_post(unsigned* bar, volatile LAS unsigned* st) {
    XcdBarrier b; b.bar = bar; b.x = xb_xcc_id(); b.st = st;
    if (threadIdx.x == 0) (void)xb_add(&bar[XB_XCNT(b.x)], 1u);
    return b;
}
__device__ __forceinline__ void xcd_barrier_complete(unsigned* bar, unsigned x, unsigned& nloc, unsigned& nx) {
    const unsigned G = gridDim.x * gridDim.y * gridDim.z;
    unsigned sum, cnt, mine, sp = 0u;
    for (;;) {
        sum = 0u; cnt = 0u; mine = 0u;
#pragma unroll
        for (unsigned j = 0; j < 16; ++j) { const unsigned c = xb_ld(&bar[XB_XCNT(j)]); sum += c; cnt += (c > 0u) ? 1u : 0u; mine = (j == x) ? c : mine; }
        if (sum == G) break;
        __builtin_amdgcn_s_sleep(1);
        if ((++sp & 255u) == 0u) { if (xb_ld(&bar[XB_TMO])) break; if (sp > XB_SPIN_CAP) { atomicAdd(&bar[XB_TMO], 1u); break; } }
    }
    nloc = mine > 0u ? mine : 1u; nx = cnt > 0u ? cnt : 1u;
}
__device__ __forceinline__ void xcd_barrier(const XcdBarrier& b) {
    asm volatile("s_waitcnt vmcnt(0)" ::: "memory");
    __syncthreads();
    if (threadIdx.x == 0) {
        unsigned* bar = b.bar;
        __builtin_amdgcn_s_waitcnt(0);
        unsigned nloc = b.st[0], nx = b.st[1];
        if (nloc == 0u) { xcd_barrier_complete(bar, b.x, nloc, nx); b.st[0] = nloc; b.st[1] = nx; }
        const unsigned old = xb_add(&bar[XB_XSUB(b.x)], 1u);
        const unsigned gen = old / nloc;
        if (old + 1u == (gen + 1u) * nloc) {
            __builtin_amdgcn_fence(__ATOMIC_RELEASE, "agent");
            asm volatile("s_waitcnt vmcnt(0)" ::: "memory");
            const unsigned og = xb_add(&bar[XB_TOP], 1u);
            const unsigned tg = og / nx;
            if (og + 1u == (tg + 1u) * nx) xb_add(&bar[XB_TOPGEN], 1u);
            else XB_SPIN(xb_ld(&bar[XB_TOPGEN]) == tg, bar);
            __builtin_amdgcn_fence(__ATOMIC_ACQUIRE, "agent");
            xb_add(&bar[XB_XGEN(b.x)], 1u);
            asm volatile("s_waitcnt vmcnt(0)" ::: "memory");
        } else {
            XB_SPIN(xb_ld(&bar[XB_XGEN(b.x)]) == gen, bar);
            __builtin_amdgcn_fence(__ATOMIC_ACQUIRE, "agent");
            asm volatile("s_waitcnt vmcnt(0)" ::: "memory");
        }
    }
    __syncthreads();
}

struct Args { const float* in[27]; float* out; unsigned char* ws; int ph_lo, ph_hi, li, pad; };
enum { I_XP = 0, I_XS, I_SCONV, I_SC, I_SN, I_SM, I_SH, I_PP, I_PS, I_NORMG, I_WIN, I_BIG, I_BFG, I_CONVW, I_CONVB, I_WQM, I_WKM, I_MNORMG, I_MSKIP, I_WBRM, I_LB, I_HNORMG, I_WBRH, I_WOUT, I_WPLE, I_WPG, I_FINALG };
struct Frame { LAS unsigned char* lds; int tid, lane, wave, vcu, G; };

__device__ __forceinline__ float wave_sum(float v) {
#pragma unroll
    for (int o = 1; o < 64; o <<= 1) v += __shfl_xor(v, o);
    return v;
}
__device__ __forceinline__ const float* xrow(const Args& a, int m) { return m < NTOK_P ? a.in[I_XP] + (size_t)m * DM : a.in[I_XS] + (size_t)(m - NTOK_P) * DM; }

__device__ __forceinline__ void p0_transpose_item(const float* W, int pitch, int K, int ncols, bf16* WT, int row_off, LAS float* scr, int item, int lane) {
    const int nblk = ncols / 32, kb = item / nblk, nb = item % nblk, k0 = 64 * kb, n0 = 32 * nb;
#pragma unroll 8
    for (int i = 0; i < 32; ++i) { const int kk = 2 * i + (lane >> 5); scr[kk * 33 + (lane & 31)] = W[(size_t)(k0 + kk) * pitch + n0 + (lane & 31)]; }
    LDS_WAIT(); asm volatile("" ::: "memory");
    const int c = lane & 7;
#pragma unroll
    for (int j = 0; j < 4; ++j) { const int n = (lane >> 3) + 8 * j; const LAS float* s = scr + (8 * c) * 33 + n;
        v4u o; o.x = pk2(s[0 * 33], s[1 * 33]); o.y = pk2(s[2 * 33], s[3 * 33]); o.z = pk2(s[4 * 33], s[5 * 33]); o.w = pk2(s[6 * 33], s[7 * 33]);
        *(GAS v4u*)(WT + (size_t)(row_off + n0 + n) * K + k0 + 8 * c) = o; }
    LDS_WAIT(); asm volatile("" ::: "memory");
}
struct Seg { const float* W; int pitch, K, ncols; bf16* WT; int row_off, items; };
__device__ __forceinline__ Seg seg_info(int s, const Args& a) {
    Seg g; unsigned char* ws = a.ws;
    switch (s) {
    case 0: g = Seg{a.in[I_WIN] + 0,    NSRC, 1024, 4096, (bf16*)(ws + WS_WIN), 0,    0}; break;
    case 1: g = Seg{a.in[I_WIN] + 6152, NSRC, 1024, 3072, (bf16*)(ws + WS_WIN), 4096, 0}; break;
    case 2: g = Seg{a.in[I_WIN] + 4096, NSRC, 1024, 2048, (bf16*)(ws + WS_WIN), 7168, 0}; break;
    case 3: g = Seg{a.in[I_WIN] + 9224, NSRC, 1024, 3072, (bf16*)(ws + WS_WIN), 9216, 0}; break;
    case 4: case 5: case 6: case 7: g = Seg{a.in[I_WQM] + (size_t)(s - 4) * 262144, 512, 512, 512, (bf16*)(ws + WS_WQK), (s - 4) * 512, 0}; break;
    case 8: case 9: case 10: case 11: g = Seg{a.in[I_WKM] + (size_t)(s - 8) * 262144, 512, 512, 512, (bf16*)(ws + WS_WQK), 2048 + (s - 8) * 512, 0}; break;
    case 12: g = Seg{a.in[I_WBRM], 1024, 2048, 1024, (bf16*)(ws + WS_WBRM), 0, 0}; break;
    case 13: g = Seg{a.in[I_WBRH], 1024, 1024, 1024, (bf16*)(ws + WS_WBRH), 0, 0}; break;
    case 14: g = Seg{a.in[I_WOUT], 1024, 1024, 1024, (bf16*)(ws + WS_WOUT), 0, 0}; break;
    case 15: g = Seg{a.in[I_WPG],  1024, 1024, 1024, (bf16*)(ws + WS_WPG),  0, 0}; break;
    default: g = Seg{a.in[I_WPLE], 1024, 256,  1024, (bf16*)(ws + WS_WPLE), 0, 0}; break;
    }
    g.items = (g.K / 64) * (g.ncols / 32);
    return g;
}
__device__ __forceinline__ void p0_prep(Frame& F, const Args& a) {
    LAS float* scr = (LAS float*)(F.lds + RING_OFF + F.wave * 16384);
    const int gw = F.vcu * NWAVES + F.wave, NGW = F.G * NWAVES;
    for (int s = 0; s < 17; ++s) {
        const Seg g = seg_info(s, a);
        for (int it = gw; it < g.items; it += NGW) p0_transpose_item(g.W, g.pitch, g.K, g.ncols, g.WT, g.row_off, scr, it, F.lane);
    }
    __syncthreads();
    LAS float* wg = (LAS float*)(F.lds + RING_OFF);
    for (int i = F.tid; i < 8192; i += NTHREADS) { const int k = i >> 3, q = i & 7; wg[q * 1024 + k] = a.in[I_WIN][(size_t)k * NSRC + 6144 + q]; }
    __syncthreads();
    bf16* XN = (bf16*)(a.ws + WS_XN); float* GATES = (float*)(a.ws + WS_GATES);
    const float* ng = a.in[I_NORMG];
    for (int m = gw; m < NTOK; m += NGW) {
        const GAS f32x4* xr = (const GAS f32x4*)xrow(a, m) + F.lane;
        f32x4 v[4]; float ss = 0.f;
#pragma unroll
        for (int j = 0; j < 4; ++j) { v[j] = xr[64 * j]; ss += (v[j].x * v[j].x + v[j].y * v[j].y) + (v[j].z * v[j].z + v[j].w * v[j].w); }
        const float rstd = 1.0f / sqrtf(wave_sum(ss) * (1.f / DM) + EPS);
        GAS v2u* o8 = (GAS v2u*)(XN + (size_t)m * DM) + F.lane;
        float gacc[8];
#pragma unroll
        for (int q = 0; q < 8; ++q) gacc[q] = 0.f;
#pragma unroll
        for (int j = 0; j < 4; ++j) {
            const f32x4 gg = *(const GAS f32x4*)(ng + 4 * F.lane + 256 * j);
            v[j] = v[j] * rstd * gg;
            v2u w; w.x = pk2(v[j].x, v[j].y); w.y = pk2(v[j].z, v[j].w); o8[64 * j] = w;
#pragma unroll
            for (int q = 0; q < 8; ++q) { const f32x4 ww = *(const LAS f32x4*)(wg + q * 1024 + 4 * F.lane + 256 * j); gacc[q] += (v[j].x * ww.x + v[j].y * ww.y) + (v[j].z * ww.z + v[j].w * ww.w); }
        }
#pragma unroll
        for (int q = 0; q < 8; ++q) gacc[q] = wave_sum(gacc[q]);
        if (F.lane == 0) {
#pragma unroll
            for (int q = 0; q < 4; ++q) { GATES[(size_t)m * 8 + q] = gacc[q] + a.in[I_BIG][q]; GATES[(size_t)m * 8 + 4 + q] = logsigmoidf_(gacc[4 + q] + a.in[I_BFG][q]); }
        }
    }
    bf16* PB = (bf16*)(a.ws + WS_PB);
    for (int i = F.vcu * NTHREADS + F.tid; i < NTOK * 32; i += F.G * NTHREADS) {
        const int m = i >> 5, c8 = (i & 31) * 8;
        const float* src = (m < NTOK_P ? a.in[I_PP] + (size_t)m * PLE : a.in[I_PS] + (size_t)(m - NTOK_P) * PLE) + c8;
        const f32x4 p0 = *(const GAS f32x4*)src, p1 = *(const GAS f32x4*)(src + 4);
        v4u w; w.x = pk2(p0.x, p0.y); w.y = pk2(p0.z, p0.w); w.z = pk2(p1.x, p1.y); w.w = pk2(p1.z, p1.w);
        *(GAS v4u*)(PB + (size_t)m * PLE + c8) = w;
    }
}

__device__ __forceinline__ void p2_conv(Frame& F, const Args& a) {
    const bf16* U = (const bf16*)(a.ws + WS_U); bf16* C = (bf16*)(a.ws + WS_C);
    const float* cw = a.in[I_CONVW]; const float* cb = a.in[I_CONVB]; const float* sconv = a.in[I_SCONV];
    for (int i = F.vcu * NTHREADS + F.tid; i < NTOK * 256; i += F.G * NTHREADS) {
        const int tok = i >> 8, ch = (i & 255) * 8;
        const bool smp = tok >= NTOK_P;
        const int b = smp ? (tok - NTOK_P) >> 5 : tok >> 12, t = smp ? (tok - NTOK_P) & 31 : tok & 4095;
        float acc[8];
        { const f32x4 b0 = *(const GAS f32x4*)(cb + ch), b1 = *(const GAS f32x4*)(cb + ch + 4); acc[0] = b0.x; acc[1] = b0.y; acc[2] = b0.z; acc[3] = b0.w; acc[4] = b1.x; acc[5] = b1.y; acc[6] = b1.z; acc[7] = b1.w; }
        float ucur[8];
#pragma unroll
        for (int j = 0; j < 4; ++j) {
            const int tp = t - 3 + j;
            float val[8];
            if (tp >= 0) { unpack8(*(const GAS v4u*)(U + (size_t)(tok - 3 + j) * MI + ch), val); }
            else if (smp) { const float* s = sconv + (size_t)(b * 3 + (3 + tp)) * MI + ch; const f32x4 s0 = *(const GAS f32x4*)s, s1 = *(const GAS f32x4*)(s + 4);
                val[0] = s0.x; val[1] = s0.y; val[2] = s0.z; val[3] = s0.w; val[4] = s1.x; val[5] = s1.y; val[6] = s1.z; val[7] = s1.w; }
            else {
#pragma unroll
                for (int e = 0; e < 8; ++e) val[e] = 0.f; }
            const f32x4 w0 = *(const GAS f32x4*)(cw + (size_t)j * MI + ch), w1 = *(const GAS f32x4*)(cw + (size_t)j * MI + ch + 4);
            acc[0] += val[0] * w0.x; acc[1] += val[1] * w0.y; acc[2] += val[2] * w0.z; acc[3] += val[3] * w0.w;
            acc[4] += val[4] * w1.x; acc[5] += val[5] * w1.y; acc[6] += val[6] * w1.z; acc[7] += val[7] * w1.w;
            if (j == 3) {
#pragma unroll
                for (int e = 0; e < 8; ++e) ucur[e] = val[e]; }
        }
#pragma unroll
        for (int e = 0; e < 8; ++e) acc[e] = siluf_(acc[e]);
        *(GAS v4u*)(C + (size_t)tok * MI + ch) = pack8(acc);
        const int tl = smp ? TS : TP;
        if (t >= tl - 3) {
            float* dst = a.out + (smp ? O_CONVS : O_CONVP) + (size_t)(b * 3 + (t - (tl - 3))) * MI + ch;
            *(GAS f32x4*)dst = (f32x4){ucur[0], ucur[1], ucur[2], ucur[3]}; *(GAS f32x4*)(dst + 4) = (f32x4){ucur[4], ucur[5], ucur[6], ucur[7]};
        }
    }
}

typedef short s16x4 __attribute__((ext_vector_type(4)));
typedef short bf16x8 __attribute__((ext_vector_type(8)));
typedef float f32x16 __attribute__((ext_vector_type(16)));
typedef float f32x2 __attribute__((ext_vector_type(2)));
typedef __bf16 bf16x2v __attribute__((ext_vector_type(2)));
#define MFMA32(a, b, c) __builtin_amdgcn_mfma_f32_32x32x16_bf16((a), (b), (c), 0, 0, 0)
__device__ __forceinline__ unsigned pkc(float lo, float hi) { f32x2 f = {lo, hi}; bf16x2v h = __builtin_convertvector(f, bf16x2v); return __builtin_bit_cast(unsigned, h); }
__device__ __forceinline__ int crow(int reg, int hh) { return (reg & 3) + 8 * (reg >> 2) + 4 * hh; }
__device__ __forceinline__ bf16x8 pack_step(const f32x16& x, int s) {
    v4u p; p.x = pkc(x[8 * s], x[8 * s + 1]); p.y = pkc(x[8 * s + 2], x[8 * s + 3]); p.z = pkc(x[8 * s + 4], x[8 * s + 5]); p.w = pkc(x[8 * s + 6], x[8 * s + 7]);
    return __builtin_bit_cast(bf16x8, p);
}
__device__ __forceinline__ s16x4 trr(LAS unsigned char* p) { return __builtin_amdgcn_ds_read_tr16_b64_v4i16((LAS s16x4*)p); }
__device__ __forceinline__ bf16x8 tr_frag(LAS unsigned char* img, int pitch, int k0, int c0, int lane) {
    const int hh = lane >> 5, blk = (lane >> 4) & 1, qq = (lane & 15) >> 2, pp = lane & 3;
    LAS unsigned char* p = img + (k0 + 8 * hh + qq) * pitch + (c0 + 16 * blk + 4 * pp) * 2;
    const s16x4 lo = trr(p), hi = trr(p + 4 * pitch);
    return __builtin_shufflevector(lo, hi, 0, 1, 2, 3, 4, 5, 6, 7);
}

constexpr size_t WS_PT = 494 * MiB, WS_SC = 10 * MiB + 512 * 1024, WS_DENI = 11 * MiB + 256 * 1024;

__device__ __forceinline__ void p2_scan(Frame& F, const Args& a) {
    const int gw = F.vcu * NWAVES + F.wave, NGW = F.G * NWAVES, lane = F.lane;
    const float* GATES = (const float*)(a.ws + WS_GATES); float* SC = (float*)(a.ws + WS_SC);
    for (int sh = gw; sh < 36 * MH; sh += NGW) {
        const int seq = sh >> 2, h = sh & 3; const bool smp = seq >= BP; const int b = smp ? seq - BP : seq;
        const int tok0 = smp ? NTOK_P + b * TS : b * TP;
        const float minit = smp ? a.in[I_SM][b * MH + h] : 0.f;
        const float NEG = -3.0e38f;
        if (!smp) {
            const float* G = GATES + (size_t)(tok0 + lane * 64) * 8;
            float s = 0.f;
            for (int j = 0; j < 64; ++j) s += G[j * 8 + 4 + h];
            float incl = s;
#pragma unroll
            for (int o = 1; o < 64; o <<= 1) { const float v = __shfl_up(incl, o); if (lane >= o) incl += v; }
            const float base = incl - s;
            float bg = base, mx = NEG;
            for (int j = 0; j < 64; ++j) { bg += G[j * 8 + 4 + h]; mx = fmaxf(mx, G[j * 8 + h] - bg); }
            float pm = mx;
#pragma unroll
            for (int o = 1; o < 64; o <<= 1) { const float v = __shfl_up(pm, o); if (lane >= o) pm = fmaxf(pm, v); }
            float ex = __shfl_up(pm, 1); if (lane == 0) ex = NEG;
            float run = fmaxf(minit, ex);
            bg = base;
            float* o = SC + (size_t)(tok0 + lane * 64) * 8 + h * 2;
            for (int j = 0; j < 64; ++j) { bg += G[j * 8 + 4 + h]; run = fmaxf(run, G[j * 8 + h] - bg); o[j * 8] = bg; o[j * 8 + 1] = bg + run; }
        } else {
            const int t = lane & 31; const float* G = GATES + (size_t)(tok0 + t) * 8;
            const float lf = G[4 + h], ig = G[h];
            float incl = lf;
#pragma unroll
            for (int o = 1; o < 32; o <<= 1) { const float v = __shfl_up(incl, o); if (t >= o) incl += v; }
            float pm = ig - incl;
#pragma unroll
            for (int o = 1; o < 32; o <<= 1) { const float v = __shfl_up(pm, o); if (t >= o) pm = fmaxf(pm, v); }
            if (lane < 32) { float* o = SC + (size_t)(tok0 + t) * 8 + h * 2; o[0] = incl; o[1] = incl + fmaxf(minit, pm); }
        }
    }
}

__device__ __forceinline__ void p4_ptiles(Frame& F, const Args& a) {
    const int gw = F.vcu * NWAVES + F.wave, NGW = F.G * NWAVES, lane = F.lane, r = lane & 31, hh = lane >> 5;
    const bf16* Q = (const bf16*)(a.ws + WS_Q); const bf16* K = (const bf16*)(a.ws + WS_K);
    const float* GATES = (const float*)(a.ws + WS_GATES); const float* SC = (const float*)(a.ws + WS_SC);
    bf16* PT = (bf16*)(a.ws + WS_PT); float* DENI = (float*)(a.ws + WS_DENI);
    for (int u = gw; u < 2176; u += NGW) {
        int b, h, tok0;
        if (u < 2048) { const int bh = u >> 7, c = u & 127; b = bh >> 2; h = bh & 3; tok0 = b * TP + c * 32; }
        else { const int bh = u - 2048; b = bh >> 2; h = bh & 3; tok0 = NTOK_P + b * TS; }
        const bf16* qp = Q + (size_t)(tok0 + r) * MI + h * MHD + 8 * hh;
        const bf16* kp = K + (size_t)(tok0 + r) * MI + h * MHD + 8 * hh;
        f32x16 acc;
#pragma unroll
        for (int i = 0; i < 16; ++i) acc[i] = 0.f;
#pragma unroll 8
        for (int ks = 0; ks < 32; ++ks) {
            const bf16x8 af = *(const GAS bf16x8*)(qp + 16 * ks), bfr = *(const GAS bf16x8*)(kp + 16 * ks);
            acc = MFMA32(af, bfr, acc);
        }
        const float* sc = SC + (size_t)(tok0 + r) * 8 + h * 2;
        const float Bg = sc[0], m = sc[1], ig = GATES[(size_t)(tok0 + r) * 8 + h];
        const float cs = ig - Bg, rt = Bg - m;
#pragma unroll
        for (int reg = 0; reg < 16; ++reg) {
            const int t = crow(reg, hh);
            const float rtt = __shfl(rt, t);
            const float p = (r <= t) ? acc[reg] * __expf(rtt + cs) : 0.f;
            float sum = p;
#pragma unroll
            for (int o = 1; o < 32; o <<= 1) sum += __shfl_xor(sum, o);
            PT[(size_t)u * 1024 + t * 32 + r] = (bf16)(pkc(p, 0.f) & 0xffffu);
            if (r == 0) DENI[(size_t)(tok0 + t) * 4 + h] = sum;
        }
    }
}

namespace mr {
constexpr int QP = 1032, KP = 1088, VP = 192, PPI = 80, HP = 144;
constexpr int L_Q = 0, L_K = 33024, L_V = 67840, L_P = 73984, L_RED = 76544, L_N = 101120, L_SC = 103168, L_H = 104192, L_END = 108800;
}
__device__ __forceinline__ void rec_mlstm(Frame& F, const Args& a, int unit) {
    using namespace mr;
    const bool smp = unit >= 128; const int uu = smp ? unit - 128 : unit;
    const int bh = uu >> 3, es = uu & 7, b = bh >> 2, h = bh & 3;
    const int T = smp ? TS : TP, tok0 = smp ? NTOK_P + b * TS : b * TP, nsteps = T / 32;
    const int tid = F.tid, lane = F.lane, w = F.wave, we = w & 1, wd = w >> 1, r = lane & 31, hh = lane >> 5;
    const int el0 = we * 32, dt0 = wd * 128;
    LAS unsigned char* lds = F.lds + RING_OFF;
    LAS float* LN = (LAS float*)(lds + L_N); LAS float* LS = (LAS float*)(lds + L_SC);
    const bf16* Q = (const bf16*)(a.ws + WS_Q); const bf16* K = (const bf16*)(a.ws + WS_K); const bf16* V = (const bf16*)(a.ws + WS_V);
    const float* GATES = (const float*)(a.ws + WS_GATES); const float* SC = (const float*)(a.ws + WS_SC);
    const float* DENI = (const float*)(a.ws + WS_DENI);
    const bf16* PT = (const bf16*)(a.ws + WS_PT) + (size_t)(smp ? 2048 + bh : bh * 128) * 1024;
    bf16* HM = (bf16*)a.out;
    __syncthreads();
    f32x16 Ct[4];
    if (smp) {
        const float* c0 = a.in[I_SC] + ((size_t)bh * MHD + es * 64 + el0 + r) * MHD + dt0 + 4 * hh;
#pragma unroll
        for (int i = 0; i < 4; ++i)
#pragma unroll
            for (int g = 0; g < 4; ++g) { const f32x4 v = *(const GAS f32x4*)(c0 + 32 * i + 8 * g); Ct[i][4 * g] = v.x; Ct[i][4 * g + 1] = v.y; Ct[i][4 * g + 2] = v.z; Ct[i][4 * g + 3] = v.w; }
        LN[tid] = a.in[I_SN][(size_t)bh * MHD + tid];
    } else {
#pragma unroll
        for (int i = 0; i < 4; ++i)
#pragma unroll
            for (int g = 0; g < 16; ++g) Ct[i][g] = 0.f;
        LN[tid] = 0.f;
    }
    float Bprev = 0.f, mprev = smp ? a.in[I_SM][bh] : 0.f;
    v4u rq[4], rk[4], rv = {0u, 0u, 0u, 0u}, rp = {0u, 0u, 0u, 0u}; float sBg = 0.f, sm = 0.f, sig = 0.f, sde = 0.f;
    const size_t colq = (size_t)h * MHD;
#define MR_LOAD(c0) do { \
        _Pragma("unroll") for (int i = 0; i < 4; ++i) { const int piece = tid + 512 * i, row = piece >> 6, c16 = piece & 63; const size_t off = (size_t)(tok0 + (c0) + row) * MI + colq + c16 * 8; \
            rq[i] = *(const GAS v4u*)(Q + off); rk[i] = *(const GAS v4u*)(K + off); } \
        if (tid < 256) { const int row = tid >> 3, c16 = tid & 7; rv = *(const GAS v4u*)(V + (size_t)(tok0 + (c0) + row) * MI + colq + es * 64 + c16 * 8); } \
        if (tid < 128) { const int row = tid >> 2, c16 = tid & 3; rp = *(const GAS v4u*)(PT + (size_t)((c0) >> 5) * 1024 + row * 32 + c16 * 8); } \
        if (tid < 32) { const size_t tk = (size_t)(tok0 + (c0) + tid); sBg = SC[tk * 8 + h * 2]; sm = SC[tk * 8 + h * 2 + 1]; sig = GATES[tk * 8 + h]; sde = DENI[tk * 4 + h]; } } while (0)
    MR_LOAD(0);
    for (int step = 0; step < nsteps; ++step) {
        const int c0 = step * 32;
        if (tid < 32) { LS[tid] = sBg; LS[32 + tid] = sm; LS[64 + tid] = sig; LS[96 + tid] = __expf(sBg - Bprev + mprev - sm); LS[128 + tid] = __expf(-sm); LS[160 + tid] = sde; }
        __syncthreads();
        const float BL = LS[31], mL = LS[63];
        const float dec = __expf(BL - Bprev + mprev - mL);
#pragma unroll
        for (int i = 0; i < 4; ++i) {
            const int piece = tid + 512 * i, row = piece >> 6, c16 = piece & 63;
            const float wi = LS[96 + row], wl = __expf(BL - LS[row] + LS[64 + row] - mL);
            float x[8]; unpack8(rq[i], x);
            v2u q0, q1; q0.x = pkc(x[0] * wi, x[1] * wi); q0.y = pkc(x[2] * wi, x[3] * wi); q1.x = pkc(x[4] * wi, x[5] * wi); q1.y = pkc(x[6] * wi, x[7] * wi);
            *(LAS v2u*)(lds + L_Q + row * QP + c16 * 16) = q0; *(LAS v2u*)(lds + L_Q + row * QP + c16 * 16 + 8) = q1;
            unpack8(rk[i], x);
            v4u kk; kk.x = pkc(x[0] * wl, x[1] * wl); kk.y = pkc(x[2] * wl, x[3] * wl); kk.z = pkc(x[4] * wl, x[5] * wl); kk.w = pkc(x[6] * wl, x[7] * wl);
            *(LAS v4u*)(lds + L_K + row * KP + c16 * 16) = kk;
        }
        if (tid < 256) { const int row = tid >> 3, c16 = tid & 7; *(LAS v4u*)(lds + L_V + row * VP + c16 * 16) = rv; }
        if (tid < 128) { const int row = tid >> 2, c16 = tid & 3; *(LAS v4u*)(lds + L_P + row * PPI + c16 * 16) = rp; }
        __syncthreads();
        if (step + 1 < nsteps) MR_LOAD(c0 + 32);
        {
            const int t = tid >> 4, dp = tid & 15; float dot = 0.f;
#pragma unroll
            for (int j = 0; j < 4; ++j) {
                const v2u qa = *(const LAS v2u*)(lds + L_Q + t * QP + (dp * 32 + j * 8) * 2), qb = *(const LAS v2u*)(lds + L_Q + t * QP + (dp * 32 + j * 8) * 2 + 8);
                const f32x4 n0 = *(const LAS f32x4*)(LN + dp * 32 + j * 8), n1 = *(const LAS f32x4*)(LN + dp * 32 + j * 8 + 4);
                dot += bflo(qa.x) * n0.x + bfhi(qa.x) * n0.y + bflo(qa.y) * n0.z + bfhi(qa.y) * n0.w + bflo(qb.x) * n1.x + bfhi(qb.x) * n1.y + bflo(qb.y) * n1.z + bfhi(qb.y) * n1.w;
            }
#pragma unroll
            for (int o = 1; o < 16; o <<= 1) dot += __shfl_xor(dot, o);
            if (dp == 0) LS[192 + t] = __builtin_amdgcn_rcpf(fmaxf(fabsf(dot + LS[160 + t]), LS[128 + t]));
        }
        f32x16 acc;
#pragma unroll
        for (int i = 0; i < 16; ++i) acc[i] = 0.f;
        const bf16x8 vb0 = tr_frag(lds + L_V, VP, 0, el0, lane), vb1 = tr_frag(lds + L_V, VP, 16, el0, lane);
#pragma unroll
        for (int i = 0; i < 4; ++i) {
#pragma unroll
            for (int s = 0; s < 2; ++s) {
                const bf16x8 xs = pack_step(Ct[i], s);
                LAS unsigned char* qa = lds + L_Q + r * QP + (dt0 + 32 * i + 16 * s + 4 * hh) * 2;
                const s16x4 lo = *(const LAS s16x4*)qa, hi = *(const LAS s16x4*)(qa + 16);
                const bf16x8 pa = __builtin_shufflevector(lo, hi, 0, 1, 2, 3, 4, 5, 6, 7);
                acc = MFMA32(pa, xs, acc);
            }
            Ct[i] = Ct[i] * dec;
            const bf16x8 ka0 = tr_frag(lds + L_K, KP, 0, dt0 + 32 * i, lane), ka1 = tr_frag(lds + L_K, KP, 16, dt0 + 32 * i, lane);
            Ct[i] = MFMA32(ka0, vb0, Ct[i]);
            Ct[i] = MFMA32(ka1, vb1, Ct[i]);
        }
        if (wd == 0) {
            const bf16x8 p0 = *(const LAS bf16x8*)(lds + L_P + r * PPI + (8 * hh) * 2), p1 = *(const LAS bf16x8*)(lds + L_P + r * PPI + (16 + 8 * hh) * 2);
            acc = MFMA32(p0, vb0, acc); acc = MFMA32(p1, vb1, acc);
        } else {
            LAS float* red = (LAS float*)(lds + L_RED) + ((wd - 1) * 2 + we) * 1024;
#pragma unroll
            for (int g = 0; g < 16; ++g) red[g * 64 + lane] = acc[g];
        }
        __syncthreads();
        if (wd == 0) {
#pragma unroll
            for (int k = 0; k < 3; ++k) { const LAS float* red = (const LAS float*)(lds + L_RED) + (k * 2 + we) * 1024;
#pragma unroll
                for (int g = 0; g < 16; ++g) acc[g] += red[g * 64 + lane]; }
#pragma unroll
            for (int g = 0; g < 16; ++g) { const int t = crow(g, hh); const float hv = acc[g] * LS[192 + t];
                *(LAS bf16*)(lds + L_H + t * HP + (el0 + r) * 2) = (bf16)(pkc(hv, 0.f) & 0xffffu); }
        }
        { float s = 0.f;
#pragma unroll 8
          for (int j = 0; j < 32; ++j) s += bf2f(*(const LAS bf16*)(lds + L_K + j * KP + tid * 2));
          LN[tid] = dec * LN[tid] + s; }
        __syncthreads();
        if (tid < 256) { const int row = tid >> 3, c16 = tid & 7;
            *(GAS v4u*)(HM + (size_t)(tok0 + c0 + row) * MI + colq + es * 64 + c16 * 8) = *(const LAS v4u*)(lds + L_H + row * HP + c16 * 16); }
        Bprev = BL; mprev = mL;
        __syncthreads();
    }
#undef MR_LOAD
    { float* co = a.out + (smp ? O_CS : O_CP) + ((size_t)bh * MHD + es * 64 + el0 + r) * MHD + dt0 + 4 * hh;
#pragma unroll
      for (int i = 0; i < 4; ++i)
#pragma unroll
          for (int g = 0; g < 4; ++g) *(GAS f32x4*)(co + 32 * i + 8 * g) = (f32x4){Ct[i][4 * g], Ct[i][4 * g + 1], Ct[i][4 * g + 2], Ct[i][4 * g + 3]}; }
    if (es == 0) { a.out[(smp ? O_NS : O_NP) + (size_t)bh * MHD + tid] = LN[tid]; if (tid == 0) a.out[(smp ? O_MS : O_MP) + bh] = mprev; }
}

constexpr size_t WS_HA = 498 * MiB + 512 * 1024, WS_EGL = 507 * MiB;
__device__ __forceinline__ void p2_hprep(Frame& F, const Args& a) {
    bf16* QH = (bf16*)(a.ws + WS_QH); bf16* FH = (bf16*)(a.ws + WS_FH); float* EGL = (float*)(a.ws + WS_EGL);
    for (int i = F.vcu * NTHREADS + F.tid; i < (NTOK / 32) * DM; i += F.G * NTHREADS) {
        const int ch = i >> 10, col = i & 1023;
        const float l0 = a.in[I_LB][col], l1 = a.in[I_LB][DM + col]; const float lb = 1.0f / (1.0f + __expf(l1 - l0));
        float g = 0.f;
        size_t off = (size_t)ch * 32 * DM + col;
#pragma unroll 4
        for (int t = 0; t < 32; ++t, off += DM) {
            const float sg = sigmoidf_(bf2f(FH[off])), ql = bf2f(QH[off]);
            const float fg = lb + (1.0f - lb) * sg;
            g += __logf(fg);
            QH[off] = (bf16)f2bf(siluf_(ql) * __expf(g));
            FH[off] = (bf16)f2bf((1.0f - lb) * (1.0f - sg) * __expf(-g));
        }
        EGL[(size_t)ch * DM + col] = __expf(g);
    }
}
__device__ __forceinline__ void p4_atiles(Frame& F, const Args& a) {
    const int gw = F.vcu * NWAVES + F.wave, NGW = F.G * NWAVES, lane = F.lane, r = lane & 31, hh = lane >> 5;
    const bf16* QT = (const bf16*)(a.ws + WS_QH); const bf16* KT = (const bf16*)(a.ws + WS_FH); bf16* HA = (bf16*)(a.ws + WS_HA);
    for (int u = gw; u < 4352; u += NGW) {
        int hd, tok0;
        if (u < 4096) { const int bh = u >> 7, c = u & 127; hd = bh & 7; tok0 = (bh >> 3) * TP + c * 32; }
        else { const int bh = u - 4096; hd = bh & 7; tok0 = NTOK_P + (bh >> 3) * TS; }
        const bf16* qp = QT + (size_t)(tok0 + r) * DM + hd * HE + 8 * hh;
        const bf16* kp = KT + (size_t)(tok0 + r) * DM + hd * HE + 8 * hh;
        f32x16 acc;
#pragma unroll
        for (int i = 0; i < 16; ++i) acc[i] = 0.f;
#pragma unroll
        for (int ks = 0; ks < 8; ++ks) {
            const bf16x8 af = *(const GAS bf16x8*)(qp + 16 * ks), bfr = *(const GAS bf16x8*)(kp + 16 * ks);
            acc = MFMA32(af, bfr, acc);
        }
#pragma unroll
        for (int reg = 0; reg < 16; ++reg) { const int t = crow(reg, hh); HA[(size_t)u * 1024 + t * 32 + r] = (bf16)(pkc((r <= t) ? acc[reg] : 0.f, 0.f) & 0xffffu); }
    }
}
namespace hr {
constexpr int QP = 264, KP = 320, VP = 320, AP = 80, OP = 272;
constexpr int L_Q = 0, L_K = 8448, L_V = 18688, L_A = 28928, L_RED = 31488, L_EG = 47872, L_O = 48384, L_END = 57088;
}
__device__ __forceinline__ void rec_hgrn(Frame& F, const Args& a, int unit) {
    using namespace hr;
    const bool smp = unit >= 32; const int bh = smp ? unit - 32 : unit;
    const int b = bh >> 3, hd = bh & 7;
    const int T = smp ? TS : TP, tok0 = smp ? NTOK_P + b * TS : b * TP, nsteps = T / 32;
    const int tid = F.tid, lane = F.lane, w = F.wave, we = w & 3, wc = w >> 2, r = lane & 31, hh = lane >> 5;
    LAS unsigned char* lds = F.lds + RING_OFF;
    LAS float* EG = (LAS float*)(lds + L_EG);
    const bf16* QT = (const bf16*)(a.ws + WS_QH); const bf16* KT = (const bf16*)(a.ws + WS_FH); const bf16* VI = (const bf16*)(a.ws + WS_IH);
    const float* EGL = (const float*)(a.ws + WS_EGL);
    const bf16* HA = (const bf16*)(a.ws + WS_HA) + (size_t)(smp ? 4096 + bh : bh * 128) * 1024;
    bf16* HO = (bf16*)(a.ws + WS_HO);
    __syncthreads();
    f32x16 St[2];
    if (smp) {
        const float* s0 = a.in[I_SH] + ((size_t)bh * HE + 64 * wc + 4 * hh) * HE + 32 * we + r;
#pragma unroll
        for (int i = 0; i < 2; ++i)
#pragma unroll
            for (int g = 0; g < 16; ++g) St[i][g] = s0[(size_t)(32 * i + (g & 3) + 8 * (g >> 2)) * HE];
    } else {
#pragma unroll
        for (int i = 0; i < 2; ++i)
#pragma unroll
            for (int g = 0; g < 16; ++g) St[i][g] = 0.f;
    }
    v4u rq, rk, rv, ra = {0u, 0u, 0u, 0u}; float reg_eg = 0.f;
    const int srow = tid >> 4, sc16 = tid & 15;
#define HR_LOAD(c0) do { const size_t off = (size_t)(tok0 + (c0) + srow) * DM + hd * HE + sc16 * 8; \
        rq = *(const GAS v4u*)(QT + off); rk = *(const GAS v4u*)(KT + off); rv = *(const GAS v4u*)(VI + off); \
        if (tid < 128) { ra = *(const GAS v4u*)(HA + (size_t)((c0) >> 5) * 1024 + (tid >> 2) * 32 + (tid & 3) * 8); reg_eg = EGL[(size_t)((tok0 + (c0)) >> 5) * DM + hd * HE + tid]; } } while (0)
    HR_LOAD(0);
    for (int step = 0; step < nsteps; ++step) {
        const int c0 = step * 32;
        { v2u q0, q1; q0.x = rq.x; q0.y = rq.y; q1.x = rq.z; q1.y = rq.w;
          *(LAS v2u*)(lds + L_Q + srow * QP + sc16 * 16) = q0; *(LAS v2u*)(lds + L_Q + srow * QP + sc16 * 16 + 8) = q1; }
        *(LAS v4u*)(lds + L_K + srow * KP + sc16 * 16) = rk;
        *(LAS v4u*)(lds + L_V + srow * VP + sc16 * 16) = rv;
        if (tid < 128) { *(LAS v4u*)(lds + L_A + (tid >> 2) * AP + (tid & 3) * 16) = ra; EG[tid] = reg_eg; }
        __syncthreads();
        if (step + 1 < nsteps) HR_LOAD(c0 + 32);
        f32x16 acc;
#pragma unroll
        for (int i = 0; i < 16; ++i) acc[i] = 0.f;
        const bf16x8 vb0 = tr_frag(lds + L_V, VP, 0, 32 * we, lane), vb1 = tr_frag(lds + L_V, VP, 16, 32 * we, lane);
#pragma unroll
        for (int i = 0; i < 2; ++i) {
            const int ct0 = 64 * wc + 32 * i;
#pragma unroll
            for (int s = 0; s < 2; ++s) {
                const bf16x8 xs = pack_step(St[i], s);
                LAS unsigned char* qa = lds + L_Q + r * QP + (ct0 + 16 * s + 4 * hh) * 2;
                const s16x4 lo = *(const LAS s16x4*)qa, hi = *(const LAS s16x4*)(qa + 16);
                acc = MFMA32(__builtin_shufflevector(lo, hi, 0, 1, 2, 3, 4, 5, 6, 7), xs, acc);
            }
            const bf16x8 ka0 = tr_frag(lds + L_K, KP, 0, ct0, lane), ka1 = tr_frag(lds + L_K, KP, 16, ct0, lane);
            St[i] = MFMA32(ka0, vb0, St[i]);
            St[i] = MFMA32(ka1, vb1, St[i]);
#pragma unroll
            for (int g = 0; g < 16; ++g) St[i][g] *= EG[ct0 + crow(g, hh)];
        }
        if (wc == 0) {
            const bf16x8 p0 = *(const LAS bf16x8*)(lds + L_A + r * AP + (8 * hh) * 2), p1 = *(const LAS bf16x8*)(lds + L_A + r * AP + (16 + 8 * hh) * 2);
            acc = MFMA32(p0, vb0, acc); acc = MFMA32(p1, vb1, acc);
        } else {
            LAS float* red = (LAS float*)(lds + L_RED) + we * 1024;
#pragma unroll
            for (int g = 0; g < 16; ++g) red[g * 64 + lane] = acc[g];
        }
        __syncthreads();
        if (wc == 0) {
            const LAS float* red = (const LAS float*)(lds + L_RED) + we * 1024;
#pragma unroll
            for (int g = 0; g < 16; ++g) { const int t = crow(g, hh); const float ov = acc[g] + red[g * 64 + lane];
                *(LAS bf16*)(lds + L_O + t * OP + (32 * we + r) * 2) = (bf16)(pkc(ov, 0.f) & 0xffffu); }
        }
        __syncthreads();
        *(GAS v4u*)(HO + (size_t)(tok0 + c0 + srow) * DM + hd * HE + sc16 * 8) = *(const LAS v4u*)(lds + L_O + srow * OP + sc16 * 16);
        __syncthreads();
    }
#undef HR_LOAD
    { float* so = a.out + (smp ? O_SS : O_SP) + ((size_t)bh * HE + 64 * wc + 4 * hh) * HE + 32 * we + r;
#pragma unroll
      for (int i = 0; i < 2; ++i)
#pragma unroll
          for (int g = 0; g < 16; ++g) so[(size_t)(32 * i + (g & 3) + 8 * (g >> 2)) * HE] = St[i][g]; }
}

__device__ __forceinline__ void rec_mlstm_naive(Frame& F, const Args& a, int unit) {
    const int seq = unit >> 6, h = (unit >> 4) & 3, es = unit & 15;
    const bool smp = seq >= BP; const int b = smp ? seq - BP : seq;
    const int T = smp ? TS : TP, tok0 = smp ? NTOK_P + b * TS : b * TP;
    const int dp = F.tid & 15, el = F.tid >> 4, e = es * 32 + el;
    const bf16* Q = (const bf16*)(a.ws + WS_Q); const bf16* K = (const bf16*)(a.ws + WS_K); const bf16* V = (const bf16*)(a.ws + WS_V);
    const float* GATES = (const float*)(a.ws + WS_GATES);
    bf16* HM = (bf16*)a.out;
    float Cs[32], ns[32]; float m;
    if (smp) {
        const float* c0 = a.in[I_SC] + ((size_t)(b * MH + h) * MHD + e) * MHD; const float* n0 = a.in[I_SN] + (size_t)(b * MH + h) * MHD;
#pragma unroll
        for (int j = 0; j < 32; ++j) { Cs[j] = c0[dp + 16 * j]; ns[j] = n0[dp + 16 * j]; }
        m = a.in[I_SM][b * MH + h];
    } else {
#pragma unroll
        for (int j = 0; j < 32; ++j) { Cs[j] = 0.f; ns[j] = 0.f; }
        m = 0.f;
    }
    LAS float* qs = (LAS float*)(F.lds + RING_OFF);
    LAS float* ks = qs + 16 * 512;
    LAS float* vs = ks + 16 * 512;
    LAS float* gs = vs + 16 * 32;
    for (int t0 = 0; t0 < T; t0 += 16) {
        __syncthreads();
        for (int i = F.tid; i < 16 * 512; i += NTHREADS) { const int tt = i >> 9, d = i & 511; const size_t off = (size_t)(tok0 + t0 + tt) * MI + h * MHD + d; qs[i] = bf2f(Q[off]); ks[i] = bf2f(K[off]); }
        { const int tt = F.tid >> 5, ee = F.tid & 31; vs[F.tid] = bf2f(V[(size_t)(tok0 + t0 + tt) * MI + h * MHD + es * 32 + ee]); }
        if (F.tid < 32) { const int tt = F.tid >> 1; gs[F.tid] = GATES[(size_t)(tok0 + t0 + tt) * 8 + (F.tid & 1) * 4 + h]; }
        __syncthreads();
        for (int tt = 0; tt < 16; ++tt) {
            const float ig = gs[tt * 2], lf = gs[tt * 2 + 1];
            const float mn = fmaxf(lf + m, ig), fp = __expf(lf + m - mn), ip = __expf(ig - mn); m = mn;
            const float vv = ip * vs[tt * 32 + el];
            float dot = 0.f, nd = 0.f;
#pragma unroll
            for (int j = 0; j < 32; ++j) { const float kk = ks[tt * 512 + dp + 16 * j], qq = qs[tt * 512 + dp + 16 * j];
                Cs[j] = fp * Cs[j] + vv * kk; ns[j] = fp * ns[j] + ip * kk; dot += Cs[j] * qq; nd += ns[j] * qq; }
#pragma unroll
            for (int o = 1; o < 16; o <<= 1) { dot += __shfl_xor(dot, o); nd += __shfl_xor(nd, o); }
            const float hv = dot / fmaxf(fabsf(nd), __expf(-m));
            if (dp == 0) HM[(size_t)(tok0 + t0 + tt) * MI + h * MHD + e] = (bf16)f2bf(hv);
        }
    }
    float* co = a.out + (smp ? O_CS : O_CP) + ((size_t)(b * MH + h) * MHD + e) * MHD;
#pragma unroll
    for (int j = 0; j < 32; ++j) co[dp + 16 * j] = Cs[j];
    if (es == 0 && el == 0) { float* no = a.out + (smp ? O_NS : O_NP) + (size_t)(b * MH + h) * MHD;
#pragma unroll
        for (int j = 0; j < 32; ++j) no[dp + 16 * j] = ns[j];
        if (dp == 0) a.out[(smp ? O_MS : O_MP) + b * MH + h] = m; }
}
__device__ __forceinline__ void rec_hgrn_naive(Frame& F, const Args& a, int unit) {
    const int seq = unit >> 5, hd = (unit >> 2) & 7, es = unit & 3;
    const bool smp = seq >= BP; const int b = smp ? seq - BP : seq;
    const int T = smp ? TS : TP, tok0 = smp ? NTOK_P + b * TS : b * TP;
    const int cp = F.tid & 15, el = F.tid >> 4, e = es * 32 + el;
    const bf16* QH = (const bf16*)(a.ws + WS_QH); const bf16* FH = (const bf16*)(a.ws + WS_FH); const bf16* IH = (const bf16*)(a.ws + WS_IH);
    bf16* HO = (bf16*)(a.ws + WS_HO);
    float S[8];
    if (smp) {
#pragma unroll
        for (int j = 0; j < 8; ++j) S[j] = a.in[I_SH][((size_t)(b * HH + hd) * HE + cp + 16 * j) * HE + e];
    } else {
#pragma unroll
        for (int j = 0; j < 8; ++j) S[j] = 0.f;
    }
    LAS float* qs = (LAS float*)(F.lds + RING_OFF);
    LAS float* fs = qs + 2048; LAS float* ks = fs + 2048; LAS float* vs = ks + 2048;
    for (int t0 = 0; t0 < T; t0 += 16) {
        __syncthreads();
        for (int i = F.tid; i < 2048; i += NTHREADS) { const int tt = i >> 7, c = i & 127, col = hd * HE + c; const size_t off = (size_t)(tok0 + t0 + tt) * DM + col;
            const float l0 = a.in[I_LB][col], l1 = a.in[I_LB][DM + col]; const float lb = 1.0f / (1.0f + __expf(l1 - l0));
            const float sg = sigmoidf_(bf2f(FH[off]));
            qs[i] = siluf_(bf2f(QH[off])); fs[i] = lb + (1.0f - lb) * sg; ks[i] = (1.0f - lb) * (1.0f - sg); }
        { const int tt = F.tid >> 5, ee = F.tid & 31; vs[F.tid] = bf2f(IH[(size_t)(tok0 + t0 + tt) * DM + hd * HE + es * 32 + ee]); }
        __syncthreads();
        for (int tt = 0; tt < 16; ++tt) {
            const float vv = vs[tt * 32 + el]; float o = 0.f;
#pragma unroll
            for (int j = 0; j < 8; ++j) { const int c = cp + 16 * j; S[j] = fs[tt * 128 + c] * S[j] + ks[tt * 128 + c] * vv; o += qs[tt * 128 + c] * S[j]; }
#pragma unroll
            for (int s = 1; s < 16; s <<= 1) o += __shfl_xor(o, s);
            if (cp == 0) HO[(size_t)(tok0 + t0 + tt) * DM + hd * HE + e] = (bf16)f2bf(o);
        }
    }
    float* so = a.out + (smp ? O_SS : O_SP);
#pragma unroll
    for (int j = 0; j < 8; ++j) so[((size_t)(b * HH + hd) * HE + cp + 16 * j) * HE + e] = S[j];
}
__device__ __forceinline__ void p5_rec(Frame& F, const Args& a) {
    const int bx = blockIdx.x;
    if (F.G == 256) {
        const int x = bx & 7, y = bx >> 3;
        if (y < 16) rec_mlstm(F, a, (x * 2 + (y >> 3)) * 8 + (y & 7));
        else if (y < 20) rec_hgrn(F, a, x * 4 + (y - 16));
        else for (int u = x * 12 + (y - 20); u < 1280; u += 96) { if (u < 1024) rec_mlstm(F, a, 128 + u); else rec_hgrn(F, a, 32 + (u - 1024)); }
    } else {
        for (int u = bx; u < 128 + 1024; u += F.G) rec_mlstm(F, a, u);
        for (int u = bx; u < 32 + 256; u += F.G) rec_hgrn(F, a, u);
    }
}

__device__ __forceinline__ void p6_norm(Frame& F, const Args& a) {
    const int gw = F.vcu * NWAVES + F.wave, NGW = F.G * NWAVES;
    const bf16* HM = (const bf16*)a.out; const bf16* C = (const bf16*)(a.ws + WS_C); const bf16* ZP = (const bf16*)(a.ws + WS_ZP);
    const bf16* HO = (const bf16*)(a.ws + WS_HO); const bf16* GHP = (const bf16*)(a.ws + WS_GHP);
    bf16* HMN = (bf16*)(a.ws + WS_HMN); bf16* OH = (bf16*)(a.ws + WS_OH);
    for (int m = gw; m < NTOK; m += NGW) {
#pragma unroll 1
        for (int h = 0; h < MH; ++h) {
            const int col = h * MHD + F.lane * 8; const size_t off = (size_t)m * MI + col;
            float x[8], c[8], z[8];
            unpack8(*(const GAS v4u*)(HM + off), x); unpack8(*(const GAS v4u*)(C + off), c); unpack8(*(const GAS v4u*)(ZP + off), z);
            float s = 0.f;
#pragma unroll
            for (int e = 0; e < 8; ++e) s += x[e];
            const float mu = wave_sum(s) * (1.f / MHD); float q = 0.f;
#pragma unroll
            for (int e = 0; e < 8; ++e) { x[e] -= mu; q += x[e] * x[e]; }
            const float rstd = 1.0f / sqrtf(wave_sum(q) * (1.f / MHD) + EPS);
            float o[8];
#pragma unroll
            for (int e = 0; e < 8; ++e) o[e] = (x[e] * rstd * a.in[I_MNORMG][col + e] + a.in[I_MSKIP][col + e] * c[e]) * z[e];
            *(GAS v4u*)(HMN + off) = pack8(o);
        }
        {
            const int col = F.lane * 16; const size_t off = (size_t)m * DM + col;
            float x[16], g[16];
            { float t0[8], t1[8]; unpack8(*(const GAS v4u*)(HO + off), t0); unpack8(*(const GAS v4u*)(HO + off + 8), t1);
#pragma unroll
              for (int e = 0; e < 8; ++e) { x[e] = t0[e]; x[8 + e] = t1[e]; } }
            { float t0[8], t1[8]; unpack8(*(const GAS v4u*)(GHP + off), t0); unpack8(*(const GAS v4u*)(GHP + off + 8), t1);
#pragma unroll
              for (int e = 0; e < 8; ++e) { g[e] = t0[e]; g[8 + e] = t1[e]; } }
            float q = 0.f;
#pragma unroll
            for (int e = 0; e < 16; ++e) q += x[e] * x[e];
            q += __shfl_xor(q, 1); q += __shfl_xor(q, 2); q += __shfl_xor(q, 4);
            const float rstd = 1.0f / sqrtf(q * (1.f / HE) + EPS);
            float o0[8], o1[8];
#pragma unroll
            for (int e = 0; e < 8; ++e) { o0[e] = x[e] * rstd * a.in[I_HNORMG][col + e] * g[e]; o1[e] = x[8 + e] * rstd * a.in[I_HNORMG][col + 8 + e] * g[8 + e]; }
            *(GAS v4u*)(OH + off) = pack8(o0); *(GAS v4u*)(OH + off + 8) = pack8(o1);
        }
    }
}

__device__ __forceinline__ void p12_final(Frame& F, const Args& a) {
    const int gw = F.vcu * NWAVES + F.wave, NGW = F.G * NWAVES;
    const float* fg = a.in[I_FINALG];
    for (int m = gw; m < NTOK; m += NGW) {
        GAS f32x4* xr = (GAS f32x4*)(a.out + (size_t)m * DM) + F.lane;
        f32x4 v[4]; float ss = 0.f;
#pragma unroll
        for (int j = 0; j < 4; ++j) { v[j] = xr[64 * j]; ss += (v[j].x * v[j].x + v[j].y * v[j].y) + (v[j].z * v[j].z + v[j].w * v[j].w); }
        const float rstd = 1.0f / sqrtf(wave_sum(ss) * (1.f / DM) + EPS);
#pragma unroll
        for (int j = 0; j < 4; ++j) { const f32x4 gg = *(const GAS f32x4*)(fg + 4 * F.lane + 256 * j); xr[64 * j] = v[j] * rstd * gg; }
    }
}

__device__ __forceinline__ void st8bf(bf16* p, f32x4 v0, f32x4 v1) {
    v4u w; w.x = pg8::cvt_pk_bf16(v0[0], v0[1]); w.y = pg8::cvt_pk_bf16(v0[2], v0[3]); w.z = pg8::cvt_pk_bf16(v1[0], v1[1]); w.w = pg8::cvt_pk_bf16(v1[2], v1[3]);
    *(GAS v4u*)p = w;
}
__device__ __forceinline__ void ld8bf(const bf16* p, f32x4& v0, f32x4& v1) {
    const v4u w = *(const GAS v4u*)p; v0 = (f32x4){bflo(w.x), bfhi(w.x), bflo(w.y), bfhi(w.y)}; v1 = (f32x4){bflo(w.z), bfhi(w.z), bflo(w.w), bfhi(w.w)};
}
__device__ __forceinline__ f32x4 sig4(f32x4 v) { return (f32x4){sigmoidf_(v[0]), sigmoidf_(v[1]), sigmoidf_(v[2]), sigmoidf_(v[3])}; }
struct Fn1a { unsigned char* ws;
    __device__ __forceinline__ void operator()(int row, int pn, int ct, f32x4 v0, f32x4 v1) const {
        bf16* base; int ld, col;
        if (pn < 8) { base = (bf16*)(ws + WS_U); ld = MI; col = pn * 256; } else if (pn < 16) { base = (bf16*)(ws + WS_V); ld = MI; col = (pn - 8) * 256; }
        else if (pn < 20) { base = (bf16*)(ws + WS_QH); ld = DM; col = (pn - 16) * 256; } else if (pn < 24) { base = (bf16*)(ws + WS_FH); ld = DM; col = (pn - 20) * 256; }
        else { base = (bf16*)(ws + WS_IH); ld = DM; col = (pn - 24) * 256; }
        st8bf(base + (size_t)row * ld + col + ct, v0, v1);
    } };
struct Fn3 { unsigned char* ws;
    __device__ __forceinline__ void operator()(int row, int pn, int ct, f32x4 v0, f32x4 v1) const {
        if (pn < 8) st8bf((bf16*)(ws + WS_Q) + (size_t)row * MI + pn * 256 + ct, v0, v1);
        else { const float s = 0.044194173824159216f; st8bf((bf16*)(ws + WS_K) + (size_t)row * MI + (pn - 8) * 256 + ct, v0 * s, v1 * s); }
    } };
struct Fn5 { unsigned char* ws;
    __device__ __forceinline__ void operator()(int row, int pn, int ct, f32x4 v0, f32x4 v1) const {
        bf16* base; int ld, col; bool sil;
        if (pn < 8) { base = (bf16*)(ws + WS_ZP); ld = MI; col = pn * 256; sil = true; } else if (pn < 12) { base = (bf16*)(ws + WS_GHP); ld = DM; col = (pn - 8) * 256; sil = true; }
        else if (pn < 16) { base = (bf16*)(ws + WS_GAP); ld = DM; col = (pn - 12) * 256; sil = false; } else { base = (bf16*)(ws + WS_GBP); ld = DM; col = (pn - 16) * 256; sil = false; }
        f32x4 s0 = sig4(v0), s1 = sig4(v1);
        if (sil) { s0 = s0 * v0; s1 = s1 * v1; }
        st8bf(base + (size_t)row * ld + col + ct, s0, s1);
    } };
struct Fn7 { unsigned char* ws;
    __device__ __forceinline__ void operator()(int row, int pn, int ct, f32x4 v0, f32x4 v1) const {
        const size_t off = (size_t)row * DM + pn * 256 + ct; f32x4 g0, g1; ld8bf((const bf16*)(ws + WS_GAP) + off, g0, g1);
        st8bf((bf16*)(ws + WS_YA) + off, v0 * g0, v1 * g1);
    } };
struct Fn8 { unsigned char* ws;
    __device__ __forceinline__ void operator()(int row, int pn, int ct, f32x4 v0, f32x4 v1) const {
        const size_t off = (size_t)row * DM + pn * 256 + ct; f32x4 g0, g1, y0, y1; ld8bf((const bf16*)(ws + WS_GBP) + off, g0, g1); ld8bf((const bf16*)(ws + WS_YA) + off, y0, y1);
        st8bf((bf16*)(ws + WS_Y) + off, y0 + v0 * g0, y1 + v1 * g1);
    } };
struct Fn9 { unsigned char* ws; const float* xp; const float* xs; float* out;
    __device__ __forceinline__ void operator()(int row, int pn, int ct, f32x4 v0, f32x4 v1) const {
        const int col = pn * 256 + ct; const float* xr = (row < NTOK_P ? xp + (size_t)row * DM : xs + (size_t)(row - NTOK_P) * DM) + col;
        const f32x4 h0 = *(const GAS f32x4*)xr + v0, h1 = *(const GAS f32x4*)(xr + 4) + v1;
        float* o = out + (size_t)row * DM + col; *(GAS f32x4*)o = h0; *(GAS f32x4*)(o + 4) = h1;
        st8bf((bf16*)(ws + WS_H1B) + (size_t)row * DM + col, h0, h1);
    } };
struct Fn10 { unsigned char* ws;
    __device__ __forceinline__ void operator()(int row, int pn, int ct, f32x4 v0, f32x4 v1) const { st8bf((bf16*)(ws + WS_G2) + (size_t)row * DM + pn * 256 + ct, v0, v1); } };
struct Fn11 { unsigned char* ws; float* out;
    __device__ __forceinline__ void operator()(int row, int pn, int ct, f32x4 v0, f32x4 v1) const {
        const size_t off = (size_t)row * DM + pn * 256 + ct; f32x4 g0, g1; ld8bf((const bf16*)(ws + WS_G2) + off, g0, g1);
        float* o = out + off; const f32x4 h0 = *(const GAS f32x4*)o, h1 = *(const GAS f32x4*)(o + 4);
        *(GAS f32x4*)o = h0 + sig4(v0) * g0; *(GAS f32x4*)(o + 4) = h1 + sig4(v1) * g1;
    } };

constexpr int N_PHASES = 14;
#ifndef MK_PER_PHASE
#define MK_PER_PHASE 0
#endif
template <class Fn>
__device__ __forceinline__ void run_gemm(Frame& F, const bf16* A, int lda, const bf16* Bt, int ldb, int K, int N, int amask, int ashift, int astride, const Fn& fn) {
    asm volatile("" : "+s"(K));
    pg8::Gemm g{A, Bt, lda, ldb, K, amask, ashift, astride}; pg8::StaticOrder S; S.init(NTOK, N, F.G, (int)blockIdx.x);
    pg8::EpiF<Fn> E{fn};
    pg8::gemm_phase<pg8::EpiF<Fn>, pg8::StaticOrder, true, true>(F.lds + RING_OFF, g, S, E);
}
__global__ void __launch_bounds__(NTHREADS, 2) mk_fwd(Args args) {
    extern __shared__ __attribute__((aligned(16))) unsigned char lds[];
    Frame F;
    F.lds = (LAS unsigned char*)lds;
    F.tid = threadIdx.x; F.lane = F.tid & 63; F.wave = __builtin_amdgcn_readfirstlane(F.tid >> 6);
    F.G = gridDim.x; { const int bx = blockIdx.x; F.vcu = (F.G % 8 == 0) ? (bx % 8) * (F.G / 8) + bx / 8 : bx; }
    volatile LAS unsigned* MISC = (volatile LAS unsigned*)(F.lds + MISC_OFF);
    for (int u = F.tid; u < (LDS_BYTES - LDSCTL_OFF) / 4; u += NTHREADS) ((LAS unsigned*)(F.lds + LDSCTL_OFF))[u] = 0u;
    __syncthreads();
    unsigned char* ws = args.ws;
    XcdBarrier bar; bar.bar = (unsigned*)(ws + WS_CTL) + CW_BAR; bar.x = 0; bar.st = nullptr;
    if (!MK_PER_PHASE) bar = xcd_barrier_post((unsigned*)(ws + WS_CTL) + CW_BAR, MISC + 8);
    const int lo = args.ph_lo, hi = args.ph_hi;
#ifndef PHMASK
#define PHMASK 0x3fff
#endif
#define IN(k) (((PHMASK >> (k)) & 1) && lo <= (k) && (k) < hi)
#define SEAM(k) do { if (IN(k) && IN((k) + 1)) xcd_barrier(bar); } while (0)
    if (IN(0)) { p0_prep(F, args); } SEAM(0);
    if (IN(1)) { run_gemm(F, (const bf16*)(ws + WS_XN), DM, (const bf16*)(ws + WS_WIN), DM, DM, 7168, 0, 0, 0, Fn1a{ws}); } SEAM(1);
    if (IN(2)) { p2_conv(F, args); p2_scan(F, args); p2_hprep(F, args); } SEAM(2);
    if (IN(3)) { run_gemm(F, (const bf16*)(ws + WS_C), MI, (const bf16*)(ws + WS_WQK), MHD, MHD, 4096, 7, 1, MHD, Fn3{ws}); } SEAM(3);
    if (IN(4)) { p4_ptiles(F, args); p4_atiles(F, args); } SEAM(4);
    if (IN(5)) { p5_rec(F, args); } SEAM(5);
    if (IN(6)) { run_gemm(F, (const bf16*)(ws + WS_XN), DM, (const bf16*)(ws + WS_WIN) + (size_t)7168 * DM, DM, DM, 5120, 0, 0, 0, Fn5{ws}); } SEAM(6);
    if (IN(7)) { p6_norm(F, args); } SEAM(7);
    if (IN(8)) { run_gemm(F, (const bf16*)(ws + WS_HMN), MI, (const bf16*)(ws + WS_WBRM), MI, MI, DM, 0, 0, 0, Fn7{ws}); } SEAM(8);
    if (IN(9)) { run_gemm(F, (const bf16*)(ws + WS_OH), DM, (const bf16*)(ws + WS_WBRH), DM, DM, DM, 0, 0, 0, Fn8{ws}); } SEAM(9);
    if (IN(10)) { run_gemm(F, (const bf16*)(ws + WS_Y), DM, (const bf16*)(ws + WS_WOUT), DM, DM, DM, 0, 0, 0, Fn9{ws, args.in[I_XP], args.in[I_XS], args.out}); } SEAM(10);
    if (IN(11)) { run_gemm(F, (const bf16*)(ws + WS_PB), PLE, (const bf16*)(ws + WS_WPLE), PLE, PLE, DM, 0, 0, 0, Fn10{ws}); } SEAM(11);
    if (IN(12)) { run_gemm(F, (const bf16*)(ws + WS_H1B), DM, (const bf16*)(ws + WS_WPG), DM, DM, DM, 0, 0, 0, Fn11{ws, args.out}); } SEAM(12);
    if (IN(13)) { p12_final(F, args); }
#undef IN
#undef SEAM
}

extern "C" void kernel_launch(void* const* d_in, const int* in_sizes, int n_in, void* d_out, int out_size, void* d_ws, size_t ws_size, hipStream_t stream) {
    static int grid = 0;
    if (grid == 0) {
        if (n_in != 27 || out_size != (int)O_END || ws_size < WS_END) { fprintf(stderr, "kernel_launch: unexpected shapes (n_in %d out %d ws %zu)\n", n_in, out_size, ws_size); grid = -1; return; }
        int dev = 0, cus = 0, per_cu = 0;
        if (hipGetDevice(&dev) != hipSuccess || hipDeviceGetAttribute(&cus, hipDeviceAttributeMultiprocessorCount, dev) != hipSuccess) { grid = -1; return; }
        if (hipFuncSetAttribute((const void*)mk_fwd, hipFuncAttributeMaxDynamicSharedMemorySize, LDS_BYTES) != hipSuccess) { grid = -1; return; }
        if (hipOccupancyMaxActiveBlocksPerMultiprocessor(&per_cu, (const void*)mk_fwd, NTHREADS, LDS_BYTES) != hipSuccess || per_cu < 1) { fprintf(stderr, "kernel_launch: occupancy query says %d\n", per_cu); grid = -1; (void)hipGetLastError(); return; }
        grid = cus;
    }
    if (grid < 0) return;
    if (hipMemsetAsync((char*)d_ws + WS_CTL, 0, CTL_ZERO_BYTES, stream) != hipSuccess) return;
    Args a{};
    for (int i = 0; i < 27; ++i) a.in[i] = (const float*)d_in[i];
    a.out = (float*)d_out; a.ws = (unsigned char*)d_ws;
#if MK_PER_PHASE
    for (int p = 0; p < N_PHASES; ++p) { a.ph_lo = p; a.ph_hi = p + 1; a.li = p; hipLaunchKernelGGL(mk_fwd, dim3(grid), dim3(NTHREADS), LDS_BYTES, stream, a); }
#else
    a.ph_lo = 0; a.ph_hi = N_PHASES; a.li = 0;
    hipLaunchKernelGGL(mk_fwd, dim3(grid), dim3(NTHREADS), LDS_BYTES, stream, a);
#endif
}
```

```cpp
#include <hip/hip_runtime.h>
#include <cstdio>
#include <cstdint>
#include <cmath>
namespace pg8 {
#define PG8_LAS __attribute__((address_space(3)))
typedef unsigned short bf16_t;
typedef short bf16x8 __attribute__((ext_vector_type(8)));
typedef float f32x4 __attribute__((ext_vector_type(4)));
typedef unsigned u32x4 __attribute__((ext_vector_type(4)));
constexpr int BM = 256, BK = 64, HALF = 128, HTB = HALF * BK * 2  , STAGE_BYTES = 8 * HTB, NXCD = 8, WGM = 8;

__host__ __device__ __forceinline__ int lds_byte(int r, int c) { const int st = (r >> 4) * 2 + (c >> 5), rr = r & 15, cc = c & 31, ob = rr * 64 + cc * 2; return st * 1024 + (ob ^ (((ob >> 9) & 1) << 5)); }
__host__ __device__ __forceinline__ void stage_rc(int b, int& R, int& C) { const int st = b / 1024, sb = b % 1024, swz = sb ^ (((sb >> 9) & 1) << 5); R = (st >> 1) * 16 + swz / 64; C = (st & 1) * 32 + (swz % 64) / 2; }
__host__ __device__ __forceinline__ int perm32(int rho) { const int n = rho >> 4, i = rho & 15; return 8 * (i >> 2) + 4 * n + (i & 3); }

struct Unit { int pm, pn; };
struct Gemm { const bf16_t* A; const bf16_t* Bt; int lda, ldb, K, amask, ashift, astride;
    __device__ __forceinline__ const char* abase(const Unit& u) const { return (const char*)(A + (size_t)u.pm * BM * lda + (size_t)(((u.pn & amask) >> ashift) * astride)); }
    __device__ __forceinline__ const char* bbase(const Unit& u) const { return (const char*)(Bt + (size_t)u.pn * BM * ldb); } };

struct StaticOrder {
    int nM, nN, nwg, G, c;
    __host__ __device__ void init(int M, int N, int G_, int c_) { nM = M / BM; nN = N / BM; nwg = nM * nN; G = G_; c = c_; }
    __host__ __device__ bool next(int i, Unit& u) const {
        const long L = (long)i * G + c; if (L >= nwg) return false;
        int wgid = (int)L; { const int q = nwg / NXCD, r = nwg % NXCD, xcd = wgid % NXCD, off = wgid / NXCD; wgid = (xcd < r ? xcd * (q + 1) : r * (q + 1) + (xcd - r) * q) + off; }
        const int nig = WGM * nN, gid = wgid / nig, fm = gid * WGM, gsz = (nM - fm) < WGM ? (nM - fm) : WGM;
        u.pm = fm + ((wgid % nig) % gsz); u.pn = (wgid % nig) / gsz; return true;
    }
    __device__ __forceinline__ void a_ready(const Unit&) const {}
    __device__ __forceinline__ void done(const Unit&) const {}
};

typedef float f32x2_cv __attribute__((ext_vector_type(2)));
typedef __bf16 bf16x2_cv __attribute__((ext_vector_type(2)));
__device__ __forceinline__ unsigned cvt_pk_bf16(float lo, float hi) { f32x2_cv f = {lo, hi}; bf16x2_cv h = __builtin_convertvector(f, bf16x2_cv); return __builtin_bit_cast(unsigned, h); }
template <class Epi, class Sched, bool ALIGN_EPI = false, bool SP2 = false>
__device__ __forceinline__ void gemm_phase(PG8_LAS unsigned char* lds, const Gemm g, const Sched& S, const Epi& E) {
    const int lda = g.lda, ldb = g.ldb;
    const int tid = threadIdx.x, wid = __builtin_amdgcn_readfirstlane(tid >> 6), lane = tid & 63, wr = wid >> 2, wc = wid & 3, fr = lane & 15, fq = lane >> 4;
    const int K = g.K, nt = K / BK;
    unsigned voffA[2], voffB[2];
#pragma unroll
    for (int i = 0; i < 2; ++i) { int R, C; stage_rc(tid * 16 + i * 8192, R, C); const int Rb = Epi::PERM ? ((R & ~31) + perm32(R & 31)) : R;
        voffA[i] = (unsigned)(R * lda + C) * 2u; voffB[i] = (unsigned)(Rb * ldb + C) * 2u; }
    const size_t kstep = (size_t)(BK * 2);
    const size_t hstepA = (size_t)HALF * lda * 2, hstepB = (size_t)HALF * ldb * 2;
    const unsigned ldsw = (unsigned)wid * 1024u;
    const int aoff = lds_byte(wr * 64 + fr, fq * 8), boff = lds_byte(wc * 32 + fr, fq * 8);
#define PG8_SA(b, h) (((b) * 2 + (h)) * HTB)
#define PG8_SB(b, h) ((4 + (b) * 2 + (h)) * HTB)
#define PG8_STAGE(bufoff, gbase, voff) do { _Pragma("unroll") for (int _i = 0; _i < 2; ++_i) \
        __builtin_amdgcn_global_load_lds((const unsigned*)((const char*)(gbase) + (voff)[_i]), (PG8_LAS unsigned*)(lds + (bufoff) + ldsw + _i * 8192), 16, 0, 0); } while (0)
#define PG8_LDA(dst, b, h) do { _Pragma("unroll") for (int m = 0; m < 4; ++m) _Pragma("unroll") for (int k = 0; k < 2; ++k) dst[m][k] = *(const PG8_LAS bf16x8*)(lds + PG8_SA(b, h) + aoff + m * 2048 + k * 1024); } while (0)
#define PG8_LDB(dst, b, h) do { _Pragma("unroll") for (int n = 0; n < 2; ++n) _Pragma("unroll") for (int k = 0; k < 2; ++k) dst[n][k] = *(const PG8_LAS bf16x8*)(lds + PG8_SB(b, h) + boff + n * 2048 + k * 1024); } while (0)
#define PG8_MMA(ai, bj, At, Bt) do { __builtin_amdgcn_s_setprio(1); _Pragma("unroll") for (int m = 0; m < 4; ++m) _Pragma("unroll") for (int n = 0; n < 2; ++n) _Pragma("unroll") for (int k = 0; k < 2; ++k) \
        acc[ai][bj][m][n] = __builtin_amdgcn_mfma_f32_16x16x32_bf16(Bt[n][k], At[m][k], acc[ai][bj][m][n], 0, 0, 0); __builtin_amdgcn_s_setprio(0); } while (0)
#define PG8_WAIT_V(n) asm volatile("s_waitcnt vmcnt(" #n ")" ::: "memory")
#define PG8_WAIT_L(n) asm volatile("s_waitcnt lgkmcnt(" #n ")" ::: "memory")
#define PG8_BAR __builtin_amdgcn_s_barrier()
#define PG8_SCHED __builtin_amdgcn_sched_barrier(0)
    Unit cur, nxt; int ui = 0;
    if (!S.next(0, cur)) return;
    f32x4 acc[2][2][4][2];
#pragma unroll
    for (int a = 0; a < 2; ++a)
#pragma unroll
        for (int b = 0; b < 2; ++b)
#pragma unroll
            for (int m = 0; m < 4; ++m)
#pragma unroll
                for (int n = 0; n < 2; ++n) acc[a][b][m][n] = (f32x4){0.f, 0.f, 0.f, 0.f};
    bf16x8 At[4][2], B0[2][2], B1[2][2];
    const char* cA = g.abase(cur); const char* cB = g.bbase(cur);
    S.a_ready(cur);
    if constexpr (SP2) {
        PG8_STAGE(PG8_SB(0, 0), cB, voffB); PG8_STAGE(PG8_SB(0, 1), cB + hstepB, voffB); PG8_STAGE(PG8_SA(0, 0), cA, voffA); PG8_STAGE(PG8_SA(0, 1), cA + hstepA, voffA);
        if (wr == 1) PG8_BAR;
        PG8_WAIT_V(2); PG8_BAR;
        PG8_STAGE(PG8_SB(1, 0), cB + kstep, voffB); PG8_STAGE(PG8_SA(1, 0), cA + kstep, voffA); PG8_STAGE(PG8_SB(1, 1), cB + hstepB + kstep, voffB);
        PG8_WAIT_V(6); PG8_BAR;
    } else {
        PG8_STAGE(PG8_SB(0, 0), cB, voffB); PG8_STAGE(PG8_SA(0, 0), cA, voffA); PG8_STAGE(PG8_SB(0, 1), cB + hstepB, voffB); PG8_STAGE(PG8_SA(0, 1), cA + hstepA, voffA);
        if (wr == 1) PG8_BAR;
        PG8_WAIT_V(4); PG8_BAR;
        PG8_STAGE(PG8_SB(1, 0), cB + kstep, voffB); PG8_STAGE(PG8_SA(1, 0), cA + kstep, voffA); PG8_STAGE(PG8_SB(1, 1), cB + hstepB + kstep, voffB);
        PG8_WAIT_V(6); PG8_BAR;
    }
    for (;;) {
        const bool has_next = S.next(ui + 1, nxt);
        const char* nA = has_next ? g.abase(nxt) : cA; const char* nB = has_next ? g.bbase(nxt) : cB;
        for (int t = 0; t < nt; t += 2) {
            const bool last = (t == nt - 2);
            const char* a1 = cA + (size_t)(t + 1) * kstep;
            const char* a2 = last ? nA : cA + (size_t)(t + 2) * kstep; const char* b2 = last ? nB : cB + (size_t)(t + 2) * kstep;
            const char* a3 = a2 + kstep; const char* b3 = b2 + kstep;
            if (last && has_next) S.a_ready(nxt);
            if constexpr (SP2) {
            PG8_LDB(B0, 0, 0); PG8_LDB(B1, 0, 1); PG8_SCHED; PG8_LDA(At, 0, 0); PG8_STAGE(PG8_SA(1, 1), a1 + hstepA, voffA);
            PG8_WAIT_V(8); PG8_WAIT_L(0); PG8_BAR; PG8_MMA(0, 0, At, B0); PG8_MMA(0, 1, At, B1); PG8_BAR; PG8_SCHED;
            PG8_LDA(At, 0, 1); PG8_STAGE(PG8_SB(0, 0), b2, voffB); PG8_STAGE(PG8_SB(0, 1), b2 + hstepB, voffB); PG8_STAGE(PG8_SA(0, 0), a2, voffA);
            PG8_WAIT_V(8); PG8_WAIT_L(0); PG8_BAR; PG8_MMA(1, 0, At, B0); PG8_MMA(1, 1, At, B1); PG8_BAR; PG8_SCHED;
            PG8_LDB(B0, 1, 0); PG8_LDB(B1, 1, 1); PG8_SCHED; PG8_LDA(At, 1, 0); PG8_STAGE(PG8_SA(0, 1), a2 + hstepA, voffA);
            PG8_WAIT_V(8); PG8_WAIT_L(0); PG8_BAR; PG8_MMA(0, 0, At, B0); PG8_MMA(0, 1, At, B1); PG8_BAR; PG8_SCHED;
            PG8_LDA(At, 1, 1); PG8_STAGE(PG8_SB(1, 0), b3, voffB); PG8_STAGE(PG8_SB(1, 1), b3 + hstepB, voffB); PG8_STAGE(PG8_SA(1, 0), a3, voffA);
            PG8_WAIT_V(8); PG8_WAIT_L(0); PG8_BAR; PG8_MMA(1, 0, At, B0); PG8_MMA(1, 1, At, B1); PG8_BAR; PG8_SCHED;
            } else {
            PG8_LDB(B0, 0, 0); PG8_SCHED; PG8_LDA(At, 0, 0); PG8_STAGE(PG8_SA(1, 1), a1 + hstepA, voffA);
            PG8_WAIT_L(8); PG8_BAR; PG8_WAIT_L(0); PG8_MMA(0, 0, At, B0); PG8_BAR; PG8_SCHED;
            PG8_LDB(B1, 0, 1); PG8_STAGE(PG8_SB(0, 0), b2, voffB);
            PG8_BAR; PG8_WAIT_L(0); PG8_MMA(0, 1, At, B1); PG8_BAR;
            PG8_LDA(At, 0, 1); PG8_STAGE(PG8_SA(0, 0), a2, voffA);
            PG8_BAR; PG8_WAIT_L(0); PG8_MMA(1, 0, At, B0); PG8_BAR; PG8_SCHED;
            PG8_STAGE(PG8_SB(0, 1), b2 + hstepB, voffB);
            PG8_WAIT_V(6); PG8_BAR; PG8_MMA(1, 1, At, B1); PG8_BAR;
            PG8_LDB(B0, 1, 0); PG8_SCHED; PG8_LDA(At, 1, 0); PG8_STAGE(PG8_SA(0, 1), a2 + hstepA, voffA);
            PG8_WAIT_L(8); PG8_BAR; PG8_WAIT_L(0); PG8_MMA(0, 0, At, B0); PG8_BAR; PG8_SCHED;
            PG8_LDB(B1, 1, 1); PG8_STAGE(PG8_SB(1, 0), b3, voffB);
            PG8_BAR; PG8_WAIT_L(0); PG8_MMA(0, 1, At, B1); PG8_BAR;
            PG8_LDA(At, 1, 1); PG8_STAGE(PG8_SA(1, 0), a3, voffA);
            PG8_BAR; PG8_WAIT_L(0); PG8_MMA(1, 0, At, B0); PG8_BAR; PG8_SCHED;
            PG8_STAGE(PG8_SB(1, 1), b3 + hstepB, voffB);
            PG8_WAIT_V(6); PG8_BAR; PG8_MMA(1, 1, At, B1); PG8_BAR;
            }
        }
        if constexpr (ALIGN_EPI) { if (wr == 0) PG8_BAR; }
        if constexpr (!Epi::AFTER_DRAIN) { E(acc, cur, wr, wc, fr, fq); S.done(cur); }
        if (!has_next) break;
#pragma unroll
        for (int a = 0; a < 2; ++a)
#pragma unroll
            for (int b = 0; b < 2; ++b)
#pragma unroll
                for (int m = 0; m < 4; ++m)
#pragma unroll
                    for (int n = 0; n < 2; ++n) acc[a][b][m][n] = (f32x4){0.f, 0.f, 0.f, 0.f};
        cur = nxt; cA = nA; cB = nB; ++ui;
        if constexpr (ALIGN_EPI) { if (wr == 1) PG8_BAR; }
    }
    PG8_WAIT_V(0);
    if constexpr (!ALIGN_EPI) { if (wr == 0) PG8_BAR; }
    PG8_BAR;
    if constexpr (Epi::AFTER_DRAIN) { E.fused(acc, cur, wr, wc, fr, fq, lds, wid, lane); S.done(cur); }
#undef PG8_SA
#undef PG8_SB
#undef PG8_STAGE
#undef PG8_LDA
#undef PG8_LDB
#undef PG8_MMA
#undef PG8_WAIT_V
#undef PG8_WAIT_L
#undef PG8_BAR
#undef PG8_SCHED
}

template <class Fn> struct EpiF {
    static constexpr bool PERM = true, AFTER_DRAIN = false;
    Fn f;
    __device__ __forceinline__ void operator()(const f32x4 (&acc)[2][2][4][2], const Unit& u, int wr, int wc, int fr, int fq) const {
        const int row0 = u.pm * BM + wr * 64 + fr, ct0 = wc * 32 + 8 * fq;
#pragma unroll
        for (int ai = 0; ai < 2; ++ai)
#pragma unroll
            for (int m = 0; m < 4; ++m)
#pragma unroll
                for (int bj = 0; bj < 2; ++bj) f(row0 + ai * HALF + m * 16, u.pn, ct0 + bj * HALF, acc[ai][bj][m][0], acc[ai][bj][m][1]);
    }
};
}

constexpr int NWAVES = 8, NTHREADS = 512;
constexpr int DM = 1024, MI = 2048, NSRC = 12296, PLE = 256;
constexpr int TP = 4096, TS = 32, BP = 4, BS = 32;
constexpr int NTOK_P = BP * TP, NTOK_S = BS * TS, NTOK = NTOK_P + NTOK_S;
constexpr int MH = 4, MHD = 512, HH = 8, HE = 128;
constexpr float EPS = 1e-6f;
constexpr size_t O_Y = 0, O_CONVP = 17825792, O_CP = 17850368, O_NP = 22044672, O_MP = 22052864, O_SP = 22052880,
                 O_CONVS = 22577168, O_CS = 22773776, O_NS = 56328208, O_MS = 56393744, O_SS = 56393872, O_END = 60588176;
constexpr size_t MiB = 1u << 20;
constexpr size_t WS_CTL = 0, CTL_ZERO_BYTES = 1 * MiB;
constexpr size_t WS_GATES = 1 * MiB, WS_PB = 2 * MiB;
constexpr size_t WS_WIN = 12 * MiB, WS_WQK = 36 * MiB, WS_WBRM = 40 * MiB, WS_WBRH = 44 * MiB, WS_WOUT = 46 * MiB, WS_WPG = 48 * MiB, WS_WPLE = 50 * MiB;
constexpr size_t WS_XN = 52 * MiB, WS_U = 86 * MiB, WS_V = 154 * MiB, WS_QH = 222 * MiB, WS_FH = 256 * MiB, WS_IH = 290 * MiB, WS_C = 324 * MiB, WS_K = 392 * MiB, WS_HO = 460 * MiB;
constexpr size_t WS_END = 510 * MiB;
constexpr size_t WS_Q = WS_U, WS_ZP = WS_V, WS_GHP = WS_QH, WS_GAP = WS_FH, WS_GBP = WS_IH, WS_HMN = WS_U, WS_OH = WS_K, WS_YA = WS_K + 34 * MiB, WS_Y = WS_C, WS_H1B = WS_C + 34 * MiB, WS_G2 = WS_HO;
constexpr int CW_BAR = 4096;
constexpr int RING_OFF = 0, RING_BYTES = 131072, LDSCTL_OFF = RING_BYTES, MISC_OFF = LDSCTL_OFF + 320, LDS_BYTES = 147456;

#define GAS __attribute__((address_space(1)))
#define LAS __attribute__((address_space(3)))
typedef unsigned short bf16;
typedef unsigned v4u __attribute__((ext_vector_type(4)));
typedef unsigned v2u __attribute__((ext_vector_type(2)));
typedef float f32x4 __attribute__((ext_vector_type(4)));
typedef GAS unsigned gu32;
#define RLX_AGENT __ATOMIC_RELAXED, __HIP_MEMORY_SCOPE_AGENT
#define LDS_WAIT() asm volatile("s_waitcnt lgkmcnt(0)" ::: "memory")
#define VM_WAIT() asm volatile("s_waitcnt vmcnt(0)" ::: "memory")
__device__ __forceinline__ unsigned f2bf(float f) { unsigned u = __builtin_bit_cast(unsigned, f); return (u + 0x7fffu + ((u >> 16) & 1u)) >> 16; }
__device__ __forceinline__ unsigned pk2(float lo, float hi) { return f2bf(lo) | (f2bf(hi) << 16); }
__device__ __forceinline__ float bflo(unsigned w) { return __builtin_bit_cast(float, w << 16); }
__device__ __forceinline__ float bfhi(unsigned w) { return __builtin_bit_cast(float, w & 0xffff0000u); }
__device__ __forceinline__ float bf2f(bf16 h) { return __builtin_bit_cast(float, (unsigned)h << 16); }
__device__ __forceinline__ void unpack8(v4u w, float (&o)[8]) { o[0] = bflo(w.x); o[1] = bfhi(w.x); o[2] = bflo(w.y); o[3] = bfhi(w.y); o[4] = bflo(w.z); o[5] = bfhi(w.z); o[6] = bflo(w.w); o[7] = bfhi(w.w); }
__device__ __forceinline__ v4u pack8(const float (&o)[8]) { v4u w; w.x = pk2(o[0], o[1]); w.y = pk2(o[2], o[3]); w.z = pk2(o[4], o[5]); w.w = pk2(o[6], o[7]); return w; }
__device__ __forceinline__ float sigmoidf_(float x) { return __builtin_amdgcn_rcpf(1.0f + __expf(-x)); }
__device__ __forceinline__ float siluf_(float x) { return x * sigmoidf_(x); }
__device__ __forceinline__ float logsigmoidf_(float x) { return fminf(x, 0.f) - log1pf(__expf(-fabsf(x))); }

#define XB_TMO      128
#define XB_XCNT(j)  (256  + 64 * (j))
#define XB_XSUB(j)  (1280 + 64 * (j))
#define XB_XGEN(j)  (2304 + 64 * (j))
#define XB_TOP      3328
#define XB_TOPGEN   3392
#define XCD_BAR_WORDS 3456
#define XB_SPIN_CAP (1u << 18)
__device__ __forceinline__ unsigned xb_ld(unsigned* p)              { return __hip_atomic_load(p, __ATOMIC_RELAXED, __HIP_MEMORY_SCOPE_AGENT); }
__device__ __forceinline__ unsigned xb_add(unsigned* p, unsigned v) { return __hip_atomic_fetch_add(p, v, __ATOMIC_RELAXED, __HIP_MEMORY_SCOPE_AGENT); }
__device__ __forceinline__ unsigned xb_xcc_id() { return (unsigned)__builtin_amdgcn_s_getreg((3 << 11) | 20) & 0xFu; }
#define XB_SPIN(cond, bar) do { unsigned _sp = 0; while (cond) { __builtin_amdgcn_s_sleep(1); \
    if ((++_sp & 255u) == 0u) { if (xb_ld(&(bar)[XB_TMO])) break; if (_sp > XB_SPIN_CAP) { atomicAdd(&(bar)[XB_TMO], 1u); break; } } } } while (0)
struct XcdBarrier { unsigned* bar; unsigned x; volatile LAS unsigned* st; };
__device__ __forceinline__ XcdBarrier xcd_barrier_post(unsigned* bar, volatile LAS unsigned* st) {
    XcdBarrier b; b.bar = bar; b.x = xb_xcc_id(); b.st = st;
    if (threadIdx.x == 0) (void)xb_add(&bar[XB_XCNT(b.x)], 1u);
    return b;
}
__device__ __forceinline__ void xcd_barrier_complete(unsigned* bar, unsigned x, unsigned& nloc, unsigned& nx) {
    const unsigned G = gridDim.x * gridDim.y * gridDim.z;
    unsigned sum, cnt, mine, sp = 0u;
    for (;;) {
        sum = 0u; cnt = 0u; mine = 0u;
#pragma unroll
        for (unsigned j = 0; j < 16; ++j) { const unsigned c = xb_ld(&bar[XB_XCNT(j)]); sum += c; cnt += (c > 0u) ? 1u : 0u; mine = (j == x) ? c : mine; }
        if (sum == G) break;
        __builtin_amdgcn_s_sleep(1);
        if ((++sp & 255u) == 0u) { if (xb_ld(&bar[XB_TMO])) break; if (sp > XB_SPIN_CAP) { atomicAdd(&bar[XB_TMO], 1u); break; } }
    }
    nloc = mine > 0u ? mine : 1u; nx = cnt > 0u ? cnt : 1u;
}
__device__ __forceinline__ void xcd_barrier(const XcdBarrier& b) {
    asm volatile("s_waitcnt vmcnt(0)" ::: "memory");
    __syncthreads();
    if (threadIdx.x == 0) {
        unsigned* bar = b.bar;
        __builtin_amdgcn_s_waitcnt(0);
        unsigned nloc = b.st[0], nx = b.st[1];
        if (nloc == 0u) { xcd_barrier_complete(bar, b.x, nloc, nx); b.st[0] = nloc; b.st[1] = nx; }
        const unsigned old = xb_add(&bar[XB_XSUB(b.x)], 1u);
        const unsigned gen = old / nloc;
        if (old + 1u == (gen + 1u) * nloc) {
            __builtin_amdgcn_fence(__ATOMIC_RELEASE, "agent");
            asm volatile("s_waitcnt vmcnt(0)" ::: "memory");
            const unsigned og = xb_add(&bar[XB_TOP], 1u);
            const unsigned tg = og / nx;
            if (og + 1u == (tg + 1u) * nx) xb_add(&bar[XB_TOPGEN], 1u);
            else XB_SPIN(xb_ld(&bar[XB_TOPGEN]) == tg, bar);
            __builtin_amdgcn_fence(__ATOMIC_ACQUIRE, "agent");
            xb_add(&bar[XB_XGEN(b.x)], 1u);
            asm volatile("s_waitcnt vmcnt(0)" ::: "memory");
        } else {
            XB_SPIN(xb_ld(&bar[XB_XGEN(b.x)]) == gen, bar);
            __builtin_amdgcn_fence(__ATOMIC_ACQUIRE, "agent");
            asm volatile("s_waitcnt vmcnt(0)" ::: "memory");
        }
    }
    __syncthreads();
}

__device__ __forceinline__ void local_fence() {
    asm volatile("s_waitcnt vmcnt(0)" ::: "memory"); __syncthreads();
    if (threadIdx.x == 0) { __builtin_amdgcn_fence(__ATOMIC_ACQUIRE, "agent"); asm volatile("s_waitcnt vmcnt(0)" ::: "memory"); }
    __syncthreads();
}
struct Args { const float* in[27]; float* out; unsigned char* ws; int ph_lo, ph_hi, li, pad; };
enum { I_XP = 0, I_XS, I_SCONV, I_SC, I_SN, I_SM, I_SH, I_PP, I_PS, I_NORMG, I_WIN, I_BIG, I_BFG, I_CONVW, I_CONVB, I_WQM, I_WKM, I_MNORMG, I_MSKIP, I_WBRM, I_LB, I_HNORMG, I_WBRH, I_WOUT, I_WPLE, I_WPG, I_FINALG };
struct Frame { LAS unsigned char* lds; int tid, lane, wave, vcu, G; };

__device__ __forceinline__ float wave_sum(float v) {
#pragma unroll
    for (int o = 1; o < 64; o <<= 1) v += __shfl_xor(v, o);
    return v;
}
__device__ __forceinline__ const float* xrow(const Args& a, int m) { return m < NTOK_P ? a.in[I_XP] + (size_t)m * DM : a.in[I_XS] + (size_t)(m - NTOK_P) * DM; }

__device__ __forceinline__ void p0_transpose_item(const float* W, int pitch, int K, int ncols, bf16* WT, int row_off, LAS float* scr, int item, int lane) {
    const int nblk = ncols / 32, kb = item / nblk, nb = item % nblk, k0 = 64 * kb, n0 = 32 * nb;
#pragma unroll 8
    for (int i = 0; i < 32; ++i) { const int kk = 2 * i + (lane >> 5); scr[kk * 33 + (lane & 31)] = W[(size_t)(k0 + kk) * pitch + n0 + (lane & 31)]; }
    LDS_WAIT(); asm volatile("" ::: "memory");
    const int c = lane & 7;
#pragma unroll
    for (int j = 0; j < 4; ++j) { const int n = (lane >> 3) + 8 * j; const LAS float* s = scr + (8 * c) * 33 + n;
        v4u o; o.x = pk2(s[0 * 33], s[1 * 33]); o.y = pk2(s[2 * 33], s[3 * 33]); o.z = pk2(s[4 * 33], s[5 * 33]); o.w = pk2(s[6 * 33], s[7 * 33]);
        *(GAS v4u*)(WT + (size_t)(row_off + n0 + n) * K + k0 + 8 * c) = o; }
    LDS_WAIT(); asm volatile("" ::: "memory");
}
struct Seg { const float* W; int pitch, K, ncols; bf16* WT; int row_off, items; };
__device__ __forceinline__ Seg seg_info(int s, const Args& a) {
    Seg g; unsigned char* ws = a.ws;
    switch (s) {
    case 0: g = Seg{a.in[I_WIN] + 0,    NSRC, 1024, 4096, (bf16*)(ws + WS_WIN), 0,    0}; break;
    case 1: g = Seg{a.in[I_WIN] + 6152, NSRC, 1024, 3072, (bf16*)(ws + WS_WIN), 4096, 0}; break;
    case 2: g = Seg{a.in[I_WIN] + 4096, NSRC, 1024, 2048, (bf16*)(ws + WS_WIN), 7168, 0}; break;
    case 3: g = Seg{a.in[I_WIN] + 9224, NSRC, 1024, 3072, (bf16*)(ws + WS_WIN), 9216, 0}; break;
    case 4: case 5: case 6: case 7: g = Seg{a.in[I_WQM] + (size_t)(s - 4) * 262144, 512, 512, 512, (bf16*)(ws + WS_WQK), (s - 4) * 512, 0}; break;
    case 8: case 9: case 10: case 11: g = Seg{a.in[I_WKM] + (size_t)(s - 8) * 262144, 512, 512, 512, (bf16*)(ws + WS_WQK), 2048 + (s - 8) * 512, 0}; break;
    case 12: g = Seg{a.in[I_WBRM], 1024, 2048, 1024, (bf16*)(ws + WS_WBRM), 0, 0}; break;
    case 13: g = Seg{a.in[I_WBRH], 1024, 1024, 1024, (bf16*)(ws + WS_WBRH), 0, 0}; break;
    case 14: g = Seg{a.in[I_WOUT], 1024, 1024, 1024, (bf16*)(ws + WS_WOUT), 0, 0}; break;
    case 15: g = Seg{a.in[I_WPG],  1024, 1024, 1024, (bf16*)(ws + WS_WPG),  0, 0}; break;
    default: g = Seg{a.in[I_WPLE], 1024, 256,  1024, (bf16*)(ws + WS_WPLE), 0, 0}; break;
    }
    g.items = (g.K / 64) * (g.ncols / 32);
    return g;
}
__device__ __forceinline__ void p0_prep(Frame& F, const Args& a) {
    LAS float* scr = (LAS float*)(F.lds + RING_OFF + F.wave * 16384);
    const int gw = F.vcu * NWAVES + F.wave, NGW = F.G * NWAVES;
    for (int s = 0; s < 17; ++s) {
        const Seg g = seg_info(s, a);
        for (int it = gw; it < g.items; it += NGW) p0_transpose_item(g.W, g.pitch, g.K, g.ncols, g.WT, g.row_off, scr, it, F.lane);
    }
    __syncthreads();
    LAS float* wg = (LAS float*)(F.lds + RING_OFF);
    for (int i = F.tid; i < 8192; i += NTHREADS) { const int k = i >> 3, q = i & 7; wg[q * 1024 + k] = a.in[I_WIN][(size_t)k * NSRC + 6144 + q]; }
    __syncthreads();
    bf16* XN = (bf16*)(a.ws + WS_XN); float* GATES = (float*)(a.ws + WS_GATES);
    const float* ng = a.in[I_NORMG];
    for (int m = gw; m < NTOK; m += NGW) {
        const GAS f32x4* xr = (const GAS f32x4*)xrow(a, m) + F.lane;
        f32x4 v[4]; float ss = 0.f;
#pragma unroll
        for (int j = 0; j < 4; ++j) { v[j] = xr[64 * j]; ss += (v[j].x * v[j].x + v[j].y * v[j].y) + (v[j].z * v[j].z + v[j].w * v[j].w); }
        const float rstd = 1.0f / sqrtf(wave_sum(ss) * (1.f / DM) + EPS);
        GAS v2u* o8 = (GAS v2u*)(XN + (size_t)m * DM) + F.lane;
        float gacc[8];
#pragma unroll
        for (int q = 0; q < 8; ++q) gacc[q] = 0.f;
#pragma unroll
        for (int j = 0; j < 4; ++j) {
            const f32x4 gg = *(const GAS f32x4*)(ng + 4 * F.lane + 256 * j);
            v[j] = v[j] * rstd * gg;
            v2u w; w.x = pk2(v[j].x, v[j].y); w.y = pk2(v[j].z, v[j].w); o8[64 * j] = w;
#pragma unroll
            for (int q = 0; q < 8; ++q) { const f32x4 ww = *(const LAS f32x4*)(wg + q * 1024 + 4 * F.lane + 256 * j); gacc[q] += (v[j].x * ww.x + v[j].y * ww.y) + (v[j].z * ww.z + v[j].w * ww.w); }
        }
#pragma unroll
        for (int q = 0; q < 8; ++q) gacc[q] = wave_sum(gacc[q]);
        if (F.lane == 0) {
#pragma unroll
            for (int q = 0; q < 4; ++q) { GATES[(size_t)m * 8 + q] = gacc[q] + a.in[I_BIG][q]; GATES[(size_t)m * 8 + 4 + q] = logsigmoidf_(gacc[4 + q] + a.in[I_BFG][q]); }
        }
    }
    bf16* PB = (bf16*)(a.ws + WS_PB);
    for (int i = F.vcu * NTHREADS + F.tid; i < NTOK * 32; i += F.G * NTHREADS) {
        const int m = i >> 5, c8 = (i & 31) * 8;
        const float* src = (m < NTOK_P ? a.in[I_PP] + (size_t)m * PLE : a.in[I_PS] + (size_t)(m - NTOK_P) * PLE) + c8;
        const f32x4 p0 = *(const GAS f32x4*)src, p1 = *(const GAS f32x4*)(src + 4);
        v4u w; w.x = pk2(p0.x, p0.y); w.y = pk2(p0.z, p0.w); w.z = pk2(p1.x, p1.y); w.w = pk2(p1.z, p1.w);
        *(GAS v4u*)(PB + (size_t)m * PLE + c8) = w;
    }
}

__device__ __forceinline__ void p2_conv(Frame& F, const Args& a) {
    const bf16* U = (const bf16*)(a.ws + WS_U); bf16* C = (bf16*)(a.ws + WS_C);
    const float* cw = a.in[I_CONVW]; const float* cb = a.in[I_CONVB]; const float* sconv = a.in[I_SCONV];
    const int ch = (F.tid & 255) * 8;
    float wv[4][8], bv[8];
#pragma unroll
    for (int j = 0; j < 4; ++j) { const f32x4 w0 = *(const GAS f32x4*)(cw + (size_t)j * MI + ch), w1 = *(const GAS f32x4*)(cw + (size_t)j * MI + ch + 4);
        wv[j][0] = w0.x; wv[j][1] = w0.y; wv[j][2] = w0.z; wv[j][3] = w0.w; wv[j][4] = w1.x; wv[j][5] = w1.y; wv[j][6] = w1.z; wv[j][7] = w1.w; }
    { const f32x4 b0 = *(const GAS f32x4*)(cb + ch), b1 = *(const GAS f32x4*)(cb + ch + 4); bv[0] = b0.x; bv[1] = b0.y; bv[2] = b0.z; bv[3] = b0.w; bv[4] = b1.x; bv[5] = b1.y; bv[6] = b1.z; bv[7] = b1.w; }
    for (int i = F.vcu * NTHREADS + F.tid; i < (NTOK / 4) * 256; i += F.G * NTHREADS) {
        const int tok = (i >> 8) * 4;
        const bool smp = tok >= NTOK_P;
        const int b = smp ? (tok - NTOK_P) >> 5 : tok >> 12, t = smp ? (tok - NTOK_P) & 31 : tok & 4095;
        float u[7][8];
#pragma unroll
        for (int j = 0; j < 7; ++j) {
            const int tp = t - 3 + j;
            if (tp >= 0) unpack8(*(const GAS v4u*)(U + (size_t)(tok - 3 + j) * MI + ch), u[j]);
            else if (smp) { const float* sp = sconv + (size_t)(b * 3 + (3 + tp)) * MI + ch; const f32x4 s0 = *(const GAS f32x4*)sp, s1 = *(const GAS f32x4*)(sp + 4);
                u[j][0] = s0.x; u[j][1] = s0.y; u[j][2] = s0.z; u[j][3] = s0.w; u[j][4] = s1.x; u[j][5] = s1.y; u[j][6] = s1.z; u[j][7] = s1.w; }
            else {
#pragma unroll
                for (int e = 0; e < 8; ++e) u[j][e] = 0.f; }
        }
        const int tl = smp ? TS : TP;
#pragma unroll
        for (int q = 0; q < 4; ++q) {
            float acc[8];
#pragma unroll
            for (int e = 0; e < 8; ++e) acc[e] = siluf_(bv[e] + u[q][e] * wv[0][e] + u[q + 1][e] * wv[1][e] + u[q + 2][e] * wv[2][e] + u[q + 3][e] * wv[3][e]);
            *(GAS v4u*)(C + (size_t)(tok + q) * MI + ch) = pack8(acc);
            if (t + q >= tl - 3) {
                float* dst = a.out + (smp ? O_CONVS : O_CONVP) + (size_t)(b * 3 + (t + q - (tl - 3))) * MI + ch;
                *(GAS f32x4*)dst = (f32x4){u[q + 3][0], u[q + 3][1], u[q + 3][2], u[q + 3][3]}; *(GAS f32x4*)(dst + 4) = (f32x4){u[q + 3][4], u[q + 3][5], u[q + 3][6], u[q + 3][7]};
            }
        }
    }
}

typedef short s16x4 __attribute__((ext_vector_type(4)));
typedef short bf16x8 __attribute__((ext_vector_type(8)));
typedef float f32x16 __attribute__((ext_vector_type(16)));
typedef float f32x2 __attribute__((ext_vector_type(2)));
typedef __bf16 bf16x2v __attribute__((ext_vector_type(2)));
#define MFMA32(a, b, c) __builtin_amdgcn_mfma_f32_32x32x16_bf16((a), (b), (c), 0, 0, 0)
__device__ __forceinline__ unsigned pkc(float lo, float hi) { f32x2 f = {lo, hi}; bf16x2v h = __builtin_convertvector(f, bf16x2v); return __builtin_bit_cast(unsigned, h); }
__device__ __forceinline__ int crow(int reg, int hh) { return (reg & 3) + 8 * (reg >> 2) + 4 * hh; }
__device__ __forceinline__ bf16x8 pack_step(const f32x16& x, int s) {
    v4u p; p.x = pkc(x[8 * s], x[8 * s + 1]); p.y = pkc(x[8 * s + 2], x[8 * s + 3]); p.z = pkc(x[8 * s + 4], x[8 * s + 5]); p.w = pkc(x[8 * s + 6], x[8 * s + 7]);
    return __builtin_bit_cast(bf16x8, p);
}
__device__ __forceinline__ s16x4 trr(LAS unsigned char* p) { return __builtin_amdgcn_ds_read_tr16_b64_v4i16((LAS s16x4*)p); }
__device__ __forceinline__ bf16x8 tr_frag(LAS unsigned char* img, int pitch, int k0, int c0, int lane) {
    const int hh = lane >> 5, blk = (lane >> 4) & 1, qq = (lane & 15) >> 2, pp = lane & 3;
    LAS unsigned char* p = img + (k0 + 8 * hh + qq) * pitch + (c0 + 16 * blk + 4 * pp) * 2;
    const s16x4 lo = trr(p), hi = trr(p + 4 * pitch);
    return __builtin_shufflevector(lo, hi, 0, 1, 2, 3, 4, 5, 6, 7);
}

constexpr size_t WS_PT = 494 * MiB, WS_SC = 10 * MiB + 512 * 1024, WS_DENI = 11 * MiB + 256 * 1024;

__device__ __forceinline__ void p2_scan(Frame& F, const Args& a) {
    const int gw = F.vcu * NWAVES + F.wave, NGW = F.G * NWAVES, lane = F.lane;
    const float* GATES = (const float*)(a.ws + WS_GATES); float* SC = (float*)(a.ws + WS_SC);
    for (int sh = gw; sh < 36 * MH; sh += NGW) {
        const int seq = sh >> 2, h = sh & 3; const bool smp = seq >= BP; const int b = smp ? seq - BP : seq;
        const int tok0 = smp ? NTOK_P + b * TS : b * TP;
        const float minit = smp ? a.in[I_SM][b * MH + h] : 0.f;
        const float NEG = -3.0e38f;
        if (!smp) {
            float base = 0.f, run = minit;
#pragma unroll 4
            for (int j = 0; j < 64; ++j) {
                const size_t tk = (size_t)(tok0 + 64 * j + lane) * 8;
                const float lf = GATES[tk + 4 + h], ig = GATES[tk + h];
                float incl = lf;
#pragma unroll
                for (int o = 1; o < 64; o <<= 1) { const float v = __shfl_up(incl, o); if (lane >= o) incl += v; }
                const float bg = base + incl;
                float pm = ig - bg;
#pragma unroll
                for (int o = 1; o < 64; o <<= 1) { const float v = __shfl_up(pm, o); if (lane >= o) pm = fmaxf(pm, v); }
                const float mr = fmaxf(run, pm);
                SC[tk + h * 2] = bg; SC[tk + h * 2 + 1] = bg + mr;
                base = __shfl(bg, 63); run = __shfl(mr, 63);
            }
        } else {
            const int t = lane & 31; const float* G = GATES + (size_t)(tok0 + t) * 8;
            const float lf = G[4 + h], ig = G[h];
            float incl = lf;
#pragma unroll
            for (int o = 1; o < 32; o <<= 1) { const float v = __shfl_up(incl, o); if (t >= o) incl += v; }
            float pm = ig - incl;
#pragma unroll
            for (int o = 1; o < 32; o <<= 1) { const float v = __shfl_up(pm, o); if (t >= o) pm = fmaxf(pm, v); }
            if (lane < 32) { float* o = SC + (size_t)(tok0 + t) * 8 + h * 2; o[0] = incl; o[1] = incl + fmaxf(minit, pm); }
        }
    }
}

__device__ __forceinline__ void p4_ptiles(Frame& F, const Args& a) {
    const int gw = F.vcu * NWAVES + F.wave, NGW = F.G * NWAVES, lane = F.lane, r = lane & 31, hh = lane >> 5;
    const bf16* Q = (const bf16*)(a.ws + WS_Q); const bf16* K = (const bf16*)(a.ws + WS_K);
    const float* GATES = (const float*)(a.ws + WS_GATES); const float* SC = (const float*)(a.ws + WS_SC);
    bf16* PT = (bf16*)(a.ws + WS_PT);
    for (int u = gw; u < 2176; u += NGW) {
        int b, h, tok0;
        if (u < 2048) { const int bh = u >> 7, c = u & 127; b = bh >> 2; h = bh & 3; tok0 = b * TP + c * 32; }
        else { const int bh = u - 2048; b = bh >> 2; h = bh & 3; tok0 = NTOK_P + b * TS; }
        const bf16* qp = Q + (size_t)(tok0 + r) * MI + h * MHD + 8 * hh;
        const bf16* kp = K + (size_t)(tok0 + r) * MI + h * MHD + 8 * hh;
        f32x16 acc;
#pragma unroll
        for (int i = 0; i < 16; ++i) acc[i] = 0.f;
#pragma unroll 8
        for (int ks = 0; ks < 32; ++ks) {
            const bf16x8 af = *(const GAS bf16x8*)(qp + 16 * ks), bfr = *(const GAS bf16x8*)(kp + 16 * ks);
            acc = MFMA32(af, bfr, acc);
        }
        const float* sc = SC + (size_t)(tok0 + r) * 8 + h * 2;
        const float Bg = sc[0], m = sc[1], ig = GATES[(size_t)(tok0 + r) * 8 + h];
        const float cs = ig - Bg, rt = Bg - m;
#pragma unroll
        for (int reg = 0; reg < 16; ++reg) {
            const int t = crow(reg, hh);
            const float rtt = __shfl(rt, t);
            const float p = (r <= t) ? acc[reg] * __expf(rtt + cs) : 0.f;
            PT[(size_t)u * 1024 + t * 32 + r] = (bf16)(pkc(p, 0.f) & 0xffffu);
        }
    }
}

namespace mr {
constexpr int QP = 1032, KP = 1088, VP = 192, PPI = 80, HP = 144;
constexpr int L_Q = 0, L_K = 33024, L_V = 67840, L_VW = 73984, L_P = 80128, L_RED = 82688, L_SC = 107264, L_H = 108800, L_END = 113408;
}
__device__ __forceinline__ void rec_mlstm(Frame& F, const Args& a, int unit) {
    using namespace mr;
    const bool smp = unit >= 144; const int uu = smp ? unit - 144 : unit;
    const int bh = uu / 9, es = uu - bh * 9, b = bh >> 2, h = bh & 3; const bool den = es == 8;
    const int T = smp ? TS : TP, tok0 = smp ? NTOK_P + b * TS : b * TP, nsteps = T / 32;
    const int tid = F.tid, lane = F.lane, w = F.wave, we = w & 1, wd = w >> 1, r = lane & 31, hh = lane >> 5;
    const int el0 = we * 32, dt0 = wd * 128;
    LAS unsigned char* lds = F.lds + RING_OFF;
    LAS float* LS = (LAS float*)(lds + L_SC);
    const bf16* Q = (const bf16*)(a.ws + WS_Q); const bf16* K = (const bf16*)(a.ws + WS_K); const bf16* V = (const bf16*)(a.ws + WS_V);
    const float* GATES = (const float*)(a.ws + WS_GATES); const float* SC = (const float*)(a.ws + WS_SC);
    float* DEN = (float*)(a.ws + WS_DENI);
    const bf16* PT = (const bf16*)(a.ws + WS_PT) + (size_t)(smp ? 2048 + bh : bh * 128) * 1024;
    bf16* HM = (bf16*)a.out;
    __syncthreads();
    f32x16 Ct[4];
#pragma unroll
    for (int i = 0; i < 4; ++i)
#pragma unroll
        for (int g = 0; g < 16; ++g) Ct[i][g] = 0.f;
    if (smp) {
        if (!den) {
            const float* c0 = a.in[I_SC] + ((size_t)bh * MHD + es * 64 + el0 + r) * MHD + dt0 + 4 * hh;
#pragma unroll
            for (int i = 0; i < 4; ++i)
#pragma unroll
                for (int g = 0; g < 4; ++g) { const f32x4 v = *(const GAS f32x4*)(c0 + 32 * i + 8 * g); Ct[i][4 * g] = v.x; Ct[i][4 * g + 1] = v.y; Ct[i][4 * g + 2] = v.z; Ct[i][4 * g + 3] = v.w; }
        } else if (we == 0 && r == 0) {
            const float* n0 = a.in[I_SN] + (size_t)bh * MHD + dt0 + 4 * hh;
#pragma unroll
            for (int i = 0; i < 4; ++i)
#pragma unroll
                for (int g = 0; g < 4; ++g) { const f32x4 v = *(const GAS f32x4*)(n0 + 32 * i + 8 * g); Ct[i][4 * g] = v.x; Ct[i][4 * g + 1] = v.y; Ct[i][4 * g + 2] = v.z; Ct[i][4 * g + 3] = v.w; }
        }
    }
    float Bprev = 0.f, mprev = smp ? a.in[I_SM][bh] : 0.f;
    v4u rq[4], rk[4], rv = {0u, 0u, 0u, 0u}, rp = {0u, 0u, 0u, 0u}; float sBg = 0.f, sm = 0.f, sig = 0.f;
    const size_t colq = (size_t)h * MHD;
    const unsigned qoff0 = (unsigned)(tok0 + (tid >> 6)) * MI + (unsigned)colq + (unsigned)(tid & 63) * 8u;
    const unsigned voff0 = (unsigned)(tok0 + ((tid >> 3) & 31)) * MI + (unsigned)colq + (unsigned)(es & 7) * 64u + (unsigned)(tid & 7) * 8u;
    const unsigned poff0 = (unsigned)(((tid - 256) >> 2) & 31) * 32u + (unsigned)(tid & 3) * 8u;
    const unsigned soff0 = (unsigned)(tok0 + (tid & 31)) * 8u + (unsigned)h * 2u;
#define MR_LOAD(c0) do { const unsigned cs_ = (unsigned)(c0) * MI; \
        _Pragma("unroll") for (int i = 0; i < 4; ++i) { rq[i] = *(const GAS v4u*)(Q + (qoff0 + cs_ + (unsigned)(8 * i) * MI)); rk[i] = *(const GAS v4u*)(K + (qoff0 + cs_ + (unsigned)(8 * i) * MI)); } \
        if (tid < 256 && !den) { rv = *(const GAS v4u*)(V + (voff0 + cs_)); } \
        if (tid >= 256 && tid < 384) { rp = *(const GAS v4u*)(PT + (poff0 + (unsigned)(c0) * 32u)); } \
        if (tid >= 448 && tid < 480) { const unsigned tk = soff0 + (unsigned)(c0) * 8u; sBg = SC[tk]; sm = SC[tk + 1]; sig = GATES[tk - (unsigned)h]; } } while (0)
#define MR_SCALARS(bank) do { if (tid >= 448 && tid < 480) { const int t = tid - 448; const float BLs = __shfl(sBg, 31, 32), mLs = __shfl(sm, 31, 32); \
            LAS float* ls = LS + (bank) * 128; ls[t] = __expf(sBg - Bprev + mprev - sm); ls[32 + t] = __expf(BLs - sBg + sig - mLs); \
            if (t == 31) { ls[96] = __expf(BLs - Bprev + mprev - mLs); ls[97] = BLs; ls[98] = mLs; } } } while (0)
    MR_LOAD(0);
    for (int step = 0; step < nsteps; ++step) {
        const int c0 = step * 32; const int bank = step & 1;
        MR_SCALARS(bank);
        if (step > 0 && tid < 256 && !den) { const int row = tid >> 3, c16 = tid & 7;
            *(GAS v4u*)(HM + (size_t)(tok0 + c0 - 32 + row) * MI + colq + es * 64 + c16 * 8) = *(const LAS v4u*)(lds + L_H + row * HP + c16 * 16); }
#pragma unroll
        for (int i = 0; i < 4; ++i) {
            const int piece = tid + 512 * i, row = piece >> 6, c16 = piece & 63;
            v2u q0, q1; q0.x = rq[i].x; q0.y = rq[i].y; q1.x = rq[i].z; q1.y = rq[i].w;
            *(LAS v2u*)(lds + L_Q + row * QP + c16 * 16) = q0; *(LAS v2u*)(lds + L_Q + row * QP + c16 * 16 + 8) = q1;
            *(LAS v4u*)(lds + L_K + row * KP + c16 * 16) = rk[i];
        }
        __syncthreads();
        LAS float* ls = LS + bank * 128;
        if (tid < 256) { const int row = tid >> 3, c16 = tid & 7; const float wl = ls[32 + row];
            if (!den) { float x[8]; unpack8(rv, x);
                v4u vw; vw.x = pkc(x[0] * wl, x[1] * wl); vw.y = pkc(x[2] * wl, x[3] * wl); vw.z = pkc(x[4] * wl, x[5] * wl); vw.w = pkc(x[6] * wl, x[7] * wl);
                *(LAS v4u*)(lds + L_V + row * VP + c16 * 16) = rv; *(LAS v4u*)(lds + L_VW + row * VP + c16 * 16) = vw;
            } else { v4u one = {0u, 0u, 0u, 0u}, vw = {0u, 0u, 0u, 0u}; if (c16 == 0) { one.x = 0x3f80u; vw.x = pkc(wl, 0.f) & 0xffffu; }
                *(LAS v4u*)(lds + L_V + row * VP + c16 * 16) = one; *(LAS v4u*)(lds + L_VW + row * VP + c16 * 16) = vw; }
        }
        if (tid >= 256 && tid < 384) { const int t2 = tid - 256, row = t2 >> 2, c16 = t2 & 3; *(LAS v4u*)(lds + L_P + row * PPI + c16 * 16) = rp; }
        const float dec = ls[96], BL = ls[97], mL = ls[98];
        __syncthreads();
        if (step + 1 < nsteps) { MR_LOAD(c0 + 32); }
        f32x16 acc;
#pragma unroll
        for (int i = 0; i < 16; ++i) acc[i] = 0.f;
        const bf16x8 vb0 = tr_frag(lds + L_V, VP, 0, el0, lane), vb1 = tr_frag(lds + L_V, VP, 16, el0, lane);
        const bf16x8 vw0 = tr_frag(lds + L_VW, VP, 0, el0, lane), vw1 = tr_frag(lds + L_VW, VP, 16, el0, lane);
#pragma unroll
        for (int i = 0; i < 4; ++i) {
#pragma unroll
            for (int s = 0; s < 2; ++s) {
                const bf16x8 xs = pack_step(Ct[i], s);
                LAS unsigned char* qa = lds + L_Q + r * QP + (dt0 + 32 * i + 16 * s + 4 * hh) * 2;
                const s16x4 lo = *(const LAS s16x4*)qa, hi = *(const LAS s16x4*)(qa + 16);
                acc = MFMA32(__builtin_shufflevector(lo, hi, 0, 1, 2, 3, 4, 5, 6, 7), xs, acc);
            }
            Ct[i] = Ct[i] * dec;
            const bf16x8 ka0 = tr_frag(lds + L_K, KP, 0, dt0 + 32 * i, lane), ka1 = tr_frag(lds + L_K, KP, 16, dt0 + 32 * i, lane);
            Ct[i] = MFMA32(ka0, vw0, Ct[i]);
            Ct[i] = MFMA32(ka1, vw1, Ct[i]);
        }
#pragma unroll
        for (int g = 0; g < 16; ++g) acc[g] *= ls[crow(g, hh)];
        if (wd == 0) {
            const bf16x8 p0 = *(const LAS bf16x8*)(lds + L_P + r * PPI + (8 * hh) * 2), p1 = *(const LAS bf16x8*)(lds + L_P + r * PPI + (16 + 8 * hh) * 2);
            acc = MFMA32(p0, vb0, acc); acc = MFMA32(p1, vb1, acc);
        } else {
            LAS float* red = (LAS float*)(lds + L_RED) + ((wd - 1) * 2 + we) * 1024;
#pragma unroll
            for (int g = 0; g < 16; ++g) red[g * 64 + lane] = acc[g];
        }
        Bprev = BL; mprev = mL;
        __syncthreads();
        if (wd == 0) {
#pragma unroll
            for (int k = 0; k < 3; ++k) { const LAS float* red = (const LAS float*)(lds + L_RED) + (k * 2 + we) * 1024;
#pragma unroll
                for (int g = 0; g < 16; ++g) acc[g] += red[g * 64 + lane]; }
            if (!den) {
#pragma unroll
                for (int g = 0; g < 16; ++g) { const int t = crow(g, hh); *(LAS bf16*)(lds + L_H + t * HP + (el0 + r) * 2) = (bf16)(pkc(acc[g], 0.f) & 0xffffu); }
            } else if (we == 0 && r == 0) {
#pragma unroll
                for (int g = 0; g < 16; ++g) DEN[(size_t)(tok0 + c0 + crow(g, hh)) * 4 + h] = acc[g];
            }
        }
        __syncthreads();
    }
#undef MR_LOAD
#undef MR_SCALARS
    if (tid < 256 && !den) { const int row = tid >> 3, c16 = tid & 7;
        *(GAS v4u*)(HM + (size_t)(tok0 + T - 32 + row) * MI + colq + es * 64 + c16 * 8) = *(const LAS v4u*)(lds + L_H + row * HP + c16 * 16); }
    if (!den) { float* co = a.out + (smp ? O_CS : O_CP) + ((size_t)bh * MHD + es * 64 + el0 + r) * MHD + dt0 + 4 * hh;
#pragma unroll
      for (int i = 0; i < 4; ++i)
#pragma unroll
          for (int g = 0; g < 4; ++g) *(GAS f32x4*)(co + 32 * i + 8 * g) = (f32x4){Ct[i][4 * g], Ct[i][4 * g + 1], Ct[i][4 * g + 2], Ct[i][4 * g + 3]};
    } else if (we == 0 && r == 0) {
        float* no = a.out + (smp ? O_NS : O_NP) + (size_t)bh * MHD + dt0 + 4 * hh;
#pragma unroll
        for (int i = 0; i < 4; ++i)
#pragma unroll
            for (int g = 0; g < 4; ++g) *(GAS f32x4*)(no + 32 * i + 8 * g) = (f32x4){Ct[i][4 * g], Ct[i][4 * g + 1], Ct[i][4 * g + 2], Ct[i][4 * g + 3]};
        if (wd == 0 && hh == 0) a.out[(smp ? O_MS : O_MP) + bh] = mprev;
    }
}

constexpr size_t WS_HA = 498 * MiB + 512 * 1024, WS_EGL = 507 * MiB;
__device__ __forceinline__ void p2_hprep(Frame& F, const Args& a) {
    bf16* QH = (bf16*)(a.ws + WS_QH); bf16* FH = (bf16*)(a.ws + WS_FH); float* EGL = (float*)(a.ws + WS_EGL);
    for (int i = F.vcu * NTHREADS + F.tid; i < (NTOK / 32) * (DM / 4); i += F.G * NTHREADS) {
        const int ch = i >> 8, col = (i & 255) * 4;
        const f32x4 l0 = *(const GAS f32x4*)(a.in[I_LB] + col), l1 = *(const GAS f32x4*)(a.in[I_LB] + DM + col);
        float lb[4], eg[4];
#pragma unroll
        for (int e = 0; e < 4; ++e) { lb[e] = __builtin_amdgcn_rcpf(1.0f + __expf(l1[e] - l0[e])); eg[e] = 1.0f; }
        size_t off = (size_t)ch * 32 * DM + col;
#pragma unroll 4
        for (int t = 0; t < 32; ++t, off += DM) {
            const v2u fw = *(const GAS v2u*)(FH + off), qw = *(const GAS v2u*)(QH + off);
            const float fl[4] = {bflo(fw.x), bfhi(fw.x), bflo(fw.y), bfhi(fw.y)}, ql[4] = {bflo(qw.x), bfhi(qw.x), bflo(qw.y), bfhi(qw.y)};
            float qo[4], ko[4];
#pragma unroll
            for (int e = 0; e < 4; ++e) {
                const float sg = sigmoidf_(fl[e]);
                eg[e] *= lb[e] + (1.0f - lb[e]) * sg;
                qo[e] = siluf_(ql[e]) * eg[e];
                ko[e] = (1.0f - lb[e]) * (1.0f - sg) * __builtin_amdgcn_rcpf(eg[e]);
            }
            v2u qv, kv; qv.x = pkc(qo[0], qo[1]); qv.y = pkc(qo[2], qo[3]); kv.x = pkc(ko[0], ko[1]); kv.y = pkc(ko[2], ko[3]);
            *(GAS v2u*)(QH + off) = qv; *(GAS v2u*)(FH + off) = kv;
        }
        *(GAS f32x4*)(EGL + (size_t)ch * DM + col) = (f32x4){eg[0], eg[1], eg[2], eg[3]};
    }
}
__device__ __forceinline__ void p4_atiles(Frame& F, const Args& a) {
    const int gw = F.vcu * NWAVES + F.wave, NGW = F.G * NWAVES, lane = F.lane, r = lane & 31, hh = lane >> 5;
    const bf16* QT = (const bf16*)(a.ws + WS_QH); const bf16* KT = (const bf16*)(a.ws + WS_FH); bf16* HA = (bf16*)(a.ws + WS_HA);
    for (int u = gw; u < 4352; u += NGW) {
        int hd, tok0;
        if (u < 4096) { const int bh = u >> 7, c = u & 127; hd = bh & 7; tok0 = (bh >> 3) * TP + c * 32; }
        else { const int bh = u - 4096; hd = bh & 7; tok0 = NTOK_P + (bh >> 3) * TS; }
        const bf16* qp = QT + (size_t)(tok0 + r) * DM + hd * HE + 8 * hh;
        const bf16* kp = KT + (size_t)(tok0 + r) * DM + hd * HE + 8 * hh;
        f32x16 acc;
#pragma unroll
        for (int i = 0; i < 16; ++i) acc[i] = 0.f;
#pragma unroll
        for (int ks = 0; ks < 8; ++ks) {
            const bf16x8 af = *(const GAS bf16x8*)(qp + 16 * ks), bfr = *(const GAS bf16x8*)(kp + 16 * ks);
            acc = MFMA32(af, bfr, acc);
        }
#pragma unroll
        for (int reg = 0; reg < 16; ++reg) { const int t = crow(reg, hh); HA[(size_t)u * 1024 + t * 32 + r] = (bf16)(pkc((r <= t) ? acc[reg] : 0.f, 0.f) & 0xffffu); }
    }
}
namespace hr {
constexpr int QP = 264, KP = 320, VP = 320, AP = 80, OP = 272;
constexpr int L_Q = 0, L_K = 8448, L_V = 18688, L_A = 28928, L_RED = 31488, L_EG = 47872, L_O = 48384, L_END = 57088;
}
__device__ __forceinline__ void rec_hgrn(Frame& F, const Args& a, int unit) {
    using namespace hr;
    const bool smp = unit >= 32; const int bh = smp ? unit - 32 : unit;
    const int b = bh >> 3, hd = bh & 7;
    const int T = smp ? TS : TP, tok0 = smp ? NTOK_P + b * TS : b * TP, nsteps = T / 32;
    const int tid = F.tid, lane = F.lane, w = F.wave, we = w & 3, wc = w >> 2, r = lane & 31, hh = lane >> 5;
    LAS unsigned char* lds = F.lds + RING_OFF;
    LAS float* EG = (LAS float*)(lds + L_EG);
    const bf16* QT = (const bf16*)(a.ws + WS_QH); const bf16* KT = (const bf16*)(a.ws + WS_FH); const bf16* VI = (const bf16*)(a.ws + WS_IH);
    const float* EGL = (const float*)(a.ws + WS_EGL);
    const bf16* HA = (const bf16*)(a.ws + WS_HA) + (size_t)(smp ? 4096 + bh : bh * 128) * 1024;
    bf16* HO = (bf16*)(a.ws + WS_HO);
    __syncthreads();
    f32x16 St[2];
    if (smp) {
        const float* s0 = a.in[I_SH] + ((size_t)bh * HE + 64 * wc + 4 * hh) * HE + 32 * we + r;
#pragma unroll
        for (int i = 0; i < 2; ++i)
#pragma unroll
            for (int g = 0; g < 16; ++g) St[i][g] = s0[(size_t)(32 * i + (g & 3) + 8 * (g >> 2)) * HE];
    } else {
#pragma unroll
        for (int i = 0; i < 2; ++i)
#pragma unroll
            for (int g = 0; g < 16; ++g) St[i][g] = 0.f;
    }
    v4u rq, rk, rv, ra = {0u, 0u, 0u, 0u}; float reg_eg = 0.f;
    const int srow = tid >> 4, sc16 = tid & 15;
#define HR_LOAD(c0) do { const size_t off = (size_t)(tok0 + (c0) + srow) * DM + hd * HE + sc16 * 8; \
        rq = *(const GAS v4u*)(QT + off); rk = *(const GAS v4u*)(KT + off); rv = *(const GAS v4u*)(VI + off); \
        if (tid < 128) { ra = *(const GAS v4u*)(HA + (size_t)((c0) >> 5) * 1024 + (tid >> 2) * 32 + (tid & 3) * 8); reg_eg = EGL[(size_t)((tok0 + (c0)) >> 5) * DM + hd * HE + tid]; } } while (0)
    HR_LOAD(0);
    for (int step = 0; step < nsteps; ++step) {
        const int c0 = step * 32;
        { v2u q0, q1; q0.x = rq.x; q0.y = rq.y; q1.x = rq.z; q1.y = rq.w;
          *(LAS v2u*)(lds + L_Q + srow * QP + sc16 * 16) = q0; *(LAS v2u*)(lds + L_Q + srow * QP + sc16 * 16 + 8) = q1; }
        *(LAS v4u*)(lds + L_K + srow * KP + sc16 * 16) = rk;
        *(LAS v4u*)(lds + L_V + srow * VP + sc16 * 16) = rv;
        if (tid < 128) { *(LAS v4u*)(lds + L_A + (tid >> 2) * AP + (tid & 3) * 16) = ra; EG[tid] = reg_eg; }
        __syncthreads();
        if (step + 1 < nsteps) HR_LOAD(c0 + 32);
        f32x16 acc;
#pragma unroll
        for (int i = 0; i < 16; ++i) acc[i] = 0.f;
        const bf16x8 vb0 = tr_frag(lds + L_V, VP, 0, 32 * we, lane), vb1 = tr_frag(lds + L_V, VP, 16, 32 * we, lane);
#pragma unroll
        for (int i = 0; i < 2; ++i) {
            const int ct0 = 64 * wc + 32 * i;
#pragma unroll
            for (int s = 0; s < 2; ++s) {
                const bf16x8 xs = pack_step(St[i], s);
                LAS unsigned char* qa = lds + L_Q + r * QP + (ct0 + 16 * s + 4 * hh) * 2;
                const s16x4 lo = *(const LAS s16x4*)qa, hi = *(const LAS s16x4*)(qa + 16);
                acc = MFMA32(__builtin_shufflevector(lo, hi, 0, 1, 2, 3, 4, 5, 6, 7), xs, acc);
            }
            const bf16x8 ka0 = tr_frag(lds + L_K, KP, 0, ct0, lane), ka1 = tr_frag(lds + L_K, KP, 16, ct0, lane);
            St[i] = MFMA32(ka0, vb0, St[i]);
            St[i] = MFMA32(ka1, vb1, St[i]);
#pragma unroll
            for (int g = 0; g < 16; ++g) St[i][g] *= EG[ct0 + crow(g, hh)];
        }
        if (wc == 0) {
            const bf16x8 p0 = *(const LAS bf16x8*)(lds + L_A + r * AP + (8 * hh) * 2), p1 = *(const LAS bf16x8*)(lds + L_A + r * AP + (16 + 8 * hh) * 2);
            acc = MFMA32(p0, vb0, acc); acc = MFMA32(p1, vb1, acc);
        } else {
            LAS float* red = (LAS float*)(lds + L_RED) + we * 1024;
#pragma unroll
            for (int g = 0; g < 16; ++g) red[g * 64 + lane] = acc[g];
        }
        __syncthreads();
        if (wc == 0) {
            const LAS float* red = (const LAS float*)(lds + L_RED) + we * 1024;
#pragma unroll
            for (int g = 0; g < 16; ++g) { const int t = crow(g, hh); const float ov = acc[g] + red[g * 64 + lane];
                *(LAS bf16*)(lds + L_O + t * OP + (32 * we + r) * 2) = (bf16)(pkc(ov, 0.f) & 0xffffu); }
        }
        __syncthreads();
        *(GAS v4u*)(HO + (size_t)(tok0 + c0 + srow) * DM + hd * HE + sc16 * 8) = *(const LAS v4u*)(lds + L_O + srow * OP + sc16 * 16);
        __syncthreads();
    }
#undef HR_LOAD
    { float* so = a.out + (smp ? O_SS : O_SP) + ((size_t)bh * HE + 64 * wc + 4 * hh) * HE + 32 * we + r;
#pragma unroll
      for (int i = 0; i < 2; ++i)
#pragma unroll
          for (int g = 0; g < 16; ++g) so[(size_t)(32 * i + (g & 3) + 8 * (g >> 2)) * HE] = St[i][g]; }
}

__device__ __forceinline__ void rec_mlstm_naive(Frame& F, const Args& a, int unit) {
    const int seq = unit >> 6, h = (unit >> 4) & 3, es = unit & 15;
    const bool smp = seq >= BP; const int b = smp ? seq - BP : seq;
    const int T = smp ? TS : TP, tok0 = smp ? NTOK_P + b * TS : b * TP;
    const int dp = F.tid & 15, el = F.tid >> 4, e = es * 32 + el;
    const bf16* Q = (const bf16*)(a.ws + WS_Q); const bf16* K = (const bf16*)(a.ws + WS_K); const bf16* V = (const bf16*)(a.ws + WS_V);
    const float* GATES = (const float*)(a.ws + WS_GATES);
    bf16* HM = (bf16*)a.out;
    float Cs[32], ns[32]; float m;
    if (smp) {
        const float* c0 = a.in[I_SC] + ((size_t)(b * MH + h) * MHD + e) * MHD; const float* n0 = a.in[I_SN] + (size_t)(b * MH + h) * MHD;
#pragma unroll
        for (int j = 0; j < 32; ++j) { Cs[j] = c0[dp + 16 * j]; ns[j] = n0[dp + 16 * j]; }
        m = a.in[I_SM][b * MH + h];
    } else {
#pragma unroll
        for (int j = 0; j < 32; ++j) { Cs[j] = 0.f; ns[j] = 0.f; }
        m = 0.f;
    }
    LAS float* qs = (LAS float*)(F.lds + RING_OFF);
    LAS float* ks = qs + 16 * 512;
    LAS float* vs = ks + 16 * 512;
    LAS float* gs = vs + 16 * 32;
    for (int t0 = 0; t0 < T; t0 += 16) {
        __syncthreads();
        for (int i = F.tid; i < 16 * 512; i += NTHREADS) { const int tt = i >> 9, d = i & 511; const size_t off = (size_t)(tok0 + t0 + tt) * MI + h * MHD + d; qs[i] = bf2f(Q[off]); ks[i] = bf2f(K[off]); }
        { const int tt = F.tid >> 5, ee = F.tid & 31; vs[F.tid] = bf2f(V[(size_t)(tok0 + t0 + tt) * MI + h * MHD + es * 32 + ee]); }
        if (F.tid < 32) { const int tt = F.tid >> 1; gs[F.tid] = GATES[(size_t)(tok0 + t0 + tt) * 8 + (F.tid & 1) * 4 + h]; }
        __syncthreads();
        for (int tt = 0; tt < 16; ++tt) {
            const float ig = gs[tt * 2], lf = gs[tt * 2 + 1];
            const float mn = fmaxf(lf + m, ig), fp = __expf(lf + m - mn), ip = __expf(ig - mn); m = mn;
            const float vv = ip * vs[tt * 32 + el];
            float dot = 0.f, nd = 0.f;
#pragma unroll
            for (int j = 0; j < 32; ++j) { const float kk = ks[tt * 512 + dp + 16 * j], qq = qs[tt * 512 + dp + 16 * j];
                Cs[j] = fp * Cs[j] + vv * kk; ns[j] = fp * ns[j] + ip * kk; dot += Cs[j] * qq; nd += ns[j] * qq; }
#pragma unroll
            for (int o = 1; o < 16; o <<= 1) { dot += __shfl_xor(dot, o); nd += __shfl_xor(nd, o); }
            const float hv = dot / fmaxf(fabsf(nd), __expf(-m));
            if (dp == 0) HM[(size_t)(tok0 + t0 + tt) * MI + h * MHD + e] = (bf16)f2bf(hv);
        }
    }
    float* co = a.out + (smp ? O_CS : O_CP) + ((size_t)(b * MH + h) * MHD + e) * MHD;
#pragma unroll
    for (int j = 0; j < 32; ++j) co[dp + 16 * j] = Cs[j];
    if (es == 0 && el == 0) { float* no = a.out + (smp ? O_NS : O_NP) + (size_t)(b * MH + h) * MHD;
#pragma unroll
        for (int j = 0; j < 32; ++j) no[dp + 16 * j] = ns[j];
        if (dp == 0) a.out[(smp ? O_MS : O_MP) + b * MH + h] = m; }
}
__device__ __forceinline__ void rec_hgrn_naive(Frame& F, const Args& a, int unit) {
    const int seq = unit >> 5, hd = (unit >> 2) & 7, es = unit & 3;
    const bool smp = seq >= BP; const int b = smp ? seq - BP : seq;
    const int T = smp ? TS : TP, tok0 = smp ? NTOK_P + b * TS : b * TP;
    const int cp = F.tid & 15, el = F.tid >> 4, e = es * 32 + el;
    const bf16* QH = (const bf16*)(a.ws + WS_QH); const bf16* FH = (const bf16*)(a.ws + WS_FH); const bf16* IH = (const bf16*)(a.ws + WS_IH);
    bf16* HO = (bf16*)(a.ws + WS_HO);
    float S[8];
    if (smp) {
#pragma unroll
        for (int j = 0; j < 8; ++j) S[j] = a.in[I_SH][((size_t)(b * HH + hd) * HE + cp + 16 * j) * HE + e];
    } else {
#pragma unroll
        for (int j = 0; j < 8; ++j) S[j] = 0.f;
    }
    LAS float* qs = (LAS float*)(F.lds + RING_OFF);
    LAS float* fs = qs + 2048; LAS float* ks = fs + 2048; LAS float* vs = ks + 2048;
    for (int t0 = 0; t0 < T; t0 += 16) {
        __syncthreads();
        for (int i = F.tid; i < 2048; i += NTHREADS) { const int tt = i >> 7, c = i & 127, col = hd * HE + c; const size_t off = (size_t)(tok0 + t0 + tt) * DM + col;
            const float l0 = a.in[I_LB][col], l1 = a.in[I_LB][DM + col]; const float lb = 1.0f / (1.0f + __expf(l1 - l0));
            const float sg = sigmoidf_(bf2f(FH[off]));
            qs[i] = siluf_(bf2f(QH[off])); fs[i] = lb + (1.0f - lb) * sg; ks[i] = (1.0f - lb) * (1.0f - sg); }
        { const int tt = F.tid >> 5, ee = F.tid & 31; vs[F.tid] = bf2f(IH[(size_t)(tok0 + t0 + tt) * DM + hd * HE + es * 32 + ee]); }
        __syncthreads();
        for (int tt = 0; tt < 16; ++tt) {
            const float vv = vs[tt * 32 + el]; float o = 0.f;
#pragma unroll
            for (int j = 0; j < 8; ++j) { const int c = cp + 16 * j; S[j] = fs[tt * 128 + c] * S[j] + ks[tt * 128 + c] * vv; o += qs[tt * 128 + c] * S[j]; }
#pragma unroll
            for (int s = 1; s < 16; s <<= 1) o += __shfl_xor(o, s);
            if (cp == 0) HO[(size_t)(tok0 + t0 + tt) * DM + hd * HE + e] = (bf16)f2bf(o);
        }
    }
    float* so = a.out + (smp ? O_SS : O_SP);
#pragma unroll
    for (int j = 0; j < 8; ++j) so[((size_t)(b * HH + hd) * HE + cp + 16 * j) * HE + e] = S[j];
}
__device__ __forceinline__ void p5_rec(Frame& F, const Args& a) {
    const int bx = blockIdx.x;
    if (F.G == 256) {
        const int x = bx & 7, y = bx >> 3;
#ifndef RECDUP
#define RECDUP 0
#endif
        if (y < 18) { for (int rr = 0; rr < ((RECDUP & 1) ? 2 : 1); ++rr) rec_mlstm(F, a, (x * 2 + (y >= 9 ? 1 : 0)) * 9 + (y >= 9 ? y - 9 : y)); }
        else if (y < 22) { for (int rr = 0; rr < ((RECDUP & 2) ? 2 : 1); ++rr) rec_hgrn(F, a, x * 4 + (y - 18)); }
        else for (int u = x * 10 + (y - 22); u < 1152 + 256; u += 80) { if (u < 1152) rec_mlstm(F, a, 144 + u); else rec_hgrn(F, a, 32 + (u - 1152)); }
    } else {
        for (int u = bx; u < 144 + 1152; u += F.G) rec_mlstm(F, a, u);
        for (int u = bx; u < 32 + 256; u += F.G) rec_hgrn(F, a, u);
    }
}

__device__ __forceinline__ void p6_norm(Frame& F, const Args& a) {
    const int gw = F.vcu * NWAVES + F.wave, NGW = F.G * NWAVES, lane = F.lane;
    const bf16* HM = (const bf16*)a.out; const bf16* C = (const bf16*)(a.ws + WS_C); const bf16* ZP = (const bf16*)(a.ws + WS_ZP);
    const bf16* HO = (const bf16*)(a.ws + WS_HO); const bf16* GHP = (const bf16*)(a.ws + WS_GHP);
    const float* DEN = (const float*)(a.ws + WS_DENI); const float* SC = (const float*)(a.ws + WS_SC);
    bf16* HMN = (bf16*)(a.ws + WS_HMN); bf16* OH = (bf16*)(a.ws + WS_OH);
    const float* mg = a.in[I_MNORMG] + lane * 8; const float* ms = a.in[I_MSKIP] + lane * 8; const float* hg = a.in[I_HNORMG] + lane * 16;
    for (int m = gw; m < NTOK; m += NGW) {
        v4u hm[4], cc[4], zz[4], ho[2], gh[2]; f32x4 dn4, sc0, sc1;
        const size_t offm = (size_t)m * MI + lane * 8, offh = (size_t)m * DM + lane * 16;
#pragma unroll
        for (int h = 0; h < 4; ++h) { hm[h] = *(const GAS v4u*)(HM + offm + h * MHD); cc[h] = *(const GAS v4u*)(C + offm + h * MHD); zz[h] = *(const GAS v4u*)(ZP + offm + h * MHD); }
        ho[0] = *(const GAS v4u*)(HO + offh); ho[1] = *(const GAS v4u*)(HO + offh + 8); gh[0] = *(const GAS v4u*)(GHP + offh); gh[1] = *(const GAS v4u*)(GHP + offh + 8);
        dn4 = *(const GAS f32x4*)(DEN + (size_t)m * 4); sc0 = *(const GAS f32x4*)(SC + (size_t)m * 8); sc1 = *(const GAS f32x4*)(SC + (size_t)m * 8 + 4);
        const float mts[4] = {sc0.y, sc0.w, sc1.y, sc1.w};
#pragma unroll
        for (int h = 0; h < 4; ++h) {
            float x[8], c[8], z[8];
            unpack8(hm[h], x); unpack8(cc[h], c); unpack8(zz[h], z);
            float s = 0.f;
#pragma unroll
            for (int e = 0; e < 8; ++e) s += x[e];
            const float mu = wave_sum(s) * (1.f / MHD); float q = 0.f;
#pragma unroll
            for (int e = 0; e < 8; ++e) { x[e] -= mu; q += x[e] * x[e]; }
            const float dpr = fmaxf(fabsf(dn4[h]), __expf(-mts[h]));
            const float rstd = 1.0f / sqrtf(wave_sum(q) * (1.f / MHD) + EPS * dpr * dpr);
            const f32x4 g0 = *(const GAS f32x4*)(mg + h * MHD), g1 = *(const GAS f32x4*)(mg + h * MHD + 4), k0 = *(const GAS f32x4*)(ms + h * MHD), k1 = *(const GAS f32x4*)(ms + h * MHD + 4);
            float o[8];
#pragma unroll
            for (int e = 0; e < 4; ++e) { o[e] = (x[e] * rstd * g0[e] + k0[e] * c[e]) * z[e]; o[4 + e] = (x[4 + e] * rstd * g1[e] + k1[e] * c[4 + e]) * z[4 + e]; }
            *(GAS v4u*)(HMN + offm + h * MHD) = pack8(o);
        }
        {
            float x0[8], x1[8], g0[8], g1[8];
            unpack8(ho[0], x0); unpack8(ho[1], x1); unpack8(gh[0], g0); unpack8(gh[1], g1);
            float q = 0.f;
#pragma unroll
            for (int e = 0; e < 8; ++e) q += x0[e] * x0[e] + x1[e] * x1[e];
            q += __shfl_xor(q, 1); q += __shfl_xor(q, 2); q += __shfl_xor(q, 4);
            const float rstd = 1.0f / sqrtf(q * (1.f / HE) + EPS);
            float o0[8], o1[8];
#pragma unroll
            for (int e4 = 0; e4 < 2; ++e4) { const f32x4 ga = *(const GAS f32x4*)(hg + 4 * e4), gb = *(const GAS f32x4*)(hg + 8 + 4 * e4);
#pragma unroll
                for (int e = 0; e < 4; ++e) { o0[4 * e4 + e] = x0[4 * e4 + e] * rstd * ga[e] * g0[4 * e4 + e]; o1[4 * e4 + e] = x1[4 * e4 + e] * rstd * gb[e] * g1[4 * e4 + e]; } }
            *(GAS v4u*)(OH + offh) = pack8(o0); *(GAS v4u*)(OH + offh + 8) = pack8(o1);
        }
    }
}

__device__ __forceinline__ void p12_final(Frame& F, const Args& a) {
    const int gw = F.vcu * NWAVES + F.wave, NGW = F.G * NWAVES;
    const float* fg = a.in[I_FINALG];
    for (int m = gw; m < NTOK; m += NGW) {
        GAS f32x4* xr = (GAS f32x4*)(a.out + (size_t)m * DM) + F.lane;
        f32x4 v[4]; float ss = 0.f;
#pragma unroll
        for (int j = 0; j < 4; ++j) { v[j] = xr[64 * j]; ss += (v[j].x * v[j].x + v[j].y * v[j].y) + (v[j].z * v[j].z + v[j].w * v[j].w); }
        const float rstd = 1.0f / sqrtf(wave_sum(ss) * (1.f / DM) + EPS);
#pragma unroll
        for (int j = 0; j < 4; ++j) { const f32x4 gg = *(const GAS f32x4*)(fg + 4 * F.lane + 256 * j); xr[64 * j] = v[j] * rstd * gg; }
    }
}

__device__ __forceinline__ void st8bf(bf16* p, f32x4 v0, f32x4 v1) {
    v4u w; w.x = pg8::cvt_pk_bf16(v0[0], v0[1]); w.y = pg8::cvt_pk_bf16(v0[2], v0[3]); w.z = pg8::cvt_pk_bf16(v1[0], v1[1]); w.w = pg8::cvt_pk_bf16(v1[2], v1[3]);
    *(GAS v4u*)p = w;
}
__device__ __forceinline__ void ld8bf(const bf16* p, f32x4& v0, f32x4& v1) {
    const v4u w = *(const GAS v4u*)p; v0 = (f32x4){bflo(w.x), bfhi(w.x), bflo(w.y), bfhi(w.y)}; v1 = (f32x4){bflo(w.z), bfhi(w.z), bflo(w.w), bfhi(w.w)};
}
__device__ __forceinline__ f32x4 sig4(f32x4 v) { return (f32x4){sigmoidf_(v[0]), sigmoidf_(v[1]), sigmoidf_(v[2]), sigmoidf_(v[3])}; }
struct Fn1a { unsigned char* ws;
    __device__ __forceinline__ void operator()(int row, int pn, int ct, f32x4 v0, f32x4 v1) const {
        bf16* base; int ld, col;
        if (pn < 8) { base = (bf16*)(ws + WS_U); ld = MI; col = pn * 256; } else if (pn < 16) { base = (bf16*)(ws + WS_V); ld = MI; col = (pn - 8) * 256; }
        else if (pn < 20) { base = (bf16*)(ws + WS_QH); ld = DM; col = (pn - 16) * 256; } else if (pn < 24) { base = (bf16*)(ws + WS_FH); ld = DM; col = (pn - 20) * 256; }
        else { base = (bf16*)(ws + WS_IH); ld = DM; col = (pn - 24) * 256; }
        st8bf(base + (size_t)row * ld + col + ct, v0, v1);
    } };
struct Fn3 { unsigned char* ws;
    __device__ __forceinline__ void operator()(int row, int pn, int ct, f32x4 v0, f32x4 v1) const {
        if (pn < 8) st8bf((bf16*)(ws + WS_Q) + (size_t)row * MI + pn * 256 + ct, v0, v1);
        else { const float s = 0.044194173824159216f; st8bf((bf16*)(ws + WS_K) + (size_t)row * MI + (pn - 8) * 256 + ct, v0 * s, v1 * s); }
    } };
struct Fn5 { unsigned char* ws;
    __device__ __forceinline__ void operator()(int row, int pn, int ct, f32x4 v0, f32x4 v1) const {
        bf16* base; int ld, col; bool sil;
        if (pn < 8) { base = (bf16*)(ws + WS_ZP); ld = MI; col = pn * 256; sil = true; } else if (pn < 12) { base = (bf16*)(ws + WS_GHP); ld = DM; col = (pn - 8) * 256; sil = true; }
        else if (pn < 16) { base = (bf16*)(ws + WS_GAP); ld = DM; col = (pn - 12) * 256; sil = false; } else { base = (bf16*)(ws + WS_GBP); ld = DM; col = (pn - 16) * 256; sil = false; }
        f32x4 s0 = sig4(v0), s1 = sig4(v1);
        if (sil) { s0 = s0 * v0; s1 = s1 * v1; }
        st8bf(base + (size_t)row * ld + col + ct, s0, s1);
    } };
struct Fn7 { unsigned char* ws;
    __device__ __forceinline__ void operator()(int row, int pn, int ct, f32x4 v0, f32x4 v1) const {
        const size_t off = (size_t)row * DM + pn * 256 + ct; f32x4 g0, g1; ld8bf((const bf16*)(ws + WS_GAP) + off, g0, g1);
        st8bf((bf16*)(ws + WS_YA) + off, v0 * g0, v1 * g1);
    } };
struct Fn8 { unsigned char* ws;
    __device__ __forceinline__ void operator()(int row, int pn, int ct, f32x4 v0, f32x4 v1) const {
        const size_t off = (size_t)row * DM + pn * 256 + ct; f32x4 g0, g1, y0, y1; ld8bf((const bf16*)(ws + WS_GBP) + off, g0, g1); ld8bf((const bf16*)(ws + WS_YA) + off, y0, y1);
        st8bf((bf16*)(ws + WS_Y) + off, y0 + v0 * g0, y1 + v1 * g1);
    } };
struct Fn9 { unsigned char* ws; const float* xp; const float* xs; float* out;
    __device__ __forceinline__ void operator()(int row, int pn, int ct, f32x4 v0, f32x4 v1) const {
        const int col = pn * 256 + ct; const float* xr = (row < NTOK_P ? xp + (size_t)row * DM : xs + (size_t)(row - NTOK_P) * DM) + col;
        const f32x4 h0 = *(const GAS f32x4*)xr + v0, h1 = *(const GAS f32x4*)(xr + 4) + v1;
        float* o = out + (size_t)row * DM + col; *(GAS f32x4*)o = h0; *(GAS f32x4*)(o + 4) = h1;
        st8bf((bf16*)(ws + WS_H1B) + (size_t)row * DM + col, h0, h1);
    } };
struct Fn10 { unsigned char* ws;
    __device__ __forceinline__ void operator()(int row, int pn, int ct, f32x4 v0, f32x4 v1) const { st8bf((bf16*)(ws + WS_G2) + (size_t)row * DM + pn * 256 + ct, v0, v1); } };
struct Fn11 { unsigned char* ws; float* out;
    __device__ __forceinline__ void operator()(int row, int pn, int ct, f32x4 v0, f32x4 v1) const {
        const size_t off = (size_t)row * DM + pn * 256 + ct; f32x4 g0, g1; ld8bf((const bf16*)(ws + WS_G2) + off, g0, g1);
        float* o = out + off; const f32x4 h0 = *(const GAS f32x4*)o, h1 = *(const GAS f32x4*)(o + 4);
        *(GAS f32x4*)o = h0 + sig4(v0) * g0; *(GAS f32x4*)(o + 4) = h1 + sig4(v1) * g1;
    } };

template <class Fn>
__device__ __forceinline__ void small_gemm(Frame& F, const bf16* A, int lda, const bf16* Bt, int ldb, int K, const Fn& fn) {
    typedef float f32x4v __attribute__((ext_vector_type(4)));
    const int lane = F.lane, w = F.wave, wm = w >> 1, wn = w & 1, i16 = lane & 15, fq = lane >> 4;
    for (int t = blockIdx.x; t < 256; t += F.G) {
        const int row0 = NTOK_P + (t >> 4) * 64, col0 = (t & 15) * 64;
        const bf16* ap = A + (size_t)(row0 + 16 * wm + i16) * lda + 8 * fq;
        const bf16* b0 = Bt + (size_t)(col0 + 32 * wn + 8 * (i16 >> 2) + (i16 & 3)) * ldb + 8 * fq;
        const bf16* b1 = b0 + (size_t)4 * ldb;
        f32x4v acc0 = {0.f, 0.f, 0.f, 0.f}, acc1 = {0.f, 0.f, 0.f, 0.f};
#pragma unroll 8
        for (int k0 = 0; k0 < K; k0 += 32) {
            const bf16x8 xa = *(const GAS bf16x8*)(ap + k0), w0 = *(const GAS bf16x8*)(b0 + k0), w1 = *(const GAS bf16x8*)(b1 + k0);
            acc0 = __builtin_amdgcn_mfma_f32_16x16x32_bf16(w0, xa, acc0, 0, 0, 0);
            acc1 = __builtin_amdgcn_mfma_f32_16x16x32_bf16(w1, xa, acc1, 0, 0, 0);
        }
        const int col = col0 + 32 * wn + 8 * fq;
        fn(row0 + 16 * wm + i16, col >> 8, col & 255, acc0, acc1);
    }
}
template <class Fn> struct RowOff { Fn f; int r0; __device__ __forceinline__ void operator()(int row, int pn, int ct, pg8::f32x4 v0, pg8::f32x4 v1) const { f(row + r0, pn, ct, v0, v1); } };
constexpr int N_PHASES = 13;
#ifndef MK_PER_PHASE
#define MK_PER_PHASE 0
#endif
template <class Fn>
__device__ __forceinline__ void run_gemm(Frame& F, const bf16* A, int lda, const bf16* Bt, int ldb, int K, int N, int amask, int ashift, int astride, const Fn& fn, int M = NTOK) {
    asm volatile("" : "+s"(K));
    pg8::Gemm g{A, Bt, lda, ldb, K, amask, ashift, astride}; pg8::StaticOrder S; S.init(M, N, F.G, (int)blockIdx.x);
    pg8::EpiF<Fn> E{fn};
    pg8::gemm_phase<pg8::EpiF<Fn>, pg8::StaticOrder, true, true>(F.lds + RING_OFF, g, S, E);
}
__global__ void __launch_bounds__(NTHREADS, 2) mk_fwd(Args args) {
    extern __shared__ __attribute__((aligned(16))) unsigned char lds[];
    Frame F;
    F.lds = (LAS unsigned char*)lds;
    F.tid = threadIdx.x; F.lane = F.tid & 63; F.wave = __builtin_amdgcn_readfirstlane(F.tid >> 6);
    F.G = gridDim.x; { const int bx = blockIdx.x; F.vcu = (F.G % 8 == 0) ? (bx % 8) * (F.G / 8) + bx / 8 : bx; }
    volatile LAS unsigned* MISC = (volatile LAS unsigned*)(F.lds + MISC_OFF);
    for (int u = F.tid; u < (LDS_BYTES - LDSCTL_OFF) / 4; u += NTHREADS) ((LAS unsigned*)(F.lds + LDSCTL_OFF))[u] = 0u;
    __syncthreads();
    unsigned char* ws = args.ws;
    XcdBarrier bar; bar.bar = (unsigned*)(ws + WS_CTL) + CW_BAR; bar.x = 0; bar.st = nullptr;
    if (!MK_PER_PHASE) bar = xcd_barrier_post((unsigned*)(ws + WS_CTL) + CW_BAR, MISC + 8);
    const int lo = args.ph_lo, hi = args.ph_hi;
#ifndef PHMASK
#define PHMASK 0x1fff
#endif
#define IN(k) (((PHMASK >> (k)) & 1) && lo <= (k) && (k) < hi)
#define SEAM(k) do { if (IN(k) && IN((k) + 1)) xcd_barrier(bar); } while (0)
#ifndef RMASK
#define RMASK 0
#endif
#define REP(k, ...) do { __VA_ARGS__; if ((RMASK >> (k)) & 1) { xcd_barrier(bar); __VA_ARGS__; } } while (0)
    if (IN(0)) REP(0, p0_prep(F, args)); SEAM(0);
    if (IN(1)) REP(1, run_gemm(F, (const bf16*)(ws + WS_XN), DM, (const bf16*)(ws + WS_WIN), DM, DM, 7168, 0, 0, 0, Fn1a{ws})); SEAM(1);
    if (IN(2)) { REP(2, p2_conv(F, args); p2_scan(F, args)); p2_hprep(F, args); } SEAM(2);
    if (IN(3)) REP(3, run_gemm(F, (const bf16*)(ws + WS_C), MI, (const bf16*)(ws + WS_WQK), MHD, MHD, 4096, 7, 1, MHD, Fn3{ws})); SEAM(3);
    if (IN(4)) REP(4, p4_ptiles(F, args); p4_atiles(F, args)); SEAM(4);
    if (IN(5)) REP(5, p5_rec(F, args)); SEAM(5);
    if (IN(6)) REP(6, run_gemm(F, (const bf16*)(ws + WS_XN), DM, (const bf16*)(ws + WS_WIN) + (size_t)7168 * DM, DM, DM, 5120, 0, 0, 0, Fn5{ws})); SEAM(6);
    if (IN(7)) REP(7, p6_norm(F, args)); SEAM(7);
    if (IN(8)) REP(8, run_gemm(F, (const bf16*)(ws + WS_HMN), MI, (const bf16*)(ws + WS_WBRM), MI, MI, DM, 0, 0, 0, Fn7{ws}, NTOK_P); small_gemm(F, (const bf16*)(ws + WS_HMN), MI, (const bf16*)(ws + WS_WBRM), MI, MI, Fn7{ws});
                     run_gemm(F, (const bf16*)(ws + WS_PB), PLE, (const bf16*)(ws + WS_WPLE), PLE, PLE, DM, 0, 0, 0, Fn10{ws}, NTOK_P); small_gemm(F, (const bf16*)(ws + WS_PB), PLE, (const bf16*)(ws + WS_WPLE), PLE, PLE, Fn10{ws}));
    if (IN(8) && IN(9)) local_fence();
    if (IN(9)) REP(9, run_gemm(F, (const bf16*)(ws + WS_OH), DM, (const bf16*)(ws + WS_WBRH), DM, DM, DM, 0, 0, 0, Fn8{ws}, NTOK_P); small_gemm(F, (const bf16*)(ws + WS_OH), DM, (const bf16*)(ws + WS_WBRH), DM, DM, Fn8{ws})); SEAM(9);
    if (IN(10)) REP(10, run_gemm(F, (const bf16*)(ws + WS_Y), DM, (const bf16*)(ws + WS_WOUT), DM, DM, DM, 0, 0, 0, Fn9{ws, args.in[I_XP], args.in[I_XS], args.out}, NTOK_P); small_gemm(F, (const bf16*)(ws + WS_Y), DM, (const bf16*)(ws + WS_WOUT), DM, DM, Fn9{ws, args.in[I_XP], args.in[I_XS], args.out})); SEAM(10);
    if (IN(11)) { run_gemm(F, (const bf16*)(ws + WS_H1B), DM, (const bf16*)(ws + WS_WPG), DM, DM, DM, 0, 0, 0, Fn11{ws, args.out}, NTOK_P); small_gemm(F, (const bf16*)(ws + WS_H1B), DM, (const bf16*)(ws + WS_WPG), DM, DM, Fn11{ws, args.out}); } SEAM(11);
    if (IN(12)) { p12_final(F, args); }
#undef IN
#undef SEAM
}

extern "C" void kernel_launch(void* const* d_in, const int* in_sizes, int n_in, void* d_out, int out_size, void* d_ws, size_t ws_size, hipStream_t stream) {
    static int grid = 0;
    if (grid == 0) {
        if (n_in != 27 || out_size != (int)O_END || ws_size < WS_END) { fprintf(stderr, "kernel_launch: unexpected shapes (n_in %d out %d ws %zu)\n", n_in, out_size, ws_size); grid = -1; return; }
        int dev = 0, cus = 0, per_cu = 0;
        if (hipGetDevice(&dev) != hipSuccess || hipDeviceGetAttribute(&cus, hipDeviceAttributeMultiprocessorCount, dev) != hipSuccess) { grid = -1; return; }
        if (hipFuncSetAttribute((const void*)mk_fwd, hipFuncAttributeMaxDynamicSharedMemorySize, LDS_BYTES) != hipSuccess) { grid = -1; return; }
        if (hipOccupancyMaxActiveBlocksPerMultiprocessor(&per_cu, (const void*)mk_fwd, NTHREADS, LDS_BYTES) != hipSuccess || per_cu < 1) { fprintf(stderr, "kernel_launch: occupancy query says %d\n", per_cu); grid = -1; (void)hipGetLastError(); return; }
        grid = cus;
    }
    if (grid < 0) return;
    if (hipMemsetAsync((char*)d_ws + WS_CTL, 0, CTL_ZERO_BYTES, stream) != hipSuccess) return;
    Args a{};
    for (int i = 0; i < 27; ++i) a.in[i] = (const float*)d_in[i];
    a.out = (float*)d_out; a.ws = (unsigned char*)d_ws;
#if MK_PER_PHASE
    for (int p = 0; p < N_PHASES; ++p) { a.ph_lo = p; a.ph_hi = p + 1; a.li = p; hipLaunchKernelGGL(mk_fwd, dim3(grid), dim3(NTHREADS), LDS_BYTES, stream, a); }
#else
    a.ph_lo = 0; a.ph_hi = N_PHASES; a.li = 0;
    hipLaunchKernelGGL(mk_fwd, dim3(grid), dim3(NTHREADS), LDS_BYTES, stream, a);
#endif
}
```

```cpp
#include <hip/hip_runtime.h>
#include <cstdio>
#include <cstdint>
#include <cmath>
namespace pg8 {
#define PG8_LAS __attribute__((address_space(3)))
typedef unsigned short bf16_t;
typedef short bf16x8 __attribute__((ext_vector_type(8)));
typedef float f32x4 __attribute__((ext_vector_type(4)));
typedef unsigned u32x4 __attribute__((ext_vector_type(4)));
constexpr int BM = 256, BK = 64, HALF = 128, HTB = HALF * BK * 2  , STAGE_BYTES = 8 * HTB, NXCD = 8;

__host__ __device__ __forceinline__ int lds_byte(int r, int c) { const int st = (r >> 4) * 2 + (c >> 5), rr = r & 15, cc = c & 31, ob = rr * 64 + cc * 2; return st * 1024 + (ob ^ (((ob >> 9) & 1) << 5)); }
__host__ __device__ __forceinline__ void stage_rc(int b, int& R, int& C) { const int st = b / 1024, sb = b % 1024, swz = sb ^ (((sb >> 9) & 1) << 5); R = (st >> 1) * 16 + swz / 64; C = (st & 1) * 32 + (swz % 64) / 2; }
__host__ __device__ __forceinline__ int perm32(int rho) { const int n = rho >> 4, i = rho & 15; return 8 * (i >> 2) + 4 * n + (i & 3); }

struct Unit { int pm, pn; };
struct Gemm { const bf16_t* A; const bf16_t* Bt; int lda, ldb, K, amask, ashift, astride;
    __device__ __forceinline__ const char* abase(const Unit& u) const { return (const char*)(A + (size_t)u.pm * BM * lda + (size_t)(((u.pn & amask) >> ashift) * astride)); }
    __device__ __forceinline__ const char* bbase(const Unit& u) const { return (const char*)(Bt + (size_t)u.pn * BM * ldb); } };

struct StaticOrder {
    int nM, nN, nwg, G, c, WGM;
    __host__ __device__ void init(int M, int N, int G_, int c_, int wgm = 4) { nM = M / BM; nN = N / BM; nwg = nM * nN; G = G_; c = c_; WGM = wgm; }
    __host__ __device__ bool next(int i, Unit& u) const {
        const long L = (long)i * G + c; if (L >= nwg) return false;
        int wgid = (int)L; { const int q = nwg / NXCD, r = nwg % NXCD, xcd = wgid % NXCD, off = wgid / NXCD; wgid = (xcd < r ? xcd * (q + 1) : r * (q + 1) + (xcd - r) * q) + off; }
        const int nig = WGM * nN, gid = wgid / nig, fm = gid * WGM, gsz = (nM - fm) < WGM ? (nM - fm) : WGM;
        u.pm = fm + ((wgid % nig) % gsz); u.pn = (wgid % nig) / gsz; return true;
    }
    __device__ __forceinline__ void a_ready(const Unit&) const {}
    __device__ __forceinline__ void done(const Unit&) const {}
};

typedef float f32x2_cv __attribute__((ext_vector_type(2)));
typedef __bf16 bf16x2_cv __attribute__((ext_vector_type(2)));
__device__ __forceinline__ unsigned cvt_pk_bf16(float lo, float hi) { f32x2_cv f = {lo, hi}; bf16x2_cv h = __builtin_convertvector(f, bf16x2_cv); return __builtin_bit_cast(unsigned, h); }
template <class Epi, class Sched, bool ALIGN_EPI = false, bool SP2 = false>
__device__ __forceinline__ void gemm_phase(PG8_LAS unsigned char* lds, const Gemm g, const Sched& S, const Epi& E) {
    const int lda = g.lda, ldb = g.ldb;
    int tid_ = threadIdx.x; asm volatile("" : "+v"(tid_));
    const int tid = tid_, wid = __builtin_amdgcn_readfirstlane(tid >> 6), lane = tid & 63, wr = wid >> 2, wc = wid & 3, fr = lane & 15, fq = lane >> 4;
    const int K = g.K, nt = K / BK;
    unsigned voffA[2], voffB[2];
#pragma unroll
    for (int i = 0; i < 2; ++i) { int R, C; stage_rc(tid * 16 + i * 8192, R, C); const int Rb = Epi::PERM ? ((R & ~31) + perm32(R & 31)) : R;
        voffA[i] = (unsigned)(R * lda + C) * 2u; voffB[i] = (unsigned)(Rb * ldb + C) * 2u; }
    const size_t kstep = (size_t)(BK * 2);
    const size_t hstepA = (size_t)HALF * lda * 2, hstepB = (size_t)HALF * ldb * 2;
    const unsigned ldsw = (unsigned)wid * 1024u;
    const int aoff = lds_byte(wr * 64 + fr, fq * 8), boff = lds_byte(wc * 32 + fr, fq * 8);
#define PG8_SA(b, h) (((b) * 2 + (h)) * HTB)
#define PG8_SB(b, h) ((4 + (b) * 2 + (h)) * HTB)
#define PG8_STAGE(bufoff, gbase, voff) do { _Pragma("unroll") for (int _i = 0; _i < 2; ++_i) \
        __builtin_amdgcn_global_load_lds((const unsigned*)((const char*)(gbase) + (voff)[_i]), (PG8_LAS unsigned*)(lds + (bufoff) + ldsw + _i * 8192), 16, 0, 0); } while (0)
#define PG8_LDA(dst, b, h) do { _Pragma("unroll") for (int m = 0; m < 4; ++m) _Pragma("unroll") for (int k = 0; k < 2; ++k) dst[m][k] = *(const PG8_LAS bf16x8*)(lds + PG8_SA(b, h) + aoff + m * 2048 + k * 1024); } while (0)
#define PG8_LDB(dst, b, h) do { _Pragma("unroll") for (int n = 0; n < 2; ++n) _Pragma("unroll") for (int k = 0; k < 2; ++k) dst[n][k] = *(const PG8_LAS bf16x8*)(lds + PG8_SB(b, h) + boff + n * 2048 + k * 1024); } while (0)
#define PG8_MMA(ai, bj, At, Bt) do { __builtin_amdgcn_s_setprio(1); _Pragma("unroll") for (int m = 0; m < 4; ++m) _Pragma("unroll") for (int n = 0; n < 2; ++n) _Pragma("unroll") for (int k = 0; k < 2; ++k) \
        acc[ai][bj][m][n] = __builtin_amdgcn_mfma_f32_16x16x32_bf16(Bt[n][k], At[m][k], acc[ai][bj][m][n], 0, 0, 0); __builtin_amdgcn_s_setprio(0); } while (0)
#define PG8_WAIT_V(n) asm volatile("s_waitcnt vmcnt(" #n ")" ::: "memory")
#define PG8_WAIT_L(n) asm volatile("s_waitcnt lgkmcnt(" #n ")" ::: "memory")
#define PG8_BAR __builtin_amdgcn_s_barrier()
#define PG8_SCHED __builtin_amdgcn_sched_barrier(0)
    Unit cur, nxt; int ui = 0;
    if (!S.next(0, cur)) return;
    f32x4 acc[2][2][4][2];
#pragma unroll
    for (int a = 0; a < 2; ++a)
#pragma unroll
        for (int b = 0; b < 2; ++b)
#pragma unroll
            for (int m = 0; m < 4; ++m)
#pragma unroll
                for (int n = 0; n < 2; ++n) acc[a][b][m][n] = (f32x4){0.f, 0.f, 0.f, 0.f};
    bf16x8 At[4][2], B0[2][2], B1[2][2];
    const char* cA = g.abase(cur); const char* cB = g.bbase(cur);
    S.a_ready(cur);
    if constexpr (SP2) {
        PG8_STAGE(PG8_SB(0, 0), cB, voffB); PG8_STAGE(PG8_SB(0, 1), cB + hstepB, voffB); PG8_STAGE(PG8_SA(0, 0), cA, voffA); PG8_STAGE(PG8_SA(0, 1), cA + hstepA, voffA);
        if (wr == 1) PG8_BAR;
        PG8_WAIT_V(2); PG8_BAR;
        PG8_STAGE(PG8_SB(1, 0), cB + kstep, voffB); PG8_STAGE(PG8_SA(1, 0), cA + kstep, voffA); PG8_STAGE(PG8_SB(1, 1), cB + hstepB + kstep, voffB);
        PG8_WAIT_V(6); PG8_BAR;
    } else {
        PG8_STAGE(PG8_SB(0, 0), cB, voffB); PG8_STAGE(PG8_SA(0, 0), cA, voffA); PG8_STAGE(PG8_SB(0, 1), cB + hstepB, voffB); PG8_STAGE(PG8_SA(0, 1), cA + hstepA, voffA);
        if (wr == 1) PG8_BAR;
        PG8_WAIT_V(4); PG8_BAR;
        PG8_STAGE(PG8_SB(1, 0), cB + kstep, voffB); PG8_STAGE(PG8_SA(1, 0), cA + kstep, voffA); PG8_STAGE(PG8_SB(1, 1), cB + hstepB + kstep, voffB);
        PG8_WAIT_V(6); PG8_BAR;
    }
    for (;;) {
        const bool has_next = S.next(ui + 1, nxt);
        const char* nA = has_next ? g.abase(nxt) : cA; const char* nB = has_next ? g.bbase(nxt) : cB;
        for (int t = 0; t < nt; t += 2) {
            const bool last = (t == nt - 2);
            const char* a1 = cA + (size_t)(t + 1) * kstep;
            const char* a2 = last ? nA : cA + (size_t)(t + 2) * kstep; const char* b2 = last ? nB : cB + (size_t)(t + 2) * kstep;
            const char* a3 = a2 + kstep; const char* b3 = b2 + kstep;
            if (last && has_next) S.a_ready(nxt);
            if constexpr (SP2) {
            PG8_LDB(B0, 0, 0); PG8_LDB(B1, 0, 1); PG8_SCHED; PG8_LDA(At, 0, 0); PG8_STAGE(PG8_SA(1, 1), a1 + hstepA, voffA);
            PG8_WAIT_V(8); PG8_WAIT_L(0); PG8_BAR; PG8_MMA(0, 0, At, B0); PG8_MMA(0, 1, At, B1); PG8_BAR; PG8_SCHED;
            PG8_LDA(At, 0, 1); PG8_STAGE(PG8_SB(0, 0), b2, voffB); PG8_STAGE(PG8_SB(0, 1), b2 + hstepB, voffB); PG8_STAGE(PG8_SA(0, 0), a2, voffA);
            PG8_WAIT_V(8); PG8_WAIT_L(0); PG8_BAR; PG8_MMA(1, 0, At, B0); PG8_MMA(1, 1, At, B1); PG8_BAR; PG8_SCHED;
            PG8_LDB(B0, 1, 0); PG8_LDB(B1, 1, 1); PG8_SCHED; PG8_LDA(At, 1, 0); PG8_STAGE(PG8_SA(0, 1), a2 + hstepA, voffA);
            PG8_WAIT_V(8); PG8_WAIT_L(0); PG8_BAR; PG8_MMA(0, 0, At, B0); PG8_MMA(0, 1, At, B1); PG8_BAR; PG8_SCHED;
            PG8_LDA(At, 1, 1); PG8_STAGE(PG8_SB(1, 0), b3, voffB); PG8_STAGE(PG8_SB(1, 1), b3 + hstepB, voffB); PG8_STAGE(PG8_SA(1, 0), a3, voffA);
            PG8_WAIT_V(8); PG8_WAIT_L(0); PG8_BAR; PG8_MMA(1, 0, At, B0); PG8_MMA(1, 1, At, B1); PG8_BAR; PG8_SCHED;
            } else {
            PG8_LDB(B0, 0, 0); PG8_SCHED; PG8_LDA(At, 0, 0); PG8_STAGE(PG8_SA(1, 1), a1 + hstepA, voffA);
            PG8_WAIT_L(8); PG8_BAR; PG8_WAIT_L(0); PG8_MMA(0, 0, At, B0); PG8_BAR; PG8_SCHED;
            PG8_LDB(B1, 0, 1); PG8_STAGE(PG8_SB(0, 0), b2, voffB);
            PG8_BAR; PG8_WAIT_L(0); PG8_MMA(0, 1, At, B1); PG8_BAR;
            PG8_LDA(At, 0, 1); PG8_STAGE(PG8_SA(0, 0), a2, voffA);
            PG8_BAR; PG8_WAIT_L(0); PG8_MMA(1, 0, At, B0); PG8_BAR; PG8_SCHED;
            PG8_STAGE(PG8_SB(0, 1), b2 + hstepB, voffB);
            PG8_WAIT_V(6); PG8_BAR; PG8_MMA(1, 1, At, B1); PG8_BAR;
            PG8_LDB(B0, 1, 0); PG8_SCHED; PG8_LDA(At, 1, 0); PG8_STAGE(PG8_SA(0, 1), a2 + hstepA, voffA);
            PG8_WAIT_L(8); PG8_BAR; PG8_WAIT_L(0); PG8_MMA(0, 0, At, B0); PG8_BAR; PG8_SCHED;
            PG8_LDB(B1, 1, 1); PG8_STAGE(PG8_SB(1, 0), b3, voffB);
            PG8_BAR; PG8_WAIT_L(0); PG8_MMA(0, 1, At, B1); PG8_BAR;
            PG8_LDA(At, 1, 1); PG8_STAGE(PG8_SA(1, 0), a3, voffA);
            PG8_BAR; PG8_WAIT_L(0); PG8_MMA(1, 0, At, B0); PG8_BAR; PG8_SCHED;
            PG8_STAGE(PG8_SB(1, 1), b3 + hstepB, voffB);
            PG8_WAIT_V(6); PG8_BAR; PG8_MMA(1, 1, At, B1); PG8_BAR;
            }
        }
        if constexpr (ALIGN_EPI) { if (wr == 0) PG8_BAR; }
        if constexpr (!Epi::AFTER_DRAIN) { E(acc, cur, wr, wc, fr, fq); S.done(cur); }
        if (!has_next) break;
#pragma unroll
        for (int a = 0; a < 2; ++a)
#pragma unroll
            for (int b = 0; b < 2; ++b)
#pragma unroll
                for (int m = 0; m < 4; ++m)
#pragma unroll
                    for (int n = 0; n < 2; ++n) acc[a][b][m][n] = (f32x4){0.f, 0.f, 0.f, 0.f};
        cur = nxt; cA = nA; cB = nB; ++ui;
        if constexpr (ALIGN_EPI) { if (wr == 1) PG8_BAR; }
    }
    PG8_WAIT_V(0);
    if constexpr (!ALIGN_EPI) { if (wr == 0) PG8_BAR; }
    PG8_BAR;
    if constexpr (Epi::AFTER_DRAIN) { E.fused(acc, cur, wr, wc, fr, fq, lds, wid, lane); S.done(cur); }
#undef PG8_SA
#undef PG8_SB
#undef PG8_STAGE
#undef PG8_LDA
#undef PG8_LDB
#undef PG8_MMA
#undef PG8_WAIT_V
#undef PG8_WAIT_L
#undef PG8_BAR
#undef PG8_SCHED
}

template <class Fn> struct EpiF {
    static constexpr bool PERM = true, AFTER_DRAIN = false;
    Fn f;
    __device__ __forceinline__ void operator()(const f32x4 (&acc)[2][2][4][2], const Unit& u, int wr, int wc, int fr, int fq) const {
        const int row0 = u.pm * BM + wr * 64 + fr, ct0 = wc * 32 + 8 * fq;
#pragma unroll
        for (int ai = 0; ai < 2; ++ai)
#pragma unroll
            for (int m = 0; m < 4; ++m)
#pragma unroll
                for (int bj = 0; bj < 2; ++bj) f(row0 + ai * HALF + m * 16, u.pn, ct0 + bj * HALF, acc[ai][bj][m][0], acc[ai][bj][m][1]);
    }
};
}

constexpr int NWAVES = 8, NTHREADS = 512;
constexpr int DM = 1024, MI = 2048, NSRC = 12296, PLE = 256;
constexpr int TP = 4096, TS = 32, BP = 4, BS = 32;
constexpr int NTOK_P = BP * TP, NTOK_S = BS * TS, NTOK = NTOK_P + NTOK_S;
constexpr int MH = 4, MHD = 512, HH = 8, HE = 128;
constexpr float EPS = 1e-6f;
constexpr size_t O_Y = 0, O_CONVP = 17825792, O_CP = 17850368, O_NP = 22044672, O_MP = 22052864, O_SP = 22052880,
                 O_CONVS = 22577168, O_CS = 22773776, O_NS = 56328208, O_MS = 56393744, O_SS = 56393872, O_END = 60588176;
constexpr size_t MiB = 1u << 20;
constexpr size_t WS_CTL = 0, CTL_ZERO_BYTES = 64 * 1024;
constexpr size_t WS_GATES = 1 * MiB, WS_PB = 2 * MiB;
constexpr size_t WS_WIN = 12 * MiB, WS_WQK = 36 * MiB + 512 * 1024, WS_WBRM = WS_WQK + 4 * MiB, WS_WBRH = WS_WBRM + 4 * MiB, WS_WOUT = WS_WBRH + 2 * MiB, WS_WPG = WS_WOUT + 2 * MiB, WS_WPLE = WS_WPG + 2 * MiB;
constexpr size_t WS_XN = 52 * MiB, WS_U = 86 * MiB, WS_V = 154 * MiB, WS_QH = 222 * MiB, WS_FH = 256 * MiB, WS_IH = 290 * MiB, WS_C = 324 * MiB, WS_K = 392 * MiB, WS_HO = 460 * MiB;
constexpr size_t WS_END = 510 * MiB;
constexpr size_t WS_Q = WS_U, WS_ZP = WS_V, WS_GHP = WS_QH, WS_GAP = WS_FH, WS_GBP = WS_IH, WS_HMN = WS_U, WS_OH = WS_K, WS_YA = WS_K + 34 * MiB, WS_Y = WS_C, WS_H1B = WS_C + 34 * MiB, WS_G2 = WS_HO;
constexpr int CW_BAR = 4096;
constexpr int RING_OFF = 0, RING_BYTES = 131072, LDSCTL_OFF = RING_BYTES, MISC_OFF = LDSCTL_OFF + 320, LDS_BYTES = 147456;

#define GAS __attribute__((address_space(1)))
#define LAS __attribute__((address_space(3)))
typedef unsigned short bf16;
typedef unsigned v4u __attribute__((ext_vector_type(4)));
typedef unsigned v2u __attribute__((ext_vector_type(2)));
typedef float f32x4 __attribute__((ext_vector_type(4)));
typedef GAS unsigned gu32;
#define RLX_AGENT __ATOMIC_RELAXED, __HIP_MEMORY_SCOPE_AGENT
#define LDS_WAIT() asm volatile("s_waitcnt lgkmcnt(0)" ::: "memory")
#define VM_WAIT() asm volatile("s_waitcnt vmcnt(0)" ::: "memory")
__device__ __forceinline__ unsigned f2bf(float f) { unsigned u = __builtin_bit_cast(unsigned, f); return (u + 0x7fffu + ((u >> 16) & 1u)) >> 16; }
__device__ __forceinline__ unsigned pk2(float lo, float hi) { return f2bf(lo) | (f2bf(hi) << 16); }
__device__ __forceinline__ float bflo(unsigned w) { return __builtin_bit_cast(float, w << 16); }
__device__ __forceinline__ float bfhi(unsigned w) { return __builtin_bit_cast(float, w & 0xffff0000u); }
__device__ __forceinline__ float bf2f(bf16 h) { return __builtin_bit_cast(float, (unsigned)h << 16); }
__device__ __forceinline__ void unpack8(v4u w, float (&o)[8]) { o[0] = bflo(w.x); o[1] = bfhi(w.x); o[2] = bflo(w.y); o[3] = bfhi(w.y); o[4] = bflo(w.z); o[5] = bfhi(w.z); o[6] = bflo(w.w); o[7] = bfhi(w.w); }
__device__ __forceinline__ v4u pack8(const float (&o)[8]) { v4u w; w.x = pk2(o[0], o[1]); w.y = pk2(o[2], o[3]); w.z = pk2(o[4], o[5]); w.w = pk2(o[6], o[7]); return w; }
__device__ __forceinline__ float sigmoidf_(float x) { return __builtin_amdgcn_rcpf(1.0f + __expf(-x)); }
__device__ __forceinline__ float siluf_(float x) { return x * sigmoidf_(x); }
__device__ __forceinline__ float logsigmoidf_(float x) { return fminf(x, 0.f) - log1pf(__expf(-fabsf(x))); }

#define XB_TMO      128
#define XB_XCNT(j)  (256  + 64 * (j))
#define XB_XSUB(j)  (1280 + 64 * (j))
#define XB_XGEN(j)  (2304 + 64 * (j))
#define XB_TOP      3328
#define XB_TOPGEN   3392
#define XCD_BAR_WORDS 3456
#define XB_SPIN_CAP (1u << 18)
__device__ __forceinline__ unsigned xb_ld(unsigned* p)              { return __hip_atomic_load(p, __ATOMIC_RELAXED, __HIP_MEMORY_SCOPE_AGENT); }
__device__ __forceinline__ unsigned xb_add(unsigned* p, unsigned v) { return __hip_atomic_fetch_add(p, v, __ATOMIC_RELAXED, __HIP_MEMORY_SCOPE_AGENT); }
__device__ __forceinline__ unsigned xb_xcc_id() { return (unsigned)__builtin_amdgcn_s_getreg((3 << 11) | 20) & 0xFu; }
#define XB_SPIN(cond, bar) do { unsigned _sp = 0; while (cond) { __builtin_amdgcn_s_sleep(1); \
    if ((++_sp & 255u) == 0u) { if (xb_ld(&(bar)[XB_TMO])) break; if (_sp > XB_SPIN_CAP) { atomicAdd(&(bar)[XB_TMO], 1u); break; } } } } while (0)
struct XcdBarrier { unsigned* bar; unsigned x; volatile LAS unsigned* st; };
__device__ __forceinline__ XcdBarrier xcd_barrier_post(unsigned* bar, volatile LAS unsigned* st) {
    XcdBarrier b; b.bar = bar; b.x = xb_xcc_id(); b.st = st;
    if (threadIdx.x == 0) (void)xb_add(&bar[XB_XCNT(b.x)], 1u);
    return b;
}
__device__ __forceinline__ void xcd_barrier_complete(unsigned* bar, unsigned x, unsigned& nloc, unsigned& nx) {
    const unsigned G = gridDim.x * gridDim.y * gridDim.z;
    unsigned sum, cnt, mine, sp = 0u;
    for (;;) {
        sum = 0u; cnt = 0u; mine = 0u;
#pragma unroll
        for (unsigned j = 0; j < 16; ++j) { const unsigned c = xb_ld(&bar[XB_XCNT(j)]); sum += c; cnt += (c > 0u) ? 1u : 0u; mine = (j == x) ? c : mine; }
        if (sum == G) break;
        __builtin_amdgcn_s_sleep(1);
        if ((++sp & 255u) == 0u) { if (xb_ld(&bar[XB_TMO])) break; if (sp > XB_SPIN_CAP) { atomicAdd(&bar[XB_TMO], 1u); break; } }
    }
    nloc = mine > 0u ? mine : 1u; nx = cnt > 0u ? cnt : 1u;
}
__device__ __forceinline__ void xcd_barrier(const XcdBarrier& b) {
    asm volatile("s_waitcnt vmcnt(0)" ::: "memory");
    __syncthreads();
    if (threadIdx.x == 0) {
        unsigned* bar = b.bar;
        __builtin_amdgcn_s_waitcnt(0);
        unsigned nloc = b.st[0], nx = b.st[1];
        if (nloc == 0u) { xcd_barrier_complete(bar, b.x, nloc, nx); b.st[0] = nloc; b.st[1] = nx; }
        const unsigned old = xb_add(&bar[XB_XSUB(b.x)], 1u);
        const unsigned gen = old / nloc;
        if (old + 1u == (gen + 1u) * nloc) {
            __builtin_amdgcn_fence(__ATOMIC_RELEASE, "agent");
            asm volatile("s_waitcnt vmcnt(0)" ::: "memory");
            const unsigned og = xb_add(&bar[XB_TOP], 1u);
            const unsigned tg = og / nx;
            if (og + 1u == (tg + 1u) * nx) xb_add(&bar[XB_TOPGEN], 1u);
            else XB_SPIN(xb_ld(&bar[XB_TOPGEN]) == tg, bar);
            __builtin_amdgcn_fence(__ATOMIC_ACQUIRE, "agent");
            xb_add(&bar[XB_XGEN(b.x)], 1u);
            asm volatile("s_waitcnt vmcnt(0)" ::: "memory");
        } else {
            XB_SPIN(xb_ld(&bar[XB_XGEN(b.x)]) == gen, bar);
            __builtin_amdgcn_fence(__ATOMIC_ACQUIRE, "agent");
            asm volatile("s_waitcnt vmcnt(0)" ::: "memory");
        }
    }
    __syncthreads();
}

__device__ __forceinline__ void local_fence() {
    asm volatile("s_waitcnt vmcnt(0)" ::: "memory"); __syncthreads();
    if (threadIdx.x == 0) { __builtin_amdgcn_fence(__ATOMIC_ACQUIRE, "agent"); asm volatile("s_waitcnt vmcnt(0)" ::: "memory"); }
    __syncthreads();
}
struct Args { const float* in[27]; float* out; unsigned char* ws; int ph_lo, ph_hi, li, pad; };
enum { I_XP = 0, I_XS, I_SCONV, I_SC, I_SN, I_SM, I_SH, I_PP, I_PS, I_NORMG, I_WIN, I_BIG, I_BFG, I_CONVW, I_CONVB, I_WQM, I_WKM, I_MNORMG, I_MSKIP, I_WBRM, I_LB, I_HNORMG, I_WBRH, I_WOUT, I_WPLE, I_WPG, I_FINALG };
struct Frame { LAS unsigned char* lds; int tid, lane, wave, vcu, G; };

__device__ __forceinline__ float wave_sum(float v) {
#pragma unroll
    for (int o = 1; o < 64; o <<= 1) v += __shfl_xor(v, o);
    return v;
}
__device__ __forceinline__ const float* xrow(const Args& a, int m) { return m < NTOK_P ? a.in[I_XP] + (size_t)m * DM : a.in[I_XS] + (size_t)(m - NTOK_P) * DM; }

__device__ __forceinline__ void p0_transpose_item(const float* W, int pitch, int K, int ncols, bf16* WT, int row_off, LAS float* scr, int item, int lane) {
    const int nblk = ncols / 32, kb = item / nblk, nb = item % nblk, k0 = 64 * kb, n0 = 32 * nb;
#pragma unroll 8
    for (int i = 0; i < 32; ++i) { const int kk = 2 * i + (lane >> 5); scr[kk * 33 + (lane & 31)] = W[(size_t)(k0 + kk) * pitch + n0 + (lane & 31)]; }
    LDS_WAIT(); asm volatile("" ::: "memory");
    const int c = lane & 7;
#pragma unroll
    for (int j = 0; j < 4; ++j) { const int n = (lane >> 3) + 8 * j; const LAS float* s = scr + (8 * c) * 33 + n;
        v4u o; o.x = pk2(s[0 * 33], s[1 * 33]); o.y = pk2(s[2 * 33], s[3 * 33]); o.z = pk2(s[4 * 33], s[5 * 33]); o.w = pk2(s[6 * 33], s[7 * 33]);
        *(GAS v4u*)(WT + (size_t)(row_off + n0 + n) * K + k0 + 8 * c) = o; }
    LDS_WAIT(); asm volatile("" ::: "memory");
}
struct Seg { const float* W; int pitch, K, ncols; bf16* WT; int row_off, items; };
__device__ __forceinline__ Seg seg_info(int s, const Args& a) {
    Seg g; unsigned char* ws = a.ws;
    switch (s) {
    case 0: g = Seg{a.in[I_WIN] + 0,    NSRC, 1024, 4096, (bf16*)(ws + WS_WIN), 0,    0}; break;
    case 1: g = Seg{a.in[I_WIN] + 6152, NSRC, 1024, 3072, (bf16*)(ws + WS_WIN), 4096, 0}; break;
    case 2: g = Seg{a.in[I_WIN] + 4096, NSRC, 1024, 2048, (bf16*)(ws + WS_WIN), 7424, 0}; break;
    case 3: g = Seg{a.in[I_WIN] + 9224, NSRC, 1024, 3072, (bf16*)(ws + WS_WIN), 9472, 0}; break;
    case 4: case 5: case 6: case 7: g = Seg{a.in[I_WQM] + (size_t)(s - 4) * 262144, 512, 512, 512, (bf16*)(ws + WS_WQK), (s - 4) * 512, 0}; break;
    case 8: case 9: case 10: case 11: g = Seg{a.in[I_WKM] + (size_t)(s - 8) * 262144, 512, 512, 512, (bf16*)(ws + WS_WQK), 2048 + (s - 8) * 512, 0}; break;
    case 12: g = Seg{a.in[I_WBRM], 1024, 2048, 1024, (bf16*)(ws + WS_WBRM), 0, 0}; break;
    case 13: g = Seg{a.in[I_WBRH], 1024, 1024, 1024, (bf16*)(ws + WS_WBRH), 0, 0}; break;
    case 14: g = Seg{a.in[I_WOUT], 1024, 1024, 1024, (bf16*)(ws + WS_WOUT), 0, 0}; break;
    case 15: g = Seg{a.in[I_WPG],  1024, 1024, 1024, (bf16*)(ws + WS_WPG),  0, 0}; break;
    case 16: g = Seg{a.in[I_WPLE], 1024, 256,  1024, (bf16*)(ws + WS_WPLE), 0, 0}; break;
    default: g = Seg{a.in[I_WIN] + 6144, NSRC, 1024, 32,   (bf16*)(ws + WS_WIN), 7168, 0}; break;
    }
    g.items = (g.K / 64) * (g.ncols / 32);
    return g;
}
__device__ __forceinline__ void p0_pb(Frame& F, const Args& a, int i0, int istride) {
    bf16* PB = (bf16*)(a.ws + WS_PB);
    for (int i = i0; i < NTOK * 32; i += 4 * istride) {
        f32x4 p0[4], p1[4];
#pragma unroll
        for (int k = 0; k < 4; ++k) { const int ii = i + k * istride < NTOK * 32 ? i + k * istride : i; const int m = ii >> 5, c8 = (ii & 31) * 8;
            const float* src = (m < NTOK_P ? a.in[I_PP] + (size_t)m * PLE : a.in[I_PS] + (size_t)(m - NTOK_P) * PLE) + c8;
            p0[k] = *(const GAS f32x4*)src; p1[k] = *(const GAS f32x4*)(src + 4); }
#pragma unroll
        for (int k = 0; k < 4; ++k) { const int ii = i + k * istride; if (ii < NTOK * 32) { const int m = ii >> 5, c8 = (ii & 31) * 8;
            v4u w; w.x = pk2(p0[k].x, p0[k].y); w.y = pk2(p0[k].z, p0[k].w); w.z = pk2(p1[k].x, p1[k].y); w.w = pk2(p1[k].z, p1[k].w);
            *(GAS v4u*)(PB + (size_t)m * PLE + c8) = w; } }
    }
}
__device__ __forceinline__ void p0_prep(Frame& F, const Args& a) {
    LAS float* scr = (LAS float*)(F.lds + RING_OFF + F.wave * 16384);
    const int gw = F.vcu * NWAVES + F.wave, NGW = F.G * NWAVES;
    {
        int s = 0, base = 0; Seg g = seg_info(0, a);
        for (int f = gw; ; f += NGW) {
            while (s < 18 && f >= base + g.items) { base += g.items; ++s; if (s < 18) g = seg_info(s, a); }
            if (s >= 18) break;
            p0_transpose_item(g.W, g.pitch, g.K, g.ncols, g.WT, g.row_off, scr, f - base, F.lane);
        }
    }
    bf16* XN = (bf16*)(a.ws + WS_XN);
    const float* ng = a.in[I_NORMG];
    for (int m = gw; m < NTOK; m += NGW) {
        const GAS f32x4* xr = (const GAS f32x4*)xrow(a, m) + F.lane;
        f32x4 v[4]; float ss = 0.f;
#pragma unroll
        for (int j = 0; j < 4; ++j) { v[j] = xr[64 * j]; ss += (v[j].x * v[j].x + v[j].y * v[j].y) + (v[j].z * v[j].z + v[j].w * v[j].w); }
        const float rstd = 1.0f / sqrtf(wave_sum(ss) * (1.f / DM) + EPS);
        GAS v2u* o8 = (GAS v2u*)(XN + (size_t)m * DM) + F.lane;
#pragma unroll
        for (int j = 0; j < 4; ++j) {
            const f32x4 gg = *(const GAS f32x4*)(ng + 4 * F.lane + 256 * j);
            v[j] = v[j] * rstd * gg;
            v2u w; w.x = pk2(v[j].x, v[j].y); w.y = pk2(v[j].z, v[j].w); o8[64 * j] = w;
        }
    }
    if (F.G != 256) p0_pb(F, a, F.vcu * NTHREADS + F.tid, F.G * NTHREADS);
}

__device__ __forceinline__ void p2_conv(Frame& F, const Args& a) {
    const bf16* U = (const bf16*)(a.ws + WS_U); bf16* C = (bf16*)(a.ws + WS_C);
    const float* cw = a.in[I_CONVW]; const float* cb = a.in[I_CONVB]; const float* sconv = a.in[I_SCONV];
    const int ch = (F.tid & 255) * 8;
    float wv[4][8], bv[8];
#pragma unroll
    for (int j = 0; j < 4; ++j) { const f32x4 w0 = *(const GAS f32x4*)(cw + (size_t)j * MI + ch), w1 = *(const GAS f32x4*)(cw + (size_t)j * MI + ch + 4);
        wv[j][0] = w0.x; wv[j][1] = w0.y; wv[j][2] = w0.z; wv[j][3] = w0.w; wv[j][4] = w1.x; wv[j][5] = w1.y; wv[j][6] = w1.z; wv[j][7] = w1.w; }
    { const f32x4 b0 = *(const GAS f32x4*)(cb + ch), b1 = *(const GAS f32x4*)(cb + ch + 4); bv[0] = b0.x; bv[1] = b0.y; bv[2] = b0.z; bv[3] = b0.w; bv[4] = b1.x; bv[5] = b1.y; bv[6] = b1.z; bv[7] = b1.w; }
    const int i0 = F.vcu * NTHREADS + F.tid, istr = F.G * NTHREADS, iend = (NTOK / 4) * 256;
    v4u raw[7], nxt[7];
#define CV_LOAD(dst, ii) do { const int tk_ = ((ii) >> 8) * 4; _Pragma("unroll") for (int j = 0; j < 7; ++j) { int tr_ = tk_ - 3 + j; tr_ = tr_ < 0 ? 0 : tr_; dst[j] = *(const GAS v4u*)(U + (size_t)tr_ * MI + ch); } } while (0)
    if (i0 < iend) CV_LOAD(raw, i0);
    for (int i = i0; i < iend; i += istr) {
        { const int in_ = (i + istr < iend) ? i + istr : i; CV_LOAD(nxt, in_); }
        const int tok = (i >> 8) * 4;
        const bool smp = tok >= NTOK_P;
        const int b = smp ? (tok - NTOK_P) >> 5 : tok >> 12, t = smp ? (tok - NTOK_P) & 31 : tok & 4095;
        float u[7][8];
#pragma unroll
        for (int j = 0; j < 7; ++j) {
            unpack8(raw[j], u[j]);
            if (j < 3 && t == 0) {
                if (smp) { const float* sp = sconv + (size_t)(b * 3 + j) * MI + ch; const f32x4 s0 = *(const GAS f32x4*)sp, s1 = *(const GAS f32x4*)(sp + 4);
                    u[j][0] = s0.x; u[j][1] = s0.y; u[j][2] = s0.z; u[j][3] = s0.w; u[j][4] = s1.x; u[j][5] = s1.y; u[j][6] = s1.z; u[j][7] = s1.w; }
                else {
#pragma unroll
                    for (int e = 0; e < 8; ++e) u[j][e] = 0.f; }
            }
        }
        const int tl = smp ? TS : TP;
#pragma unroll
        for (int q = 0; q < 4; ++q) {
            float acc[8];
#pragma unroll
            for (int e = 0; e < 8; ++e) acc[e] = siluf_(bv[e] + u[q][e] * wv[0][e] + u[q + 1][e] * wv[1][e] + u[q + 2][e] * wv[2][e] + u[q + 3][e] * wv[3][e]);
            *(GAS v4u*)(C + (size_t)(tok + q) * MI + ch) = pack8(acc);
            if (t + q >= tl - 3) {
                float* dst = a.out + (smp ? O_CONVS : O_CONVP) + (size_t)(b * 3 + (t + q - (tl - 3))) * MI + ch;
                *(GAS f32x4*)dst = (f32x4){u[q + 3][0], u[q + 3][1], u[q + 3][2], u[q + 3][3]}; *(GAS f32x4*)(dst + 4) = (f32x4){u[q + 3][4], u[q + 3][5], u[q + 3][6], u[q + 3][7]};
            }
        }
#pragma unroll
        for (int j = 0; j < 7; ++j) raw[j] = nxt[j];
    }
#undef CV_LOAD
}

typedef short s16x4 __attribute__((ext_vector_type(4)));
typedef short bf16x8 __attribute__((ext_vector_type(8)));
typedef float f32x16 __attribute__((ext_vector_type(16)));
typedef float f32x2 __attribute__((ext_vector_type(2)));
typedef __bf16 bf16x2v __attribute__((ext_vector_type(2)));
#define MFMA32(a, b, c) __builtin_amdgcn_mfma_f32_32x32x16_bf16((a), (b), (c), 0, 0, 0)
__device__ __forceinline__ unsigned pkc(float lo, float hi) { f32x2 f = {lo, hi}; bf16x2v h = __builtin_convertvector(f, bf16x2v); return __builtin_bit_cast(unsigned, h); }
__device__ __forceinline__ int crow(int reg, int hh) { return (reg & 3) + 8 * (reg >> 2) + 4 * hh; }
__device__ __forceinline__ bf16x8 pack_step(const f32x16& x, int s) {
    v4u p; p.x = pkc(x[8 * s], x[8 * s + 1]); p.y = pkc(x[8 * s + 2], x[8 * s + 3]); p.z = pkc(x[8 * s + 4], x[8 * s + 5]); p.w = pkc(x[8 * s + 6], x[8 * s + 7]);
    return __builtin_bit_cast(bf16x8, p);
}
__device__ __forceinline__ s16x4 trr(LAS unsigned char* p) { return __builtin_amdgcn_ds_read_tr16_b64_v4i16((LAS s16x4*)p); }
__device__ __forceinline__ bf16x8 tr_frag(LAS unsigned char* img, int pitch, int k0, int c0, int lane) {
    const int hh = lane >> 5, blk = (lane >> 4) & 1, qq = (lane & 15) >> 2, pp = lane & 3;
    LAS unsigned char* p = img + (k0 + 8 * hh + qq) * pitch + (c0 + 16 * blk + 4 * pp) * 2;
    const s16x4 lo = trr(p), hi = trr(p + 4 * pitch);
    return __builtin_shufflevector(lo, hi, 0, 1, 2, 3, 4, 5, 6, 7);
}

constexpr size_t WS_HA = 498 * MiB + 512 * 1024, WS_EGL = 507 * MiB;
constexpr size_t WS_PT = 494 * MiB, WS_SC = 10 * MiB + 512 * 1024, WS_DENI = 11 * MiB + 256 * 1024;

template <int CTRL, int ROWMASK> __device__ __forceinline__ float dpp_f(float ident, float v) {
    return __builtin_bit_cast(float, __builtin_amdgcn_update_dpp(__builtin_bit_cast(int, ident), __builtin_bit_cast(int, v), CTRL, ROWMASK, 0xF, false)); }
__device__ __forceinline__ float wave_scan_add(float v) {
    v += dpp_f<0x111, 0xF>(0.f, v); v += dpp_f<0x112, 0xF>(0.f, v); v += dpp_f<0x114, 0xF>(0.f, v); v += dpp_f<0x118, 0xF>(0.f, v);
    v += dpp_f<0x142, 0xA>(0.f, v); v += dpp_f<0x143, 0xC>(0.f, v); return v; }
__device__ __forceinline__ float wave_scan_max(float v) {
    const float NI = -3.0e38f;
    v = fmaxf(v, dpp_f<0x111, 0xF>(NI, v)); v = fmaxf(v, dpp_f<0x112, 0xF>(NI, v)); v = fmaxf(v, dpp_f<0x114, 0xF>(NI, v)); v = fmaxf(v, dpp_f<0x118, 0xF>(NI, v));
    v = fmaxf(v, dpp_f<0x142, 0xA>(NI, v)); v = fmaxf(v, dpp_f<0x143, 0xC>(NI, v)); return v; }
__device__ __forceinline__ void p2_scan(Frame& F, const Args& a) {
    const int lane = F.lane, w = F.wave;
    const float* GATES = (const float*)(a.ws + WS_GATES); float* SC = (float*)(a.ws + WS_SC);
    LAS float* red = (LAS float*)(F.lds + RING_OFF);
    const float NEG = -3.0e38f;
    for (int sh = F.vcu; sh < BP * MH; sh += F.G) {
        const int b = sh >> 2, h = sh & 3, tokw = b * TP + 512 * w;
        float lf[8], ig[8], bl[8], lm[8];
#pragma unroll
        for (int j = 0; j < 8; ++j) { const size_t tk = (size_t)(tokw + 64 * j + lane) * 8; lf[j] = GATES[tk + 4 + h]; ig[j] = GATES[tk + h]; }
        float base = 0.f, run = NEG;
#pragma unroll
        for (int j = 0; j < 8; ++j) {
            const float bg = base + wave_scan_add(lf[j]);
            const float mr = fmaxf(run, wave_scan_max(ig[j] - bg));
            bl[j] = bg; lm[j] = mr;
            base = __builtin_bit_cast(float, __builtin_amdgcn_readlane(__builtin_bit_cast(int, bg), 63)); run = __builtin_bit_cast(float, __builtin_amdgcn_readlane(__builtin_bit_cast(int, mr), 63));
        }
        __syncthreads();
        if (lane == 0) { red[2 * w] = base; red[2 * w + 1] = run; }
        __syncthreads();
        float cb = 0.f, cr = 0.f;
        for (int i = 0; i < w; ++i) { cr = fmaxf(cr, red[2 * i + 1] - cb); cb += red[2 * i]; }
#pragma unroll
        for (int j = 0; j < 8; ++j) { const size_t tk = (size_t)(tokw + 64 * j + lane) * 8; const float bg = cb + bl[j], mr = fmaxf(cr, lm[j] - cb);
            SC[tk + h * 2] = bg; SC[tk + h * 2 + 1] = bg + mr; }
    }
    const int gw = (F.vcu - BP * MH) * NWAVES + w, NGW = F.G * NWAVES;
    for (int sh = gw < 0 ? gw + NGW : gw; sh < BS * MH; sh += NGW) {
        const int b = sh >> 2, h = sh & 3, tok0 = NTOK_P + b * TS;
        const float minit = a.in[I_SM][b * MH + h];
        const int t = lane & 31; const float* G = GATES + (size_t)(tok0 + t) * 8;
        const float lf = G[4 + h], ig = G[h];
        float incl = lf;
#pragma unroll
        for (int o = 1; o < 32; o <<= 1) { const float v = __shfl_up(incl, o); if (t >= o) incl += v; }
        float pm = ig - incl;
#pragma unroll
        for (int o = 1; o < 32; o <<= 1) { const float v = __shfl_up(pm, o); if (t >= o) pm = fmaxf(pm, v); }
        if (lane < 32) { float* o = SC + (size_t)(tok0 + t) * 8 + h * 2; o[0] = incl; o[1] = incl + fmaxf(minit, pm); }
    }
}

template <int KD, bool DECAY>
__device__ __forceinline__ void score_tiles(Frame& F, const bf16* Qb, const bf16* Kb, int ld, int nunits, int nprompt, int nh, bf16* OUT, const float* GATES, const float* SC, int u0, int ustride) {
    constexpr int QP = KD * 2 + 16, NPC = KD / 128;
    constexpr int L_Q = 0, L_K = 32 * QP, L_RED = 2 * 32 * QP, L_TAB = L_RED + 32768;
    const int tid = F.tid, lane = F.lane, w = F.wave, r = lane & 31, hh = lane >> 5;
    LAS unsigned char* lds = F.lds + RING_OFF;
    LAS float* tab = (LAS float*)(lds + L_TAB);
    v4u rq[NPC], rk[NPC]; float t0 = 0.f, t1 = 0.f;
    auto decode = [&](int u, int& hcol, int& tok0, int& h) {
        if (u < nprompt) { const int bh = u >> 7, c = u & 127; h = bh % nh; tok0 = (bh / nh) * TP + c * 32; }
        else { const int bh = u - nprompt; h = bh % nh; tok0 = NTOK_P + (bh / nh) * TS; }
        hcol = h * KD; };
#define ST_LOAD(u) do { int hcol_, tok0_, h_; decode((u), hcol_, tok0_, h_); \
        _Pragma("unroll") for (int i = 0; i < NPC; ++i) { const int piece = tid + 512 * i, row = piece / (KD / 8), c16 = piece % (KD / 8); const size_t off = (size_t)(tok0_ + row) * ld + hcol_ + c16 * 8; \
            rq[i] = *(const GAS v4u*)(Qb + off); rk[i] = *(const GAS v4u*)(Kb + off); } \
        if (DECAY && tid < 32) { const size_t tk = (size_t)(tok0_ + tid) * 8; const float Bg = SC[tk + h_ * 2], m = SC[tk + h_ * 2 + 1], ig = GATES[tk + h_]; t0 = Bg - m; t1 = ig - Bg; } } while (0)
    int u = u0;
    if (u < nunits) ST_LOAD(u);
    for (; u < nunits; u += ustride) {
#pragma unroll
        for (int i = 0; i < NPC; ++i) { const int piece = tid + 512 * i, row = piece / (KD / 8), c16 = piece % (KD / 8);
            *(LAS v4u*)(lds + L_Q + row * QP + c16 * 16) = rq[i]; *(LAS v4u*)(lds + L_K + row * QP + c16 * 16) = rk[i]; }
        if (DECAY && tid < 32) { tab[tid] = t0; tab[32 + tid] = t1; }
        __syncthreads();
        if (u + ustride < nunits) ST_LOAD(u + ustride);
        f32x16 acc;
#pragma unroll
        for (int i = 0; i < 16; ++i) acc[i] = 0.f;
#pragma unroll
        for (int ks = 0; ks < KD / 128; ++ks) {
            const int d0 = (KD / 8) * w + 16 * ks + 8 * hh;
            const bf16x8 af = *(const LAS bf16x8*)(lds + L_Q + r * QP + d0 * 2), bfr = *(const LAS bf16x8*)(lds + L_K + r * QP + d0 * 2);
            acc = MFMA32(af, bfr, acc);
        }
        { LAS float* red = (LAS float*)(lds + L_RED) + w * 1024;
#pragma unroll
          for (int g = 0; g < 16; ++g) red[g * 64 + lane] = acc[g]; }
        __syncthreads();
#pragma unroll
        for (int gg = 0; gg < 2; ++gg) {
            const int g = 2 * w + gg; float v = 0.f;
#pragma unroll
            for (int k = 0; k < 8; ++k) v += ((const LAS float*)(lds + L_RED))[k * 1024 + g * 64 + lane];
            const int t = crow(g, hh);
            if (DECAY) v *= __expf(tab[t] + tab[32 + r]);
            OUT[(size_t)u * 1024 + t * 32 + r] = (bf16)(pkc((r <= t) ? v : 0.f, 0.f) & 0xffffu);
        }
        __syncthreads();
    }
#undef ST_LOAD
}
__device__ __forceinline__ void p4_atiles(Frame& F, const Args& a, int u0, int ustride) {
    score_tiles<128, false>(F, (const bf16*)(a.ws + WS_QH), (const bf16*)(a.ws + WS_FH), DM, 4352, 4096, HH, (bf16*)(a.ws + WS_HA), nullptr, nullptr, u0, ustride);
}
__device__ __forceinline__ void p4_tiles(Frame& F, const Args& a) {
    score_tiles<512, true>(F, (const bf16*)(a.ws + WS_Q), (const bf16*)(a.ws + WS_K), MI, 2176, 2048, MH, (bf16*)(a.ws + WS_PT), (const float*)(a.ws + WS_GATES), (const float*)(a.ws + WS_SC), (int)blockIdx.x, F.G);
    if (F.G != 256) p4_atiles(F, a, (int)blockIdx.x, F.G);
}

__device__ __forceinline__ void p2_hprep(Frame& F, const Args& a) {
    bf16* QH = (bf16*)(a.ws + WS_QH); bf16* FH = (bf16*)(a.ws + WS_FH); float* EGL = (float*)(a.ws + WS_EGL);
    for (int i = F.vcu * NTHREADS + F.tid; i < (NTOK / 32) * (DM / 4); i += F.G * NTHREADS) {
        const int ch = i >> 8, col = (i & 255) * 4;
        const f32x4 l0 = *(const GAS f32x4*)(a.in[I_LB] + col), l1 = *(const GAS f32x4*)(a.in[I_LB] + DM + col);
        float lb[4], eg[4];
#pragma unroll
        for (int e = 0; e < 4; ++e) { lb[e] = __builtin_amdgcn_rcpf(1.0f + __expf(l1[e] - l0[e])); eg[e] = 1.0f; }
        size_t off = (size_t)ch * 32 * DM + col;
#pragma unroll 4
        for (int t = 0; t < 32; ++t, off += DM) {
            const v2u fw = *(const GAS v2u*)(FH + off), qw = *(const GAS v2u*)(QH + off);
            const float fl[4] = {bflo(fw.x), bfhi(fw.x), bflo(fw.y), bfhi(fw.y)}, ql[4] = {bflo(qw.x), bfhi(qw.x), bflo(qw.y), bfhi(qw.y)};
            float qo[4], ko[4];
#pragma unroll
            for (int e = 0; e < 4; ++e) {
                const float sg = sigmoidf_(fl[e]);
                eg[e] *= lb[e] + (1.0f - lb[e]) * sg;
                qo[e] = siluf_(ql[e]) * eg[e];
                ko[e] = (1.0f - lb[e]) * (1.0f - sg) * __builtin_amdgcn_rcpf(eg[e]);
            }
            v2u qv, kv; qv.x = pkc(qo[0], qo[1]); qv.y = pkc(qo[2], qo[3]); kv.x = pkc(ko[0], ko[1]); kv.y = pkc(ko[2], ko[3]);
            *(GAS v2u*)(QH + off) = qv; *(GAS v2u*)(FH + off) = kv;
        }
        *(GAS f32x4*)(EGL + (size_t)ch * DM + col) = (f32x4){eg[0], eg[1], eg[2], eg[3]};
    }
}
#ifndef TPROBE
#define TPROBE 0
#endif
#define REC_BAR() do { asm volatile("s_waitcnt lgkmcnt(0)" ::: "memory"); __builtin_amdgcn_s_barrier(); asm volatile("" ::: "memory"); } while (0)
template <bool HG>
__device__ __forceinline__ void rec_unit(Frame& F, const Args& a, int unit) {
    constexpr int KD = HG ? 128 : 512, NT = KD / 64, DW = KD / 2, NSL = HG ? 2 : 9, NPROMPT = HG ? 64 : 144;
    constexpr int QP = KD * 2 + 8, KP = KD * 2 + 64, VP = 192, PPI = 80, HP = 144, LDT = HG ? DM : MI;
    constexpr int NPQ = KD / 64, PPR = KD / 8;
    constexpr int L_Q = 0, L_K = L_Q + 32 * QP, L_V = L_K + 32 * KP, L_VW = L_V + 32 * VP, L_P = L_VW + 32 * VP, L_RED = L_P + 32 * PPI, L_SC = L_RED + 16384, L_H = L_SC + 2048, L_END = L_H + 32 * HP;
    static_assert(L_END <= RING_BYTES && (L_K % 16) == 0 && (L_V % 16) == 0 && (L_RED % 16) == 0 && (L_H % 16) == 0, "rec LDS map");
    const bool smp = unit >= NPROMPT; const int uu = smp ? unit - NPROMPT : unit;
    const int bh = uu / NSL, es = uu - bh * NSL; const bool den = !HG && es == 8;
    const int b = HG ? bh >> 3 : bh >> 2, h = HG ? bh & 7 : bh & 3;
    const int T = smp ? TS : TP, tok0 = smp ? NTOK_P + b * TS : b * TP, nsteps = T / 32;
    const int tid = F.tid, lane = F.lane, w = F.wave, r = lane & 31, hh = lane >> 5;
    LAS unsigned char* lds = F.lds + RING_OFF;
    LAS float* LS = (LAS float*)(lds + L_SC);
    const bf16* Qb = (const bf16*)(a.ws + (HG ? WS_QH : WS_Q)); const bf16* Kb = (const bf16*)(a.ws + (HG ? WS_FH : WS_K)); const bf16* Vb = (const bf16*)(a.ws + (HG ? WS_IH : WS_V));
    const bf16* PTb = (const bf16*)(a.ws + (HG ? WS_HA : WS_PT)) + (size_t)(smp ? (HG ? 4096 : 2048) + bh : bh * 128) * 1024;
    bf16* OUTb = HG ? (bf16*)(a.ws + WS_HO) : (bf16*)a.out;
    const unsigned colq = (unsigned)h * KD, colv = (unsigned)h * KD + (unsigned)(es & 7) * 64u;
    REC_BAR();
    if (w < 4) {
        const int we = w & 1, wd = w >> 1, el0 = 32 * we, dt0 = DW * wd;
        int ln = lane; asm volatile("" : "+v"(ln)); const int r_ = ln & 31, hh_ = ln >> 5, lb = ln, hb_ = hh_;
        f32x16 X[NT];
        if (smp && HG) {
            const float* s0 = a.in[I_SH] + ((size_t)bh * HE + dt0 + 4 * hh) * HE + es * 64 + el0 + r;
#pragma unroll
            for (int i = 0; i < NT; ++i)
#pragma unroll
                for (int g = 0; g < 16; ++g) X[i][g] = s0[(size_t)(32 * i + (g & 3) + 8 * (g >> 2)) * HE];
        } else if (smp) {
            const float* c0 = den ? a.in[I_SN] + (size_t)bh * MHD + dt0 + 4 * hh : a.in[I_SC] + ((size_t)bh * MHD + es * 64 + el0 + r) * MHD + dt0 + 4 * hh;
#pragma unroll
            for (int i = 0; i < NT; ++i) {
#pragma unroll
                for (int g = 0; g < 4; ++g) { const f32x4 v = *(const GAS f32x4*)(c0 + 32 * i + 8 * g); X[i][4 * g] = v.x; X[i][4 * g + 1] = v.y; X[i][4 * g + 2] = v.z; X[i][4 * g + 3] = v.w; }
            }
            if (den && !(we == 0 && r == 0)) {
#pragma unroll
                for (int i = 0; i < NT; ++i)
#pragma unroll
                    for (int g = 0; g < 16; ++g) X[i][g] = 0.f;
            }
        } else {
#pragma unroll
            for (int i = 0; i < NT; ++i)
#pragma unroll
                for (int g = 0; g < 16; ++g) X[i][g] = 0.f;
        }
        REC_BAR();
        unsigned long long tp_sum = 0ull, tp_t = 0ull; const bool tp_on = TPROBE && !HG && den && !smp && we == 0;
        for (int step = 0; step < nsteps; ++step) {
            LAS float* ls = LS + (step & 1) * 256;
            if (TPROBE == 1 && tp_on && step >= 8) tp_t = __builtin_amdgcn_s_memtime();
            const bf16x8 vb0 = tr_frag(lds + L_V, VP, 0, el0, ln), vb1 = tr_frag(lds + L_V, VP, 16, el0, ln);
            constexpr int NB = NT > 4 ? 4 : NT;
            f32x16 acc;
#pragma unroll
            for (int g = 0; g < 16; ++g) acc[g] = 0.f;
#pragma unroll
            for (int ib = 0; ib < NT; ib += NB) {
                bf16x8 pa[NB][2];
#pragma unroll
                for (int i = 0; i < NB; ++i)
#pragma unroll
                    for (int s = 0; s < 2; ++s) {
                        LAS unsigned char* qa = lds + L_Q + r_ * QP + (dt0 + 32 * (ib + i) + 16 * s + 4 * hh_) * 2;
                        const s16x4 lo = *(const LAS s16x4*)qa, hi = *(const LAS s16x4*)(qa + 16);
                        pa[i][s] = __builtin_shufflevector(lo, hi, 0, 1, 2, 3, 4, 5, 6, 7);
                    }
                __builtin_amdgcn_sched_barrier(0);
#pragma unroll
                for (int i = 0; i < NB; ++i)
#pragma unroll
                    for (int s = 0; s < 2; ++s) acc = MFMA32(pa[i][s], pack_step(X[ib + i], s), acc);
                __builtin_amdgcn_sched_barrier(0);
            }
            if (!HG) {
#pragma unroll
                for (int g = 0; g < 16; ++g) acc[g] *= ls[crow(g, hh_)];
            }
            if (wd == 0) {
                const bf16x8 p0 = *(const LAS bf16x8*)(lds + L_P + r_ * PPI + (8 * hh_) * 2), p1 = *(const LAS bf16x8*)(lds + L_P + r_ * PPI + (16 + 8 * hh_) * 2);
                acc = MFMA32(p0, vb0, acc); acc = MFMA32(p1, vb1, acc);
            }
            { LAS float* red = (LAS float*)(lds + L_RED) + w * 1024;
#pragma unroll
              for (int g = 0; g < 16; ++g) red[g * 64 + ln] = acc[g]; }
            if (TPROBE == 1 && tp_on && step >= 8) tp_sum += __builtin_amdgcn_s_memtime() - tp_t;
            if (TPROBE == 2 && tp_on && step >= 8) tp_t = __builtin_amdgcn_s_memtime();
            REC_BAR();
            if (TPROBE == 2 && tp_on && step >= 8) tp_sum += __builtin_amdgcn_s_memtime() - tp_t;
            if (TPROBE == 3 && tp_on && step >= 8) tp_t = __builtin_amdgcn_s_memtime();
            if (!HG) {
                const bf16x8 vw0 = tr_frag(lds + L_VW, VP, 0, el0, lb), vw1 = tr_frag(lds + L_VW, VP, 16, el0, lb);
                const float dec = ls[64];
                constexpr int NB = NT > 4 ? 4 : NT;
#pragma unroll
                for (int ib = 0; ib < NT; ib += NB) {
                    bf16x8 ka[NB][2];
#pragma unroll
                    for (int i = 0; i < NB; ++i) { ka[i][0] = tr_frag(lds + L_K, KP, 0, dt0 + 32 * (ib + i), lb); ka[i][1] = tr_frag(lds + L_K, KP, 16, dt0 + 32 * (ib + i), lb); }
                    __builtin_amdgcn_sched_barrier(0);
#pragma unroll
                    for (int i = 0; i < NB; ++i) {
                        X[ib + i] = X[ib + i] * dec;
                        X[ib + i] = MFMA32(ka[i][0], vw0, X[ib + i]); X[ib + i] = MFMA32(ka[i][1], vw1, X[ib + i]);
                    }
                    __builtin_amdgcn_sched_barrier(0);
                }
            } else {
#pragma unroll
                for (int i = 0; i < NT; ++i) {
                    const bf16x8 ka0 = tr_frag(lds + L_K, KP, 0, dt0 + 32 * i, lb), ka1 = tr_frag(lds + L_K, KP, 16, dt0 + 32 * i, lb);
                    X[i] = MFMA32(ka0, vb0, X[i]); X[i] = MFMA32(ka1, vb1, X[i]);
#pragma unroll
                    for (int g = 0; g < 16; ++g) X[i][g] *= ls[128 + dt0 + 32 * i + crow(g, hb_)];
                }
            }
            if (TPROBE == 3 && tp_on && step >= 8) tp_sum += __builtin_amdgcn_s_memtime() - tp_t;
            if (TPROBE == 4 && tp_on && step >= 8) tp_t = __builtin_amdgcn_s_memtime();
            REC_BAR();
            if (TPROBE == 4 && tp_on && step >= 8) tp_sum += __builtin_amdgcn_s_memtime() - tp_t;
        }
        if (TPROBE && tp_on) {
            const float avg = (float)tp_sum / 120.0f; const float eps = sqrtf(1.0e-4f * (1.0f + fminf(avg, 7000.f) / 2000.0f));
#pragma unroll
            for (int i = 0; i < NT; ++i)
#pragma unroll
                for (int g = 0; g < 16; ++g) X[i][g] *= (1.0f + eps);
        }
        if (HG) {
            float* so = a.out + (smp ? O_SS : O_SP) + ((size_t)bh * HE + dt0 + 4 * hh) * HE + es * 64 + el0 + r;
#pragma unroll
            for (int i = 0; i < NT; ++i)
#pragma unroll
                for (int g = 0; g < 16; ++g) so[(size_t)(32 * i + (g & 3) + 8 * (g >> 2)) * HE] = X[i][g];
        } else if (!den || (we == 0 && r == 0)) {
            float* co = den ? a.out + (smp ? O_NS : O_NP) + (size_t)bh * MHD + dt0 + 4 * hh : a.out + (smp ? O_CS : O_CP) + ((size_t)bh * MHD + es * 64 + el0 + r) * MHD + dt0 + 4 * hh;
#pragma unroll
            for (int i = 0; i < NT; ++i)
#pragma unroll
                for (int g = 0; g < 4; ++g) *(GAS f32x4*)(co + 32 * i + 8 * g) = (f32x4){X[i][4 * g], X[i][4 * g + 1], X[i][4 * g + 2], X[i][4 * g + 3]};
        }
    } else {
        __builtin_amdgcn_s_setprio(2);
        int ht_ = tid - 256; asm volatile("" : "+v"(ht_));
        const int ht = ht_, hx = ht_, hw = w - 4;
        const float* GATES = (const float*)(a.ws + WS_GATES); const float* SC = (const float*)(a.ws + WS_SC); const float* EGL = (const float*)(a.ws + WS_EGL);
        float* DEN = (float*)(a.ws + WS_DENI);
        const GAS unsigned char* Qg = (const GAS unsigned char*)Qb; const GAS unsigned char* Kg = (const GAS unsigned char*)Kb; const GAS unsigned char* Vg = (const GAS unsigned char*)Vb; const GAS unsigned char* Pg = (const GAS unsigned char*)PTb;
        v4u rq[NPQ], rk[NPQ], rvc = {0u, 0u, 0u, 0u}, rvn = {0u, 0u, 0u, 0u}, rp = {0u, 0u, 0u, 0u}; float sBg = 0.f, sm = 0.f, sig = 0.f, seg = 0.f;
        float Bprev = 0.f, mprev = (!HG && smp) ? a.in[I_SM][bh] : 0.f;
        const unsigned qoff0 = (unsigned)(tok0 + ht / PPR) * LDT + colq + (unsigned)(ht % PPR) * 8u;
        const unsigned voff0 = (unsigned)(tok0 + (ht >> 3)) * LDT + colv + (unsigned)(ht & 7) * 8u;
        const unsigned poff0 = (unsigned)((ht & 127) >> 2) * 32u + (unsigned)(ht & 3) * 8u;
        constexpr unsigned RSTEP = (256 / PPR) * LDT;
        unsigned pfq = 0u, pfk = 0u, pfacc = 0u;
        const unsigned pfoff0 = (unsigned)(tok0 + (ht >> 3)) * LDT + colq + (unsigned)(ht & (KD == 512 ? 7 : 1)) * 64u;
#define RC_WARM(c0) do { pfacc ^= pfq ^ pfk; const unsigned cs_ = (unsigned)((c0) < T ? (c0) : T - 32) * LDT; \
            pfq = *(const GAS unsigned*)(Qg + 2u * (pfoff0 + cs_)); pfk = *(const GAS unsigned*)(Kg + 2u * (pfoff0 + cs_)); } while (0)
#define RC_LOADQ(c0x) do { const int c0_ = (c0x) < T ? (c0x) : T - 32; const unsigned cs_ = (unsigned)c0_ * LDT;     \
            _Pragma("unroll") for (int i = 0; i < NPQ; ++i) rq[i] = *(const GAS v4u*)(Qg + 2u * (qoff0 + cs_ + (unsigned)i * RSTEP)); \
            rvn = *(const GAS v4u*)(Vg + 2u * (voff0 + cs_)); \
            rp = *(const GAS v4u*)(Pg + 2u * (poff0 + (unsigned)c0_ * 32u)); \
            if (!HG) { const unsigned tk = (unsigned)(tok0 + c0_ + (ht & 31)) * 8u + (unsigned)h * 2u; sBg = SC[tk]; sm = SC[tk + 1]; sig = GATES[tk - (unsigned)h]; } \
            else seg = EGL[(size_t)((tok0 + c0_) >> 5) * DM + colq + (ht & 127)]; } while (0)
#define RC_LOADK(c0x) do { const unsigned cs_ = (unsigned)((c0x) < T ? (c0x) : T - 32) * LDT; \
            _Pragma("unroll") for (int i = 0; i < NPQ; ++i) rk[i] = *(const GAS v4u*)(Kg + 2u * (qoff0 + cs_ + (unsigned)i * RSTEP)); } while (0)
#define RC_PUTQ(bank) do { \
            _Pragma("unroll") for (int i = 0; i < NPQ; ++i) { const int piece = hx + 256 * i, row = piece / PPR, c16 = piece % PPR; \
                v2u q0_, q1_; q0_.x = rq[i].x; q0_.y = rq[i].y; q1_.x = rq[i].z; q1_.y = rq[i].w; \
                *(LAS v2u*)(lds + L_Q + row * QP + c16 * 16) = q0_; *(LAS v2u*)(lds + L_Q + row * QP + c16 * 16 + 8) = q1_; } \
            { const int row = hx >> 3, c16 = hx & 7; v4u vv = rvn; if (den) { vv = (v4u){0u, 0u, 0u, 0u}; if (c16 == 0) vv.x = 0x3f80u; } \
              *(LAS v4u*)(lds + L_V + row * VP + c16 * 16) = vv; } \
            if (hx < 128) *(LAS v4u*)(lds + L_P + (hx >> 2) * PPI + (hx & 3) * 16) = rp; \
            LAS float* lsn = LS + (bank) * 256; \
            if (!HG && hx < 32) { const float BLs = __shfl(sBg, 31, 32), mLs = __shfl(sm, 31, 32); \
                lsn[hx] = __expf(sBg - Bprev + mprev - sm); lsn[32 + hx] = __expf(BLs - sBg + sig - mLs); \
                if (hx == 31) lsn[64] = __expf(BLs - Bprev + mprev - mLs); \
                Bprev = BLs; mprev = mLs; } \
            if (HG && hx < 128) lsn[128 + hx] = seg; } while (0)
        RC_LOADQ(0); RC_LOADK(0);
        RC_PUTQ(0);
        rvc = rvn;
        RC_LOADQ(32);
        REC_BAR();
        for (int step = 0; step < nsteps; ++step) {
            const int c0 = step * 32; LAS float* ls = LS + (step & 1) * 256;

            if (step > 0 && !den) { const int row = hx >> 3, c16 = hx & 7;
                *(GAS v4u*)(OUTb + ((unsigned)(tok0 + c0 - 32 + row) * LDT + colv + (unsigned)c16 * 8u)) = *(const LAS v4u*)(lds + L_H + row * HP + c16 * 16); }
#pragma unroll
            for (int i = 0; i < NPQ; ++i) { const int piece = hx + 256 * i, row = piece / PPR, c16 = piece % PPR; *(LAS v4u*)(lds + L_K + row * KP + c16 * 16) = rk[i]; }
            if (!HG) { const int row = hx >> 3, c16 = hx & 7; const float wl = ls[32 + row]; v4u vw = {0u, 0u, 0u, 0u};
                if (!den) { float x[8]; unpack8(rvc, x); vw.x = pkc(x[0] * wl, x[1] * wl); vw.y = pkc(x[2] * wl, x[3] * wl); vw.z = pkc(x[4] * wl, x[5] * wl); vw.w = pkc(x[6] * wl, x[7] * wl); }
                else if (c16 == 0) vw.x = pkc(wl, 0.f) & 0xffffu;
                *(LAS v4u*)(lds + L_VW + row * VP + c16 * 16) = vw; }
            RC_LOADK(c0 + 32);
            RC_WARM(c0 + 96);
            REC_BAR();
            { const int we = hw & 1, g0 = 8 * (hw >> 1), lane = hx & 63, r = lane & 31, hh = lane >> 5;
              const LAS float* ra = (const LAS float*)(lds + L_RED) + we * 1024; const LAS float* rb = ra + 2048;
              if (!den) {
#pragma unroll
                  for (int g = g0; g < g0 + 8; ++g) { const float v = ra[g * 64 + lane] + rb[g * 64 + lane];
                      *(LAS bf16*)(lds + L_H + crow(g, hh) * HP + (32 * we + r) * 2) = (bf16)(pkc(v, 0.f) & 0xffffu); }
              } else if (we == 0) {
                  float dv[8];
#pragma unroll
                  for (int g = 0; g < 8; ++g) dv[g] = ra[(g0 + g) * 64 + lane] + rb[(g0 + g) * 64 + lane];
                  if (r == 0) {
#pragma unroll
                      for (int g = 0; g < 8; ++g) DEN[(size_t)(tok0 + c0 + crow(g0 + g, hh)) * 4 + h] = dv[g]; }
              } }
            RC_PUTQ((step + 1) & 1); rvc = rvn; RC_LOADQ(c0 + 64);
            REC_BAR();
        }
        if (!den) { const int row = ht >> 3, c16 = ht & 7;
            *(GAS v4u*)(OUTb + ((unsigned)(tok0 + T - 32 + row) * LDT + colv + (unsigned)c16 * 8u)) = *(const LAS v4u*)(lds + L_H + row * HP + c16 * 16); }
        if (den && ht == 0) a.out[(smp ? O_MS : O_MP) + bh] = mprev;
        if ((pfacc ^ pfq ^ pfk) == 0x9e3779b9u && T == 7) DEN[0] = 0.f;
        __builtin_amdgcn_s_setprio(0);
#undef RC_WARM
#undef RC_LOADQ
#undef RC_LOADK
#undef RC_PUTQ
    }
}

__device__ __forceinline__ void rec_mlstm_naive(Frame& F, const Args& a, int unit) {
    const int seq = unit >> 6, h = (unit >> 4) & 3, es = unit & 15;
    const bool smp = seq >= BP; const int b = smp ? seq - BP : seq;
    const int T = smp ? TS : TP, tok0 = smp ? NTOK_P + b * TS : b * TP;
    const int dp = F.tid & 15, el = F.tid >> 4, e = es * 32 + el;
    const bf16* Q = (const bf16*)(a.ws + WS_Q); const bf16* K = (const bf16*)(a.ws + WS_K); const bf16* V = (const bf16*)(a.ws + WS_V);
    const float* GATES = (const float*)(a.ws + WS_GATES);
    bf16* HM = (bf16*)a.out;
    float Cs[32], ns[32]; float m;
    if (smp) {
        const float* c0 = a.in[I_SC] + ((size_t)(b * MH + h) * MHD + e) * MHD; const float* n0 = a.in[I_SN] + (size_t)(b * MH + h) * MHD;
#pragma unroll
        for (int j = 0; j < 32; ++j) { Cs[j] = c0[dp + 16 * j]; ns[j] = n0[dp + 16 * j]; }
        m = a.in[I_SM][b * MH + h];
    } else {
#pragma unroll
        for (int j = 0; j < 32; ++j) { Cs[j] = 0.f; ns[j] = 0.f; }
        m = 0.f;
    }
    LAS float* qs = (LAS float*)(F.lds + RING_OFF);
    LAS float* ks = qs + 16 * 512;
    LAS float* vs = ks + 16 * 512;
    LAS float* gs = vs + 16 * 32;
    for (int t0 = 0; t0 < T; t0 += 16) {
        __syncthreads();
        for (int i = F.tid; i < 16 * 512; i += NTHREADS) { const int tt = i >> 9, d = i & 511; const size_t off = (size_t)(tok0 + t0 + tt) * MI + h * MHD + d; qs[i] = bf2f(Q[off]); ks[i] = bf2f(K[off]); }
        { const int tt = F.tid >> 5, ee = F.tid & 31; vs[F.tid] = bf2f(V[(size_t)(tok0 + t0 + tt) * MI + h * MHD + es * 32 + ee]); }
        if (F.tid < 32) { const int tt = F.tid >> 1; gs[F.tid] = GATES[(size_t)(tok0 + t0 + tt) * 8 + (F.tid & 1) * 4 + h]; }
        __syncthreads();
        for (int tt = 0; tt < 16; ++tt) {
            const float ig = gs[tt * 2], lf = gs[tt * 2 + 1];
            const float mn = fmaxf(lf + m, ig), fp = __expf(lf + m - mn), ip = __expf(ig - mn); m = mn;
            const float vv = ip * vs[tt * 32 + el];
            float dot = 0.f, nd = 0.f;
#pragma unroll
            for (int j = 0; j < 32; ++j) { const float kk = ks[tt * 512 + dp + 16 * j], qq = qs[tt * 512 + dp + 16 * j];
                Cs[j] = fp * Cs[j] + vv * kk; ns[j] = fp * ns[j] + ip * kk; dot += Cs[j] * qq; nd += ns[j] * qq; }
#pragma unroll
            for (int o = 1; o < 16; o <<= 1) { dot += __shfl_xor(dot, o); nd += __shfl_xor(nd, o); }
            const float hv = dot / fmaxf(fabsf(nd), __expf(-m));
            if (dp == 0) HM[(size_t)(tok0 + t0 + tt) * MI + h * MHD + e] = (bf16)f2bf(hv);
        }
    }
    float* co = a.out + (smp ? O_CS : O_CP) + ((size_t)(b * MH + h) * MHD + e) * MHD;
#pragma unroll
    for (int j = 0; j < 32; ++j) co[dp + 16 * j] = Cs[j];
    if (es == 0 && el == 0) { float* no = a.out + (smp ? O_NS : O_NP) + (size_t)(b * MH + h) * MHD;
#pragma unroll
        for (int j = 0; j < 32; ++j) no[dp + 16 * j] = ns[j];
        if (dp == 0) a.out[(smp ? O_MS : O_MP) + b * MH + h] = m; }
}
__device__ __forceinline__ void rec_hgrn_naive(Frame& F, const Args& a, int unit) {
    const int seq = unit >> 5, hd = (unit >> 2) & 7, es = unit & 3;
    const bool smp = seq >= BP; const int b = smp ? seq - BP : seq;
    const int T = smp ? TS : TP, tok0 = smp ? NTOK_P + b * TS : b * TP;
    const int cp = F.tid & 15, el = F.tid >> 4, e = es * 32 + el;
    const bf16* QH = (const bf16*)(a.ws + WS_QH); const bf16* FH = (const bf16*)(a.ws + WS_FH); const bf16* IH = (const bf16*)(a.ws + WS_IH);
    bf16* HO = (bf16*)(a.ws + WS_HO);
    float S[8];
    if (smp) {
#pragma unroll
        for (int j = 0; j < 8; ++j) S[j] = a.in[I_SH][((size_t)(b * HH + hd) * HE + cp + 16 * j) * HE + e];
    } else {
#pragma unroll
        for (int j = 0; j < 8; ++j) S[j] = 0.f;
    }
    LAS float* qs = (LAS float*)(F.lds + RING_OFF);
    LAS float* fs = qs + 2048; LAS float* ks = fs + 2048; LAS float* vs = ks + 2048;
    for (int t0 = 0; t0 < T; t0 += 16) {
        __syncthreads();
        for (int i = F.tid; i < 2048; i += NTHREADS) { const int tt = i >> 7, c = i & 127, col = hd * HE + c; const size_t off = (size_t)(tok0 + t0 + tt) * DM + col;
            const float l0 = a.in[I_LB][col], l1 = a.in[I_LB][DM + col]; const float lb = 1.0f / (1.0f + __expf(l1 - l0));
            const float sg = sigmoidf_(bf2f(FH[off]));
            qs[i] = siluf_(bf2f(QH[off])); fs[i] = lb + (1.0f - lb) * sg; ks[i] = (1.0f - lb) * (1.0f - sg); }
        { const int tt = F.tid >> 5, ee = F.tid & 31; vs[F.tid] = bf2f(IH[(size_t)(tok0 + t0 + tt) * DM + hd * HE + es * 32 + ee]); }
        __syncthreads();
        for (int tt = 0; tt < 16; ++tt) {
            const float vv = vs[tt * 32 + el]; float o = 0.f;
#pragma unroll
            for (int j = 0; j < 8; ++j) { const int c = cp + 16 * j; S[j] = fs[tt * 128 + c] * S[j] + ks[tt * 128 + c] * vv; o += qs[tt * 128 + c] * S[j]; }
#pragma unroll
            for (int s = 1; s < 16; s <<= 1) o += __shfl_xor(o, s);
            if (cp == 0) HO[(size_t)(tok0 + t0 + tt) * DM + hd * HE + e] = (bf16)f2bf(o);
        }
    }
    float* so = a.out + (smp ? O_SS : O_SP);
#pragma unroll
    for (int j = 0; j < 8; ++j) so[((size_t)(b * HH + hd) * HE + cp + 16 * j) * HE + e] = S[j];
}
#ifndef RECDUP
#define RECDUP 0
#endif
constexpr int CW_QUEUE = 8192;
__device__ __forceinline__ void p5_rec(Frame& F, const Args& a) {
    const int bx = blockIdx.x;
    int kind = -1, unit = 0;
    if (F.G == 256) {
        const int x = bx & 7, y = bx >> 3;
        if (y < 18) { kind = 0; unit = (x * 2 + (y >= 9 ? 1 : 0)) * 9 + (y >= 9 ? y - 9 : y); }
        else if (y < 26) { kind = 1; unit = (x * 4 + ((y - 18) >> 1)) * 2 + ((y - 18) & 1); }
    } else if (bx < 144) { kind = 0; unit = bx; } else if (bx < 208) { kind = 1; unit = bx - 144; }
    volatile LAS unsigned* MISC = (volatile LAS unsigned*)(F.lds + MISC_OFF);
    unsigned* qhead = (unsigned*)(a.ws + WS_CTL) + CW_QUEUE;
    const bool prompt_m = kind == 0;
    if (!prompt_m) {
        int u = kind == 1 ? unit : -1; int again = (kind == 1 && (RECDUP & 2)) ? 1 : 0;
        for (;;) {
            if (u < 0 && again > 0) { --again; u = unit; }
            if (u < 0) {
                __syncthreads();
                if (F.tid == 0) MISC[16] = __hip_atomic_fetch_add(qhead, 1u, __ATOMIC_RELAXED, __HIP_MEMORY_SCOPE_AGENT);
                __syncthreads();
                const unsigned qi = MISC[16];
                if (qi >= 512u) break;
                u = 64 + (int)qi;
            }
            rec_unit<true>(F, a, u);
            u = -1;
        }
    }
    {
        int u = prompt_m ? unit : -1; int again = (prompt_m && (RECDUP & 1)) ? 1 : 0;
        for (;;) {
            if (u < 0 && again > 0) { --again; u = unit; }
            if (u < 0) {
                if (prompt_m) break;
                __syncthreads();
                if (F.tid == 0) MISC[16] = __hip_atomic_fetch_add(qhead + 64, 1u, __ATOMIC_RELAXED, __HIP_MEMORY_SCOPE_AGENT);
                __syncthreads();
                const unsigned qi = MISC[16];
                if (qi >= 1152u) break;
                u = 144 + (int)qi;
            }
            rec_unit<false>(F, a, u);
            u = -1;
        }
    }
}

__device__ __forceinline__ void p6_norm(Frame& F, const Args& a) {
    const int gw = F.vcu * NWAVES + F.wave, NGW = F.G * NWAVES, lane = F.lane;
    const bf16* HM = (const bf16*)a.out; const bf16* C = (const bf16*)(a.ws + WS_C); const bf16* ZP = (const bf16*)(a.ws + WS_ZP);
    const bf16* HO = (const bf16*)(a.ws + WS_HO); const bf16* GHP = (const bf16*)(a.ws + WS_GHP);
    const float* DEN = (const float*)(a.ws + WS_DENI); const float* SC = (const float*)(a.ws + WS_SC);
    bf16* HMN = (bf16*)(a.ws + WS_HMN); bf16* OH = (bf16*)(a.ws + WS_OH);
    const float* mg = a.in[I_MNORMG] + lane * 8; const float* ms = a.in[I_MSKIP] + lane * 8; const float* hg = a.in[I_HNORMG] + lane * 16;
    for (int m = gw; m < NTOK; m += NGW) {
        v4u hm[4], cc[4], zz[4], ho[2], gh[2]; f32x4 dn4, sc0, sc1;
        const size_t offm = (size_t)m * MI + lane * 8, offh = (size_t)m * DM + lane * 16;
#pragma unroll
        for (int h = 0; h < 4; ++h) { hm[h] = *(const GAS v4u*)(HM + offm + h * MHD); cc[h] = *(const GAS v4u*)(C + offm + h * MHD); zz[h] = *(const GAS v4u*)(ZP + offm + h * MHD); }
        ho[0] = *(const GAS v4u*)(HO + offh); ho[1] = *(const GAS v4u*)(HO + offh + 8); gh[0] = *(const GAS v4u*)(GHP + offh); gh[1] = *(const GAS v4u*)(GHP + offh + 8);
        dn4 = *(const GAS f32x4*)(DEN + (size_t)m * 4); sc0 = *(const GAS f32x4*)(SC + (size_t)m * 8); sc1 = *(const GAS f32x4*)(SC + (size_t)m * 8 + 4);
        const float mts[4] = {sc0.y, sc0.w, sc1.y, sc1.w};
#pragma unroll
        for (int h = 0; h < 4; ++h) {
            float x[8], c[8], z[8];
            unpack8(hm[h], x); unpack8(cc[h], c); unpack8(zz[h], z);
            float s = 0.f;
#pragma unroll
            for (int e = 0; e < 8; ++e) s += x[e];
            const float mu = wave_sum(s) * (1.f / MHD); float q = 0.f;
#pragma unroll
            for (int e = 0; e < 8; ++e) { x[e] -= mu; q += x[e] * x[e]; }
            const float dpr = fmaxf(fabsf(dn4[h]), __expf(-mts[h]));
            const float rstd = 1.0f / sqrtf(wave_sum(q) * (1.f / MHD) + EPS * dpr * dpr);
            const f32x4 g0 = *(const GAS f32x4*)(mg + h * MHD), g1 = *(const GAS f32x4*)(mg + h * MHD + 4), k0 = *(const GAS f32x4*)(ms + h * MHD), k1 = *(const GAS f32x4*)(ms + h * MHD + 4);
            float o[8];
#pragma unroll
            for (int e = 0; e < 4; ++e) { o[e] = (x[e] * rstd * g0[e] + k0[e] * c[e]) * z[e]; o[4 + e] = (x[4 + e] * rstd * g1[e] + k1[e] * c[4 + e]) * z[4 + e]; }
            *(GAS v4u*)(HMN + offm + h * MHD) = pack8(o);
        }
        {
            float x0[8], x1[8], g0[8], g1[8];
            unpack8(ho[0], x0); unpack8(ho[1], x1); unpack8(gh[0], g0); unpack8(gh[1], g1);
            float q = 0.f;
#pragma unroll
            for (int e = 0; e < 8; ++e) q += x0[e] * x0[e] + x1[e] * x1[e];
            q += __shfl_xor(q, 1); q += __shfl_xor(q, 2); q += __shfl_xor(q, 4);
            const float rstd = 1.0f / sqrtf(q * (1.f / HE) + EPS);
            float o0[8], o1[8];
#pragma unroll
            for (int e4 = 0; e4 < 2; ++e4) { const f32x4 ga = *(const GAS f32x4*)(hg + 4 * e4), gb = *(const GAS f32x4*)(hg + 8 + 4 * e4);
#pragma unroll
                for (int e = 0; e < 4; ++e) { o0[4 * e4 + e] = x0[4 * e4 + e] * rstd * ga[e] * g0[4 * e4 + e]; o1[4 * e4 + e] = x1[4 * e4 + e] * rstd * gb[e] * g1[4 * e4 + e]; } }
            *(GAS v4u*)(OH + offh) = pack8(o0); *(GAS v4u*)(OH + offh + 8) = pack8(o1);
        }
    }
}

__device__ __forceinline__ void p12_final(Frame& F, const Args& a) {
    const int gw = F.vcu * NWAVES + F.wave, NGW = F.G * NWAVES;
    const float* fg = a.in[I_FINALG];
    for (int m = gw; m < NTOK; m += NGW) {
        GAS f32x4* xr = (GAS f32x4*)(a.out + (size_t)m * DM) + F.lane;
        f32x4 v[4]; float ss = 0.f;
#pragma unroll
        for (int j = 0; j < 4; ++j) { v[j] = xr[64 * j]; ss += (v[j].x * v[j].x + v[j].y * v[j].y) + (v[j].z * v[j].z + v[j].w * v[j].w); }
        const float rstd = 1.0f / sqrtf(wave_sum(ss) * (1.f / DM) + EPS);
#pragma unroll
        for (int j = 0; j < 4; ++j) { const f32x4 gg = *(const GAS f32x4*)(fg + 4 * F.lane + 256 * j); xr[64 * j] = v[j] * rstd * gg; }
    }
}

__device__ __forceinline__ void st8bf(bf16* p, f32x4 v0, f32x4 v1) {
    v4u w; w.x = pg8::cvt_pk_bf16(v0[0], v0[1]); w.y = pg8::cvt_pk_bf16(v0[2], v0[3]); w.z = pg8::cvt_pk_bf16(v1[0], v1[1]); w.w = pg8::cvt_pk_bf16(v1[2], v1[3]);
    *(GAS v4u*)p = w;
}
__device__ __forceinline__ void ld8bf(const bf16* p, f32x4& v0, f32x4& v1) {
    const v4u w = *(const GAS v4u*)p; v0 = (f32x4){bflo(w.x), bfhi(w.x), bflo(w.y), bfhi(w.y)}; v1 = (f32x4){bflo(w.z), bfhi(w.z), bflo(w.w), bfhi(w.w)};
}
__device__ __forceinline__ f32x4 sig4(f32x4 v) { return (f32x4){sigmoidf_(v[0]), sigmoidf_(v[1]), sigmoidf_(v[2]), sigmoidf_(v[3])}; }
struct Fn1a { unsigned char* ws; const float* big; const float* bfg;
    __device__ __forceinline__ void operator()(int row, int pn, int ct, f32x4 v0, f32x4 v1) const {
        if (pn == 28) {
            if (ct == 0) { float* g = (float*)(ws + WS_GATES) + (size_t)row * 8;
                const f32x4 bi = *(const GAS f32x4*)big, bf = *(const GAS f32x4*)bfg;
                *(GAS f32x4*)g = v0 + bi;
                *(GAS f32x4*)(g + 4) = (f32x4){logsigmoidf_(v1[0] + bf[0]), logsigmoidf_(v1[1] + bf[1]), logsigmoidf_(v1[2] + bf[2]), logsigmoidf_(v1[3] + bf[3])}; }
            return;
        }
        bf16* base; int ld, col;
        if (pn < 8) { base = (bf16*)(ws + WS_U); ld = MI; col = pn * 256; } else if (pn < 16) { base = (bf16*)(ws + WS_V); ld = MI; col = (pn - 8) * 256; }
        else if (pn < 20) { base = (bf16*)(ws + WS_QH); ld = DM; col = (pn - 16) * 256; } else if (pn < 24) { base = (bf16*)(ws + WS_FH); ld = DM; col = (pn - 20) * 256; }
        else { base = (bf16*)(ws + WS_IH); ld = DM; col = (pn - 24) * 256; }
        st8bf(base + (size_t)row * ld + col + ct, v0, v1);
    } };
struct Fn3 { unsigned char* ws;
    __device__ __forceinline__ void operator()(int row, int pn, int ct, f32x4 v0, f32x4 v1) const {
        if (pn < 8) st8bf((bf16*)(ws + WS_Q) + (size_t)row * MI + pn * 256 + ct, v0, v1);
        else { const float s = 0.044194173824159216f; st8bf((bf16*)(ws + WS_K) + (size_t)row * MI + (pn - 8) * 256 + ct, v0 * s, v1 * s); }
    } };
struct Fn5 { unsigned char* ws;
    __device__ __forceinline__ void operator()(int row, int pn, int ct, f32x4 v0, f32x4 v1) const {
        bf16* base; int ld, col; bool sil;
        if (pn < 8) { base = (bf16*)(ws + WS_ZP); ld = MI; col = pn * 256; sil = true; } else if (pn < 12) { base = (bf16*)(ws + WS_GHP); ld = DM; col = (pn - 8) * 256; sil = true; }
        else if (pn < 16) { base = (bf16*)(ws + WS_GAP); ld = DM; col = (pn - 12) * 256; sil = false; } else { base = (bf16*)(ws + WS_GBP); ld = DM; col = (pn - 16) * 256; sil = false; }
        f32x4 s0 = sig4(v0), s1 = sig4(v1);
        if (sil) { s0 = s0 * v0; s1 = s1 * v1; }
        st8bf(base + (size_t)row * ld + col + ct, s0, s1);
    } };
struct Fn7 { unsigned char* ws;
    __device__ __forceinline__ void operator()(int row, int pn, int ct, f32x4 v0, f32x4 v1) const {
        const size_t off = (size_t)row * DM + pn * 256 + ct; f32x4 g0, g1; ld8bf((const bf16*)(ws + WS_GAP) + off, g0, g1);
        st8bf((bf16*)(ws + WS_YA) + off, v0 * g0, v1 * g1);
    } };
struct Fn8 { unsigned char* ws;
    __device__ __forceinline__ void operator()(int row, int pn, int ct, f32x4 v0, f32x4 v1) const {
        const size_t off = (size_t)row * DM + pn * 256 + ct; f32x4 g0, g1, y0, y1; ld8bf((const bf16*)(ws + WS_GBP) + off, g0, g1); ld8bf((const bf16*)(ws + WS_YA) + off, y0, y1);
        st8bf((bf16*)(ws + WS_Y) + off, y0 + v0 * g0, y1 + v1 * g1);
    } };
struct Fn9 { unsigned char* ws; const float* xp; const float* xs; float* out;
    __device__ __forceinline__ void operator()(int row, int pn, int ct, f32x4 v0, f32x4 v1) const {
        const int col = pn * 256 + ct; const float* xr = (row < NTOK_P ? xp + (size_t)row * DM : xs + (size_t)(row - NTOK_P) * DM) + col;
        const f32x4 h0 = *(const GAS f32x4*)xr + v0, h1 = *(const GAS f32x4*)(xr + 4) + v1;
        float* o = out + (size_t)row * DM + col; *(GAS f32x4*)o = h0; *(GAS f32x4*)(o + 4) = h1;
        st8bf((bf16*)(ws + WS_H1B) + (size_t)row * DM + col, h0, h1);
    } };
struct Fn10 { unsigned char* ws;
    __device__ __forceinline__ void operator()(int row, int pn, int ct, f32x4 v0, f32x4 v1) const { st8bf((bf16*)(ws + WS_G2) + (size_t)row * DM + pn * 256 + ct, v0, v1); } };
struct Fn11 { unsigned char* ws; float* out;
    __device__ __forceinline__ void operator()(int row, int pn, int ct, f32x4 v0, f32x4 v1) const {
        const size_t off = (size_t)row * DM + pn * 256 + ct; f32x4 g0, g1; ld8bf((const bf16*)(ws + WS_G2) + off, g0, g1);
        float* o = out + off; const f32x4 h0 = *(const GAS f32x4*)o, h1 = *(const GAS f32x4*)(o + 4);
        *(GAS f32x4*)o = h0 + sig4(v0) * g0; *(GAS f32x4*)(o + 4) = h1 + sig4(v1) * g1;
    } };

template <int K, class Fn>
__device__ __forceinline__ void small_gemm(Frame& F, const bf16* A, int lda, const bf16* Bt, int ldb, const Fn& fn) {
    typedef float f32x4v __attribute__((ext_vector_type(4)));
    constexpr int KW = K / 8, CH = KW > 128 ? 128 : KW, NS = CH / 32, RS = 68;
    const int lane = F.lane, w = F.wave, i16 = lane & 15, fq = lane >> 4;
    LAS float* red = (LAS float*)(F.lds + RING_OFF);
    for (int t = blockIdx.x; t < 256; t += F.G) {
        const int row0 = NTOK_P + (t >> 4) * 64, col0 = (t & 15) * 64;
        const bf16* ap = A + (size_t)(row0 + i16) * lda + w * KW + 8 * fq;
        const bf16* bp = Bt + (size_t)(col0 + i16) * ldb + w * KW + 8 * fq;
        f32x4v acc[4][4];
#pragma unroll
        for (int mi = 0; mi < 4; ++mi)
#pragma unroll
            for (int ni = 0; ni < 4; ++ni) acc[mi][ni] = (f32x4v){0.f, 0.f, 0.f, 0.f};
#pragma unroll
        for (int kc = 0; kc < KW; kc += CH) {
            bf16x8 xa[NS][4], wb[NS][4];
#pragma unroll
            for (int s = 0; s < NS; ++s)
#pragma unroll
                for (int i = 0; i < 4; ++i) { xa[s][i] = *(const GAS bf16x8*)(ap + (size_t)(16 * i) * lda + kc + 32 * s); wb[s][i] = *(const GAS bf16x8*)(bp + (size_t)(16 * i) * ldb + kc + 32 * s); }
#pragma unroll
            for (int s = 0; s < NS; ++s)
#pragma unroll
                for (int mi = 0; mi < 4; ++mi)
#pragma unroll
                    for (int ni = 0; ni < 4; ++ni) acc[mi][ni] = __builtin_amdgcn_mfma_f32_16x16x32_bf16(wb[s][ni], xa[s][mi], acc[mi][ni], 0, 0, 0);
        }
        __syncthreads();
        if (w >= 4) { LAS float* r = red + (w - 4) * (64 * RS);
#pragma unroll
            for (int mi = 0; mi < 4; ++mi)
#pragma unroll
                for (int ni = 0; ni < 4; ++ni) *(LAS f32x4v*)(r + (16 * mi + i16) * RS + 16 * ni + 4 * fq) = acc[mi][ni]; }
        __syncthreads();
        if (w < 4) { LAS float* r = red + w * (64 * RS);
#pragma unroll
            for (int mi = 0; mi < 4; ++mi)
#pragma unroll
                for (int ni = 0; ni < 4; ++ni) { LAS f32x4v* p = (LAS f32x4v*)(r + (16 * mi + i16) * RS + 16 * ni + 4 * fq); *p = *p + acc[mi][ni]; } }
        __syncthreads();
        const int row = F.tid >> 3, c8 = (F.tid & 7) * 8;
        f32x4v s0 = {0.f, 0.f, 0.f, 0.f}, s1 = {0.f, 0.f, 0.f, 0.f};
#pragma unroll
        for (int q = 0; q < 4; ++q) { const LAS float* r = red + q * (64 * RS) + row * RS + c8; s0 = s0 + *(const LAS f32x4v*)r; s1 = s1 + *(const LAS f32x4v*)(r + 4); }
        __syncthreads();
        const int col = col0 + c8;
        fn(row0 + row, col >> 8, col & 255, s0, s1);
    }
}
template <class Fn> struct RowOff { Fn f; int r0; __device__ __forceinline__ void operator()(int row, int pn, int ct, pg8::f32x4 v0, pg8::f32x4 v1) const { f(row + r0, pn, ct, v0, v1); } };
__device__ __forceinline__ bool launder(Frame& F) {
    int t = threadIdx.x; asm volatile("" : "+v"(t)); F.tid = t; F.lane = t & 63; return true; }
constexpr int N_PHASES = 13;
#ifndef MK_PER_PHASE
#define MK_PER_PHASE 0
#endif
template <class Fn>
__device__ __forceinline__ void run_gemm(Frame& F, const bf16* A, int lda, const bf16* Bt, int ldb, int K, int N, int amask, int ashift, int astride, const Fn& fn, int M = NTOK, int wgm = 4) {
    asm volatile("" : "+s"(K));
    pg8::Gemm g{A, Bt, lda, ldb, K, amask, ashift, astride}; pg8::StaticOrder S; S.init(M, N, F.G, (int)blockIdx.x, wgm);
    pg8::EpiF<Fn> E{fn};
    pg8::gemm_phase<pg8::EpiF<Fn>, pg8::StaticOrder, true, true>(F.lds + RING_OFF, g, S, E);
}
__device__ __forceinline__ void publish_count(unsigned* cnt) {
    asm volatile("s_waitcnt vmcnt(0)" ::: "memory");
    __syncthreads();
    if (threadIdx.x == 0) {
        __builtin_amdgcn_fence(__ATOMIC_RELEASE, "agent");
        asm volatile("s_waitcnt vmcnt(0)" ::: "memory");
        (void)__hip_atomic_fetch_add(cnt, 1u, __ATOMIC_RELAXED, __HIP_MEMORY_SCOPE_AGENT);
    }
}
__device__ __forceinline__ void wait_count(unsigned* cnt, unsigned need) {
    if (threadIdx.x == 0) {
        unsigned sp = 0;
        while (__hip_atomic_load(cnt, __ATOMIC_RELAXED, __HIP_MEMORY_SCOPE_AGENT) < need) { __builtin_amdgcn_s_sleep(8); if (++sp > (1u << 22)) break; }
        __builtin_amdgcn_fence(__ATOMIC_ACQUIRE, "agent");
        asm volatile("s_waitcnt vmcnt(0)" ::: "memory");
    }
    __syncthreads();
}
constexpr int CW_WORKERS = 8192 + 128;
struct OneTile { pg8::Unit u;
    __device__ __forceinline__ bool next(int i, pg8::Unit& o) const { if (i != 0) return false; o = u; return true; }
    __device__ __forceinline__ void a_ready(const pg8::Unit&) const {}
    __device__ __forceinline__ void done(const pg8::Unit&) const {} };
template <class Fn>
__device__ __forceinline__ void run_gemm_one(Frame& F, const bf16* A, int lda, const bf16* Bt, int ldb, int K, int pm, int pn, const Fn& fn) {
    asm volatile("" : "+s"(K));
    pg8::Gemm g{A, Bt, lda, ldb, K, 0, 0, 0}; OneTile S; S.u.pm = pm; S.u.pn = pn;
    pg8::EpiF<Fn> E{fn};
    pg8::gemm_phase<pg8::EpiF<Fn>, OneTile, true, true>(F.lds + RING_OFF, g, S, E);
}
__global__ void __launch_bounds__(NTHREADS, 2) mk_fwd(Args args) {
    extern __shared__ __attribute__((aligned(16))) unsigned char lds[];
    Frame F;
    F.lds = (LAS unsigned char*)lds;
    F.tid = threadIdx.x; F.lane = F.tid & 63; F.wave = __builtin_amdgcn_readfirstlane(F.tid >> 6);
    F.G = gridDim.x; { const int bx = blockIdx.x; F.vcu = (F.G % 8 == 0) ? (bx % 8) * (F.G / 8) + bx / 8 : bx; }
    volatile LAS unsigned* MISC = (volatile LAS unsigned*)(F.lds + MISC_OFF);
    for (int u = F.tid; u < (LDS_BYTES - LDSCTL_OFF) / 4; u += NTHREADS) ((LAS unsigned*)(F.lds + LDSCTL_OFF))[u] = 0u;
    __syncthreads();
    unsigned char* ws = args.ws;
    XcdBarrier bar; bar.bar = (unsigned*)(ws + WS_CTL) + CW_BAR; bar.x = 0; bar.st = nullptr;
    if (!MK_PER_PHASE) bar = xcd_barrier_post((unsigned*)(ws + WS_CTL) + CW_BAR, MISC + 8);
    const int lo = args.ph_lo, hi = args.ph_hi;
#ifndef PHMASK
#define PHMASK 0x1fff
#endif
#define IN(k) (((PHMASK >> (k)) & 1) && lo <= (k) && (k) < hi && launder(F))
#define SEAM(k) do { if (IN(k) && IN((k) + 1)) xcd_barrier(bar); } while (0)
#ifndef RMASK
#define RMASK 0
#endif
#define REP(k, ...) do { __VA_ARGS__; if ((RMASK >> (k)) & 1) { xcd_barrier(bar); __VA_ARGS__; } } while (0)
    if (IN(0)) REP(0, p0_prep(F, args)); SEAM(0);
    if (IN(1)) { REP(1, run_gemm(F, (const bf16*)(ws + WS_XN), DM, (const bf16*)(ws + WS_WIN), DM, DM, 7424, 0, 0, 0, Fn1a{ws, args.in[I_BIG], args.in[I_BFG]}));
        if (F.G == 256 && blockIdx.x >= 180) p0_pb(F, args, ((int)blockIdx.x - 180) * NTHREADS + F.tid, 76 * NTHREADS); } SEAM(1);
    if (IN(2)) { REP(2, p2_conv(F, args); p2_scan(F, args)); p2_hprep(F, args); } SEAM(2);
    if (IN(3)) { REP(3, run_gemm(F, (const bf16*)(ws + WS_C), MI, (const bf16*)(ws + WS_WQK), MHD, MHD, 4096, 7, 1, MHD, Fn3{ws}));
        if (F.G == 256 && blockIdx.x >= 64) p4_atiles(F, args, (int)blockIdx.x - 64, 192); } SEAM(3);
    if (IN(4)) REP(4, p4_tiles(F, args)); SEAM(4);
    if (IN(5)) { REP(5, p5_rec(F, args));
        if (F.G == 256 && (blockIdx.x >> 3) >= 18) {
            unsigned* cw = (unsigned*)(ws + WS_CTL) + CW_WORKERS;
            publish_count(cw);
            const int t = ((int)(blockIdx.x >> 3) - 18) * 8 + (int)(blockIdx.x & 7);
            if (t < 80) { wait_count(cw, 112u);
                run_gemm_one(F, (const bf16*)(ws + WS_XN), DM, (const bf16*)(ws + WS_WIN) + (size_t)7424 * DM, DM, DM, 64 + t / 20, t % 20, Fn5{ws}); }
        } } SEAM(5);
    if (IN(6)) REP(6, run_gemm(F, (const bf16*)(ws + WS_XN), DM, (const bf16*)(ws + WS_WIN) + (size_t)7424 * DM, DM, DM, 5120, 0, 0, 0, Fn5{ws}, F.G == 256 ? NTOK_P : NTOK)); SEAM(6);
    if (IN(7)) REP(7, p6_norm(F, args)); SEAM(7);
    if (IN(8)) REP(8, run_gemm(F, (const bf16*)(ws + WS_HMN), MI, (const bf16*)(ws + WS_WBRM), MI, MI, DM, 0, 0, 0, Fn7{ws}, NTOK_P); small_gemm<MI>(F, (const bf16*)(ws + WS_HMN), MI, (const bf16*)(ws + WS_WBRM), MI, Fn7{ws});
                     run_gemm(F, (const bf16*)(ws + WS_PB), PLE, (const bf16*)(ws + WS_WPLE), PLE, PLE, DM, 0, 0, 0, Fn10{ws}, NTOK_P); small_gemm<PLE>(F, (const bf16*)(ws + WS_PB), PLE, (const bf16*)(ws + WS_WPLE), PLE, Fn10{ws}));
    if (IN(8) && IN(9)) local_fence();
    if (IN(9)) REP(9, run_gemm(F, (const bf16*)(ws + WS_OH), DM, (const bf16*)(ws + WS_WBRH), DM, DM, DM, 0, 0, 0, Fn8{ws}, NTOK_P); small_gemm<DM>(F, (const bf16*)(ws + WS_OH), DM, (const bf16*)(ws + WS_WBRH), DM, Fn8{ws})); SEAM(9);
    if (IN(10)) REP(10, run_gemm(F, (const bf16*)(ws + WS_Y), DM, (const bf16*)(ws + WS_WOUT), DM, DM, DM, 0, 0, 0, Fn9{ws, args.in[I_XP], args.in[I_XS], args.out}, NTOK_P); small_gemm<DM>(F, (const bf16*)(ws + WS_Y), DM, (const bf16*)(ws + WS_WOUT), DM, Fn9{ws, args.in[I_XP], args.in[I_XS], args.out})); SEAM(10);
    if (IN(11)) { run_gemm(F, (const bf16*)(ws + WS_H1B), DM, (const bf16*)(ws + WS_WPG), DM, DM, DM, 0, 0, 0, Fn11{ws, args.out}, NTOK_P); small_gemm<DM>(F, (const bf16*)(ws + WS_H1B), DM, (const bf16*)(ws + WS_WPG), DM, Fn11{ws, args.out}); } SEAM(11);
    if (IN(12)) { p12_final(F, args); }
#undef IN
#undef SEAM
}

extern "C" void kernel_launch(void* const* d_in, const int* in_sizes, int n_in, void* d_out, int out_size, void* d_ws, size_t ws_size, hipStream_t stream) {
    static int grid = 0;
    if (grid == 0) {
        if (n_in != 27 || out_size != (int)O_END || ws_size < WS_END) { fprintf(stderr, "kernel_launch: unexpected shapes (n_in %d out %d ws %zu)\n", n_in, out_size, ws_size); grid = -1; return; }
        int dev = 0, cus = 0, per_cu = 0;
        if (hipGetDevice(&dev) != hipSuccess || hipDeviceGetAttribute(&cus, hipDeviceAttributeMultiprocessorCount, dev) != hipSuccess) { grid = -1; return; }
        if (hipFuncSetAttribute((const void*)mk_fwd, hipFuncAttributeMaxDynamicSharedMemorySize, LDS_BYTES) != hipSuccess) { grid = -1; return; }
        if (hipOccupancyMaxActiveBlocksPerMultiprocessor(&per_cu, (const void*)mk_fwd, NTHREADS, LDS_BYTES) != hipSuccess || per_cu < 1) { fprintf(stderr, "kernel_launch: occupancy query says %d\n", per_cu); grid = -1; (void)hipGetLastError(); return; }
        grid = cus;
    }
    if (grid < 0) return;
    if (hipMemsetAsync((char*)d_ws + WS_CTL, 0, CTL_ZERO_BYTES, stream) != hipSuccess) return;
    Args a{};
    for (int i = 0; i < 27; ++i) a.in[i] = (const float*)d_in[i];
    a.out = (float*)d_out; a.ws = (unsigned char*)d_ws;
#if MK_PER_PHASE
    for (int p = 0; p < N_PHASES; ++p) { a.ph_lo = p; a.ph_hi = p + 1; a.li = p; hipLaunchKernelGGL(mk_fwd, dim3(grid), dim3(NTHREADS), LDS_BYTES, stream, a); }
#else
    a.ph_lo = 0; a.ph_hi = N_PHASES; a.li = 0;
    hipLaunchKernelGGL(mk_fwd, dim3(grid), dim3(NTHREADS), LDS_BYTES, stream, a);
#endif
}
```

```cpp
#include <hip/hip_runtime.h>
#include <cstdio>
#include <cstdint>
#include <cmath>
namespace pg8 {
#define PG8_LAS __attribute__((address_space(3)))
typedef unsigned short bf16_t;
typedef short bf16x8 __attribute__((ext_vector_type(8)));
typedef float f32x4 __attribute__((ext_vector_type(4)));
typedef unsigned u32x4 __attribute__((ext_vector_type(4)));
constexpr int BM = 256, BK = 64, HALF = 128, HTB = HALF * BK * 2  , STAGE_BYTES = 8 * HTB, NXCD = 8;

__host__ __device__ __forceinline__ int lds_byte(int r, int c) { const int st = (r >> 4) * 2 + (c >> 5), rr = r & 15, cc = c & 31, ob = rr * 64 + cc * 2; return st * 1024 + (ob ^ (((ob >> 9) & 1) << 5)); }
__host__ __device__ __forceinline__ void stage_rc(int b, int& R, int& C) { const int st = b / 1024, sb = b % 1024, swz = sb ^ (((sb >> 9) & 1) << 5); R = (st >> 1) * 16 + swz / 64; C = (st & 1) * 32 + (swz % 64) / 2; }
__host__ __device__ __forceinline__ int perm32(int rho) { const int n = rho >> 4, i = rho & 15; return 8 * (i >> 2) + 4 * n + (i & 3); }

struct Unit { int pm, pn; };
struct Gemm { const bf16_t* A; const bf16_t* Bt; int lda, ldb, K, amask, ashift, astride;
    __device__ __forceinline__ const char* abase(const Unit& u) const { return (const char*)(A + (size_t)u.pm * BM * lda + (size_t)(((u.pn & amask) >> ashift) * astride)); }
    __device__ __forceinline__ const char* bbase(const Unit& u) const { return (const char*)(Bt + (size_t)u.pn * BM * ldb); } };

struct StaticOrder {
    int nM, nN, nwg, G, c, WGM;
    __host__ __device__ void init(int M, int N, int G_, int c_, int wgm = 4) { nM = M / BM; nN = N / BM; nwg = nM * nN; G = G_; c = c_; WGM = wgm; }
    __host__ __device__ bool next(int i, Unit& u) const {
        const long L = (long)i * G + c; if (L >= nwg) return false;
        int wgid = (int)L; { const int q = nwg / NXCD, r = nwg % NXCD, xcd = wgid % NXCD, off = wgid / NXCD; wgid = (xcd < r ? xcd * (q + 1) : r * (q + 1) + (xcd - r) * q) + off; }
        const int nig = WGM * nN, gid = wgid / nig, fm = gid * WGM, gsz = (nM - fm) < WGM ? (nM - fm) : WGM;
        u.pm = fm + ((wgid % nig) % gsz); u.pn = (wgid % nig) / gsz; return true;
    }
    __device__ __forceinline__ void a_ready(const Unit&) const {}
    __device__ __forceinline__ void done(const Unit&) const {}
};

typedef float f32x2_cv __attribute__((ext_vector_type(2)));
typedef __bf16 bf16x2_cv __attribute__((ext_vector_type(2)));
__device__ __forceinline__ unsigned cvt_pk_bf16(float lo, float hi) { f32x2_cv f = {lo, hi}; bf16x2_cv h = __builtin_convertvector(f, bf16x2_cv); return __builtin_bit_cast(unsigned, h); }
template <class Epi, class Sched, bool ALIGN_EPI = false, bool SP2 = false>
__device__ __forceinline__ void gemm_phase(PG8_LAS unsigned char* lds, const Gemm g, const Sched& S, const Epi& E) {
    const int lda = g.lda, ldb = g.ldb;
    int tid_ = threadIdx.x; asm volatile("" : "+v"(tid_));
    const int tid = tid_, wid = __builtin_amdgcn_readfirstlane(tid >> 6), lane = tid & 63, wr = wid >> 2, wc = wid & 3, fr = lane & 15, fq = lane >> 4;
    const int K = g.K, nt = K / BK;
    unsigned voffA[2], voffB[2];
#pragma unroll
    for (int i = 0; i < 2; ++i) { int R, C; stage_rc(tid * 16 + i * 8192, R, C); const int Rb = Epi::PERM ? ((R & ~31) + perm32(R & 31)) : R;
        voffA[i] = (unsigned)(R * lda + C) * 2u; voffB[i] = (unsigned)(Rb * ldb + C) * 2u; }
    const size_t kstep = (size_t)(BK * 2);
    const size_t hstepA = (size_t)HALF * lda * 2, hstepB = (size_t)HALF * ldb * 2;
    const unsigned ldsw = (unsigned)wid * 1024u;
    const int aoff = lds_byte(wr * 64 + fr, fq * 8), boff = lds_byte(wc * 32 + fr, fq * 8);
#define PG8_SA(b, h) (((b) * 2 + (h)) * HTB)
#define PG8_SB(b, h) ((4 + (b) * 2 + (h)) * HTB)
#define PG8_STAGE(bufoff, gbase, voff) do { _Pragma("unroll") for (int _i = 0; _i < 2; ++_i) \
        __builtin_amdgcn_global_load_lds((const unsigned*)((const char*)(gbase) + (voff)[_i]), (PG8_LAS unsigned*)(lds + (bufoff) + ldsw + _i * 8192), 16, 0, 0); } while (0)
#define PG8_LDA(dst, b, h) do { _Pragma("unroll") for (int m = 0; m < 4; ++m) _Pragma("unroll") for (int k = 0; k < 2; ++k) dst[m][k] = *(const PG8_LAS bf16x8*)(lds + PG8_SA(b, h) + aoff + m * 2048 + k * 1024); } while (0)
#define PG8_LDB(dst, b, h) do { _Pragma("unroll") for (int n = 0; n < 2; ++n) _Pragma("unroll") for (int k = 0; k < 2; ++k) dst[n][k] = *(const PG8_LAS bf16x8*)(lds + PG8_SB(b, h) + boff + n * 2048 + k * 1024); } while (0)
#define PG8_MMA(ai, bj, At, Bt) do { __builtin_amdgcn_s_setprio(1); _Pragma("unroll") for (int m = 0; m < 4; ++m) _Pragma("unroll") for (int n = 0; n < 2; ++n) _Pragma("unroll") for (int k = 0; k < 2; ++k) \
        acc[ai][bj][m][n] = __builtin_amdgcn_mfma_f32_16x16x32_bf16(Bt[n][k], At[m][k], acc[ai][bj][m][n], 0, 0, 0); __builtin_amdgcn_s_setprio(0); } while (0)
#define PG8_WAIT_V(n) asm volatile("s_waitcnt vmcnt(" #n ")" ::: "memory")
#define PG8_WAIT_L(n) asm volatile("s_waitcnt lgkmcnt(" #n ")" ::: "memory")
#define PG8_BAR __builtin_amdgcn_s_barrier()
#define PG8_SCHED __builtin_amdgcn_sched_barrier(0)
    Unit cur, nxt; int ui = 0;
    if (!S.next(0, cur)) return;
    f32x4 acc[2][2][4][2];
#pragma unroll
    for (int a = 0; a < 2; ++a)
#pragma unroll
        for (int b = 0; b < 2; ++b)
#pragma unroll
            for (int m = 0; m < 4; ++m)
#pragma unroll
                for (int n = 0; n < 2; ++n) acc[a][b][m][n] = (f32x4){0.f, 0.f, 0.f, 0.f};
    bf16x8 At[4][2], B0[2][2], B1[2][2];
    const char* cA = g.abase(cur); const char* cB = g.bbase(cur);
    S.a_ready(cur);
    if constexpr (SP2) {
        PG8_STAGE(PG8_SB(0, 0), cB, voffB); PG8_STAGE(PG8_SB(0, 1), cB + hstepB, voffB); PG8_STAGE(PG8_SA(0, 0), cA, voffA); PG8_STAGE(PG8_SA(0, 1), cA + hstepA, voffA);
        if (wr == 1) PG8_BAR;
        PG8_WAIT_V(2); PG8_BAR;
        PG8_STAGE(PG8_SB(1, 0), cB + kstep, voffB); PG8_STAGE(PG8_SA(1, 0), cA + kstep, voffA); PG8_STAGE(PG8_SB(1, 1), cB + hstepB + kstep, voffB);
        PG8_WAIT_V(6); PG8_BAR;
    } else {
        PG8_STAGE(PG8_SB(0, 0), cB, voffB); PG8_STAGE(PG8_SA(0, 0), cA, voffA); PG8_STAGE(PG8_SB(0, 1), cB + hstepB, voffB); PG8_STAGE(PG8_SA(0, 1), cA + hstepA, voffA);
        if (wr == 1) PG8_BAR;
        PG8_WAIT_V(4); PG8_BAR;
        PG8_STAGE(PG8_SB(1, 0), cB + kstep, voffB); PG8_STAGE(PG8_SA(1, 0), cA + kstep, voffA); PG8_STAGE(PG8_SB(1, 1), cB + hstepB + kstep, voffB);
        PG8_WAIT_V(6); PG8_BAR;
    }
    for (;;) {
        const bool has_next = S.next(ui + 1, nxt);
        const char* nA = has_next ? g.abase(nxt) : cA; const char* nB = has_next ? g.bbase(nxt) : cB;
        for (int t = 0; t < nt; t += 2) {
            const bool last = (t == nt - 2);
            const char* a1 = cA + (size_t)(t + 1) * kstep;
            const char* a2 = last ? nA : cA + (size_t)(t + 2) * kstep; const char* b2 = last ? nB : cB + (size_t)(t + 2) * kstep;
            const char* a3 = a2 + kstep; const char* b3 = b2 + kstep;
            if (last && has_next) S.a_ready(nxt);
            if constexpr (SP2) {
            PG8_LDB(B0, 0, 0); PG8_LDB(B1, 0, 1); PG8_SCHED; PG8_LDA(At, 0, 0); PG8_STAGE(PG8_SA(1, 1), a1 + hstepA, voffA);
            PG8_WAIT_V(8); PG8_WAIT_L(0); PG8_BAR; PG8_MMA(0, 0, At, B0); PG8_MMA(0, 1, At, B1); PG8_BAR; PG8_SCHED;
            PG8_LDA(At, 0, 1); PG8_STAGE(PG8_SB(0, 0), b2, voffB); PG8_STAGE(PG8_SB(0, 1), b2 + hstepB, voffB); PG8_STAGE(PG8_SA(0, 0), a2, voffA);
            PG8_WAIT_V(8); PG8_WAIT_L(0); PG8_BAR; PG8_MMA(1, 0, At, B0); PG8_MMA(1, 1, At, B1); PG8_BAR; PG8_SCHED;
            PG8_LDB(B0, 1, 0); PG8_LDB(B1, 1, 1); PG8_SCHED; PG8_LDA(At, 1, 0); PG8_STAGE(PG8_SA(0, 1), a2 + hstepA, voffA);
            PG8_WAIT_V(8); PG8_WAIT_L(0); PG8_BAR; PG8_MMA(0, 0, At, B0); PG8_MMA(0, 1, At, B1); PG8_BAR; PG8_SCHED;
            PG8_LDA(At, 1, 1); PG8_STAGE(PG8_SB(1, 0), b3, voffB); PG8_STAGE(PG8_SB(1, 1), b3 + hstepB, voffB); PG8_STAGE(PG8_SA(1, 0), a3, voffA);
            PG8_WAIT_V(8); PG8_WAIT_L(0); PG8_BAR; PG8_MMA(1, 0, At, B0); PG8_MMA(1, 1, At, B1); PG8_BAR; PG8_SCHED;
            } else {
            PG8_LDB(B0, 0, 0); PG8_SCHED; PG8_LDA(At, 0, 0); PG8_STAGE(PG8_SA(1, 1), a1 + hstepA, voffA);
            PG8_WAIT_L(8); PG8_BAR; PG8_WAIT_L(0); PG8_MMA(0, 0, At, B0); PG8_BAR; PG8_SCHED;
            PG8_LDB(B1, 0, 1); PG8_STAGE(PG8_SB(0, 0), b2, voffB);
            PG8_BAR; PG8_WAIT_L(0); PG8_MMA(0, 1, At, B1); PG8_BAR;
            PG8_LDA(At, 0, 1); PG8_STAGE(PG8_SA(0, 0), a2, voffA);
            PG8_BAR; PG8_WAIT_L(0); PG8_MMA(1, 0, At, B0); PG8_BAR; PG8_SCHED;
            PG8_STAGE(PG8_SB(0, 1), b2 + hstepB, voffB);
            PG8_WAIT_V(6); PG8_BAR; PG8_MMA(1, 1, At, B1); PG8_BAR;
            PG8_LDB(B0, 1, 0); PG8_SCHED; PG8_LDA(At, 1, 0); PG8_STAGE(PG8_SA(0, 1), a2 + hstepA, voffA);
            PG8_WAIT_L(8); PG8_BAR; PG8_WAIT_L(0); PG8_MMA(0, 0, At, B0); PG8_BAR; PG8_SCHED;
            PG8_LDB(B1, 1, 1); PG8_STAGE(PG8_SB(1, 0), b3, voffB);
            PG8_BAR; PG8_WAIT_L(0); PG8_MMA(0, 1, At, B1); PG8_BAR;
            PG8_LDA(At, 1, 1); PG8_STAGE(PG8_SA(1, 0), a3, voffA);
            PG8_BAR; PG8_WAIT_L(0); PG8_MMA(1, 0, At, B0); PG8_BAR; PG8_SCHED;
            PG8_STAGE(PG8_SB(1, 1), b3 + hstepB, voffB);
            PG8_WAIT_V(6); PG8_BAR; PG8_MMA(1, 1, At, B1); PG8_BAR;
            }
        }
        if constexpr (ALIGN_EPI) { if (wr == 0) PG8_BAR; }
        if constexpr (!Epi::AFTER_DRAIN) { E(acc, cur, wr, wc, fr, fq); S.done(cur); }
        if (!has_next) break;
#pragma unroll
        for (int a = 0; a < 2; ++a)
#pragma unroll
            for (int b = 0; b < 2; ++b)
#pragma unroll
                for (int m = 0; m < 4; ++m)
#pragma unroll
                    for (int n = 0; n < 2; ++n) acc[a][b][m][n] = (f32x4){0.f, 0.f, 0.f, 0.f};
        cur = nxt; cA = nA; cB = nB; ++ui;
        if constexpr (ALIGN_EPI) { if (wr == 1) PG8_BAR; }
    }
    PG8_WAIT_V(0);
    if constexpr (!ALIGN_EPI) { if (wr == 0) PG8_BAR; }
    PG8_BAR;
    if constexpr (Epi::AFTER_DRAIN) { E.fused(acc, cur, wr, wc, fr, fq, lds, wid, lane); S.done(cur); }
#undef PG8_SA
#undef PG8_SB
#undef PG8_STAGE
#undef PG8_LDA
#undef PG8_LDB
#undef PG8_MMA
#undef PG8_WAIT_V
#undef PG8_WAIT_L
#undef PG8_BAR
#undef PG8_SCHED
}

template <class Fn> struct EpiF {
    static constexpr bool PERM = true, AFTER_DRAIN = false;
    Fn f;
    __device__ __forceinline__ void operator()(const f32x4 (&acc)[2][2][4][2], const Unit& u, int wr, int wc, int fr, int fq) const {
        const int row0 = u.pm * BM + wr * 64 + fr, ct0 = wc * 32 + 8 * fq;
#pragma unroll
        for (int ai = 0; ai < 2; ++ai)
#pragma unroll
            for (int m = 0; m < 4; ++m)
#pragma unroll
                for (int bj = 0; bj < 2; ++bj) f(row0 + ai * HALF + m * 16, u.pn, ct0 + bj * HALF, acc[ai][bj][m][0], acc[ai][bj][m][1]);
    }
};
}

constexpr int NWAVES = 8, NTHREADS = 512;
constexpr int DM = 1024, MI = 2048, NSRC = 12296, PLE = 256;
constexpr int TP = 4096, TS = 32, BP = 4, BS = 32;
constexpr int NTOK_P = BP * TP, NTOK_S = BS * TS, NTOK = NTOK_P + NTOK_S;
constexpr int MH = 4, MHD = 512, HH = 8, HE = 128;
constexpr float EPS = 1e-6f;
constexpr size_t O_Y = 0, O_CONVP = 17825792, O_CP = 17850368, O_NP = 22044672, O_MP = 22052864, O_SP = 22052880,
                 O_CONVS = 22577168, O_CS = 22773776, O_NS = 56328208, O_MS = 56393744, O_SS = 56393872, O_END = 60588176;
constexpr size_t MiB = 1u << 20;
constexpr size_t WS_CTL = 0, CTL_ZERO_BYTES = 64 * 1024;
constexpr size_t WS_GATES = 1 * MiB, WS_PB = 2 * MiB;
constexpr size_t WS_WIN = 12 * MiB, WS_WQK = 36 * MiB + 512 * 1024, WS_WBRM = WS_WQK + 4 * MiB, WS_WBRH = WS_WBRM + 4 * MiB, WS_WOUT = WS_WBRH + 2 * MiB, WS_WPG = WS_WOUT + 2 * MiB, WS_WPLE = WS_WPG + 2 * MiB;
constexpr size_t WS_XN = 52 * MiB, WS_U = 86 * MiB, WS_V = 154 * MiB, WS_QH = 222 * MiB, WS_FH = 256 * MiB, WS_IH = 290 * MiB, WS_C = 324 * MiB, WS_K = 392 * MiB, WS_HO = 460 * MiB;
constexpr size_t WS_END = 510 * MiB;
constexpr size_t WS_Q = WS_U, WS_ZP = WS_V, WS_GHP = WS_QH, WS_GAP = WS_FH, WS_GBP = WS_IH, WS_HMN = WS_U, WS_OH = WS_K, WS_YA = WS_K + 34 * MiB, WS_Y = WS_C, WS_H1B = WS_C + 34 * MiB, WS_G2 = WS_HO;
constexpr size_t WS_H2B = WS_XN;
constexpr int CW_BAR = 4096;
constexpr int RING_OFF = 0, RING_BYTES = 131072, LDSCTL_OFF = RING_BYTES, MISC_OFF = LDSCTL_OFF + 320, LDS_BYTES = 147456;

#define GAS __attribute__((address_space(1)))
#define LAS __attribute__((address_space(3)))
typedef unsigned short bf16;
typedef unsigned v4u __attribute__((ext_vector_type(4)));
typedef unsigned v2u __attribute__((ext_vector_type(2)));
typedef float f32x4 __attribute__((ext_vector_type(4)));
typedef GAS unsigned gu32;
#define RLX_AGENT __ATOMIC_RELAXED, __HIP_MEMORY_SCOPE_AGENT
#define LDS_WAIT() asm volatile("s_waitcnt lgkmcnt(0)" ::: "memory")
#define VM_WAIT() asm volatile("s_waitcnt vmcnt(0)" ::: "memory")
__device__ __forceinline__ unsigned f2bf(float f) { unsigned u = __builtin_bit_cast(unsigned, f); return (u + 0x7fffu + ((u >> 16) & 1u)) >> 16; }
__device__ __forceinline__ unsigned pk2(float lo, float hi) { return f2bf(lo) | (f2bf(hi) << 16); }
__device__ __forceinline__ float bflo(unsigned w) { return __builtin_bit_cast(float, w << 16); }
__device__ __forceinline__ float bfhi(unsigned w) { return __builtin_bit_cast(float, w & 0xffff0000u); }
__device__ __forceinline__ float bf2f(bf16 h) { return __builtin_bit_cast(float, (unsigned)h << 16); }
__device__ __forceinline__ void unpack8(v4u w, float (&o)[8]) { o[0] = bflo(w.x); o[1] = bfhi(w.x); o[2] = bflo(w.y); o[3] = bfhi(w.y); o[4] = bflo(w.z); o[5] = bfhi(w.z); o[6] = bflo(w.w); o[7] = bfhi(w.w); }
__device__ __forceinline__ v4u pack8(const float (&o)[8]) { v4u w; w.x = pk2(o[0], o[1]); w.y = pk2(o[2], o[3]); w.z = pk2(o[4], o[5]); w.w = pk2(o[6], o[7]); return w; }
__device__ __forceinline__ float sigmoidf_(float x) { return __builtin_amdgcn_rcpf(1.0f + __expf(-x)); }
__device__ __forceinline__ float siluf_(float x) { return x * sigmoidf_(x); }
__device__ __forceinline__ float logsigmoidf_(float x) { return fminf(x, 0.f) - log1pf(__expf(-fabsf(x))); }

#define XB_TMO      128
#define XB_XCNT(j)  (256  + 64 * (j))
#define XB_XSUB(j)  (1280 + 64 * (j))
#define XB_XGEN(j)  (2304 + 64 * (j))
#define XB_TOP      3328
#define XB_TOPGEN   3392
#define XCD_BAR_WORDS 3456
#define XB_SPIN_CAP (1u << 18)
__device__ __forceinline__ unsigned xb_ld(unsigned* p)              { return __hip_atomic_load(p, __ATOMIC_RELAXED, __HIP_MEMORY_SCOPE_AGENT); }
__device__ __forceinline__ unsigned xb_add(unsigned* p, unsigned v) { return __hip_atomic_fetch_add(p, v, __ATOMIC_RELAXED, __HIP_MEMORY_SCOPE_AGENT); }
__device__ __forceinline__ unsigned xb_xcc_id() { return (unsigned)__builtin_amdgcn_s_getreg((3 << 11) | 20) & 0xFu; }
#define XB_SPIN(cond, bar) do { unsigned _sp = 0; while (cond) { __builtin_amdgcn_s_sleep(1); \
    if ((++_sp & 255u) == 0u) { if (xb_ld(&(bar)[XB_TMO])) break; if (_sp > XB_SPIN_CAP) { atomicAdd(&(bar)[XB_TMO], 1u); break; } } } } while (0)
struct XcdBarrier { unsigned* bar; unsigned x; volatile LAS unsigned* st; };
__device__ __forceinline__ XcdBarrier xcd_barrier_post(unsigned* bar, volatile LAS unsigned* st) {
    XcdBarrier b; b.bar = bar; b.x = xb_xcc_id(); b.st = st;
    if (threadIdx.x == 0) (void)xb_add(&bar[XB_XCNT(b.x)], 1u);
    return b;
}
__device__ __forceinline__ void xcd_barrier_complete(unsigned* bar, unsigned x, unsigned& nloc, unsigned& nx) {
    const unsigned G = gridDim.x * gridDim.y * gridDim.z;
    unsigned sum, cnt, mine, sp = 0u;
    for (;;) {
        sum = 0u; cnt = 0u; mine = 0u;
#pragma unroll
        for (unsigned j = 0; j < 16; ++j) { const unsigned c = xb_ld(&bar[XB_XCNT(j)]); sum += c; cnt += (c > 0u) ? 1u : 0u; mine = (j == x) ? c : mine; }
        if (sum == G) break;
        __builtin_amdgcn_s_sleep(1);
        if ((++sp & 255u) == 0u) { if (xb_ld(&bar[XB_TMO])) break; if (sp > XB_SPIN_CAP) { atomicAdd(&bar[XB_TMO], 1u); break; } }
    }
    nloc = mine > 0u ? mine : 1u; nx = cnt > 0u ? cnt : 1u;
}
__device__ __forceinline__ void xcd_barrier(const XcdBarrier& b) {
    asm volatile("s_waitcnt vmcnt(0)" ::: "memory");
    __syncthreads();
    if (threadIdx.x == 0) {
        unsigned* bar = b.bar;
        __builtin_amdgcn_s_waitcnt(0);
        unsigned nloc = b.st[0], nx = b.st[1];
        if (nloc == 0u) { xcd_barrier_complete(bar, b.x, nloc, nx); b.st[0] = nloc; b.st[1] = nx; }
        const unsigned old = xb_add(&bar[XB_XSUB(b.x)], 1u);
        const unsigned gen = old / nloc;
        if (old + 1u == (gen + 1u) * nloc) {
            __builtin_amdgcn_fence(__ATOMIC_RELEASE, "agent");
            asm volatile("s_waitcnt vmcnt(0)" ::: "memory");
            const unsigned og = xb_add(&bar[XB_TOP], 1u);
            const unsigned tg = og / nx;
            if (og + 1u == (tg + 1u) * nx) xb_add(&bar[XB_TOPGEN], 1u);
            else XB_SPIN(xb_ld(&bar[XB_TOPGEN]) == tg, bar);
            __builtin_amdgcn_fence(__ATOMIC_ACQUIRE, "agent");
            xb_add(&bar[XB_XGEN(b.x)], 1u);
            asm volatile("s_waitcnt vmcnt(0)" ::: "memory");
        } else {
            XB_SPIN(xb_ld(&bar[XB_XGEN(b.x)]) == gen, bar);
            __builtin_amdgcn_fence(__ATOMIC_ACQUIRE, "agent");
            asm volatile("s_waitcnt vmcnt(0)" ::: "memory");
        }
    }
    __syncthreads();
}

__device__ __forceinline__ void local_fence() {
    asm volatile("s_waitcnt vmcnt(0)" ::: "memory"); __syncthreads();
    if (threadIdx.x == 0) { __builtin_amdgcn_fence(__ATOMIC_ACQUIRE, "agent"); asm volatile("s_waitcnt vmcnt(0)" ::: "memory"); }
    __syncthreads();
}
struct Args { const float* in[27]; float* out; unsigned char* ws; int ph_lo, ph_hi, li, pad; };
enum { I_XP = 0, I_XS, I_SCONV, I_SC, I_SN, I_SM, I_SH, I_PP, I_PS, I_NORMG, I_WIN, I_BIG, I_BFG, I_CONVW, I_CONVB, I_WQM, I_WKM, I_MNORMG, I_MSKIP, I_WBRM, I_LB, I_HNORMG, I_WBRH, I_WOUT, I_WPLE, I_WPG, I_FINALG };
struct Frame { LAS unsigned char* lds; int tid, lane, wave, vcu, G; };

__device__ __forceinline__ float wave_sum(float v) {
#pragma unroll
    for (int o = 1; o < 64; o <<= 1) v += __shfl_xor(v, o);
    return v;
}
__device__ __forceinline__ const float* xrow(const Args& a, int m) { return m < NTOK_P ? a.in[I_XP] + (size_t)m * DM : a.in[I_XS] + (size_t)(m - NTOK_P) * DM; }

__device__ __forceinline__ void p0_transpose_item(const float* W, int pitch, int K, int ncols, bf16* WT, int row_off, LAS float* scr, int item, int lane) {
    const int nblk = ncols / 32, kb = item / nblk, nb = item % nblk, k0 = 64 * kb, n0 = 32 * nb;
#pragma unroll 8
    for (int i = 0; i < 32; ++i) { const int kk = 2 * i + (lane >> 5); scr[kk * 33 + (lane & 31)] = W[(size_t)(k0 + kk) * pitch + n0 + (lane & 31)]; }
    LDS_WAIT(); asm volatile("" ::: "memory");
    const int c = lane & 7;
#pragma unroll
    for (int j = 0; j < 4; ++j) { const int n = (lane >> 3) + 8 * j; const LAS float* s = scr + (8 * c) * 33 + n;
        v4u o; o.x = pk2(s[0 * 33], s[1 * 33]); o.y = pk2(s[2 * 33], s[3 * 33]); o.z = pk2(s[4 * 33], s[5 * 33]); o.w = pk2(s[6 * 33], s[7 * 33]);
        *(GAS v4u*)(WT + (size_t)(row_off + n0 + n) * K + k0 + 8 * c) = o; }
    LDS_WAIT(); asm volatile("" ::: "memory");
}
struct Seg { const float* W; int pitch, K, ncols; bf16* WT; int row_off, items; };
__device__ __forceinline__ Seg seg_info(int s, const Args& a) {
    Seg g; unsigned char* ws = a.ws;
    switch (s) {
    case 0: g = Seg{a.in[I_WIN] + 0,    NSRC, 1024, 4096, (bf16*)(ws + WS_WIN), 0,    0}; break;
    case 1: g = Seg{a.in[I_WIN] + 6152, NSRC, 1024, 3072, (bf16*)(ws + WS_WIN), 4096, 0}; break;
    case 2: g = Seg{a.in[I_WIN] + 4096, NSRC, 1024, 2048, (bf16*)(ws + WS_WIN), 7424, 0}; break;
    case 3: g = Seg{a.in[I_WIN] + 9224, NSRC, 1024, 3072, (bf16*)(ws + WS_WIN), 9472, 0}; break;
    case 4: case 5: case 6: case 7: g = Seg{a.in[I_WQM] + (size_t)(s - 4) * 262144, 512, 512, 512, (bf16*)(ws + WS_WQK), (s - 4) * 512, 0}; break;
    case 8: case 9: case 10: case 11: g = Seg{a.in[I_WKM] + (size_t)(s - 8) * 262144, 512, 512, 512, (bf16*)(ws + WS_WQK), 2048 + (s - 8) * 512, 0}; break;
    case 12: g = Seg{a.in[I_WBRM], 1024, 2048, 1024, (bf16*)(ws + WS_WBRM), 0, 0}; break;
    case 13: g = Seg{a.in[I_WBRH], 1024, 1024, 1024, (bf16*)(ws + WS_WBRH), 0, 0}; break;
    case 14: g = Seg{a.in[I_WOUT], 1024, 1024, 1024, (bf16*)(ws + WS_WOUT), 0, 0}; break;
    case 15: g = Seg{a.in[I_WPG],  1024, 1024, 1024, (bf16*)(ws + WS_WPG),  0, 0}; break;
    case 16: g = Seg{a.in[I_WPLE], 1024, 256,  1024, (bf16*)(ws + WS_WPLE), 0, 0}; break;
    default: g = Seg{a.in[I_WIN] + 6144, NSRC, 1024, 32,   (bf16*)(ws + WS_WIN), 7168, 0}; break;
    }
    g.items = (g.K / 64) * (g.ncols / 32);
    return g;
}
__device__ __forceinline__ void p0_pb(Frame& F, const Args& a, int i0, int istride) {
    bf16* PB = (bf16*)(a.ws + WS_PB);
    for (int i = i0; i < NTOK * 32; i += 4 * istride) {
        f32x4 p0[4], p1[4];
#pragma unroll
        for (int k = 0; k < 4; ++k) { const int ii = i + k * istride < NTOK * 32 ? i + k * istride : i; const int m = ii >> 5, c8 = (ii & 31) * 8;
            const float* src = (m < NTOK_P ? a.in[I_PP] + (size_t)m * PLE : a.in[I_PS] + (size_t)(m - NTOK_P) * PLE) + c8;
            p0[k] = *(const GAS f32x4*)src; p1[k] = *(const GAS f32x4*)(src + 4); }
#pragma unroll
        for (int k = 0; k < 4; ++k) { const int ii = i + k * istride; if (ii < NTOK * 32) { const int m = ii >> 5, c8 = (ii & 31) * 8;
            v4u w; w.x = pk2(p0[k].x, p0[k].y); w.y = pk2(p0[k].z, p0[k].w); w.z = pk2(p1[k].x, p1[k].y); w.w = pk2(p1[k].z, p1[k].w);
            *(GAS v4u*)(PB + (size_t)m * PLE + c8) = w; } }
    }
}
__device__ __forceinline__ void p0_prep(Frame& F, const Args& a) {
    LAS float* scr = (LAS float*)(F.lds + RING_OFF + F.wave * 16384);
    const int gw = F.vcu * NWAVES + F.wave, NGW = F.G * NWAVES;
    {
        int s = 0, base = 0; Seg g = seg_info(0, a);
        for (int f = gw; ; f += NGW) {
            while (s < 18 && f >= base + g.items) { base += g.items; ++s; if (s < 18) g = seg_info(s, a); }
            if (s >= 18) break;
            p0_transpose_item(g.W, g.pitch, g.K, g.ncols, g.WT, g.row_off, scr, f - base, F.lane);
        }
    }
    bf16* XN = (bf16*)(a.ws + WS_XN);
    const float* ng = a.in[I_NORMG];
    for (int m = gw; m < NTOK; m += NGW) {
        const GAS f32x4* xr = (const GAS f32x4*)xrow(a, m) + F.lane;
        f32x4 v[4]; float ss = 0.f;
#pragma unroll
        for (int j = 0; j < 4; ++j) { v[j] = xr[64 * j]; ss += (v[j].x * v[j].x + v[j].y * v[j].y) + (v[j].z * v[j].z + v[j].w * v[j].w); }
        const float rstd = 1.0f / sqrtf(wave_sum(ss) * (1.f / DM) + EPS);
        GAS v2u* o8 = (GAS v2u*)(XN + (size_t)m * DM) + F.lane;
#pragma unroll
        for (int j = 0; j < 4; ++j) {
            const f32x4 gg = *(const GAS f32x4*)(ng + 4 * F.lane + 256 * j);
            v[j] = v[j] * rstd * gg;
            v2u w; w.x = pk2(v[j].x, v[j].y); w.y = pk2(v[j].z, v[j].w); o8[64 * j] = w;
        }
    }
    if (F.G != 256) p0_pb(F, a, F.vcu * NTHREADS + F.tid, F.G * NTHREADS);
}

__device__ __forceinline__ void p2_conv(Frame& F, const Args& a) {
    const bf16* U = (const bf16*)(a.ws + WS_U); bf16* C = (bf16*)(a.ws + WS_C);
    const float* cw = a.in[I_CONVW]; const float* cb = a.in[I_CONVB]; const float* sconv = a.in[I_SCONV];
    const int ch = (F.tid & 255) * 8;
    float wv[4][8], bv[8];
#pragma unroll
    for (int j = 0; j < 4; ++j) { const f32x4 w0 = *(const GAS f32x4*)(cw + (size_t)j * MI + ch), w1 = *(const GAS f32x4*)(cw + (size_t)j * MI + ch + 4);
        wv[j][0] = w0.x; wv[j][1] = w0.y; wv[j][2] = w0.z; wv[j][3] = w0.w; wv[j][4] = w1.x; wv[j][5] = w1.y; wv[j][6] = w1.z; wv[j][7] = w1.w; }
    { const f32x4 b0 = *(const GAS f32x4*)(cb + ch), b1 = *(const GAS f32x4*)(cb + ch + 4); bv[0] = b0.x; bv[1] = b0.y; bv[2] = b0.z; bv[3] = b0.w; bv[4] = b1.x; bv[5] = b1.y; bv[6] = b1.z; bv[7] = b1.w; }
    const int i0 = F.vcu * NTHREADS + F.tid, istr = F.G * NTHREADS, iend = (NTOK / 4) * 256;
    v4u raw[7], nxt[7];
#define CV_LOAD(dst, ii) do { const int tk_ = ((ii) >> 8) * 4; _Pragma("unroll") for (int j = 0; j < 7; ++j) { int tr_ = tk_ - 3 + j; tr_ = tr_ < 0 ? 0 : tr_; dst[j] = *(const GAS v4u*)(U + (size_t)tr_ * MI + ch); } } while (0)
    if (i0 < iend) CV_LOAD(raw, i0);
    for (int i = i0; i < iend; i += istr) {
        { const int in_ = (i + istr < iend) ? i + istr : i; CV_LOAD(nxt, in_); }
        const int tok = (i >> 8) * 4;
        const bool smp = tok >= NTOK_P;
        const int b = smp ? (tok - NTOK_P) >> 5 : tok >> 12, t = smp ? (tok - NTOK_P) & 31 : tok & 4095;
        float u[7][8];
#pragma unroll
        for (int j = 0; j < 7; ++j) {
            unpack8(raw[j], u[j]);
            if (j < 3 && t == 0) {
                if (smp) { const float* sp = sconv + (size_t)(b * 3 + j) * MI + ch; const f32x4 s0 = *(const GAS f32x4*)sp, s1 = *(const GAS f32x4*)(sp + 4);
                    u[j][0] = s0.x; u[j][1] = s0.y; u[j][2] = s0.z; u[j][3] = s0.w; u[j][4] = s1.x; u[j][5] = s1.y; u[j][6] = s1.z; u[j][7] = s1.w; }
                else {
#pragma unroll
                    for (int e = 0; e < 8; ++e) u[j][e] = 0.f; }
            }
        }
        const int tl = smp ? TS : TP;
#pragma unroll
        for (int q = 0; q < 4; ++q) {
            float acc[8];
#pragma unroll
            for (int e = 0; e < 8; ++e) acc[e] = siluf_(bv[e] + u[q][e] * wv[0][e] + u[q + 1][e] * wv[1][e] + u[q + 2][e] * wv[2][e] + u[q + 3][e] * wv[3][e]);
            *(GAS v4u*)(C + (size_t)(tok + q) * MI + ch) = pack8(acc);
            if (t + q >= tl - 3) {
                float* dst = a.out + (smp ? O_CONVS : O_CONVP) + (size_t)(b * 3 + (t + q - (tl - 3))) * MI + ch;
                *(GAS f32x4*)dst = (f32x4){u[q + 3][0], u[q + 3][1], u[q + 3][2], u[q + 3][3]}; *(GAS f32x4*)(dst + 4) = (f32x4){u[q + 3][4], u[q + 3][5], u[q + 3][6], u[q + 3][7]};
            }
        }
#pragma unroll
        for (int j = 0; j < 7; ++j) raw[j] = nxt[j];
    }
#undef CV_LOAD
}

typedef short s16x4 __attribute__((ext_vector_type(4)));
typedef short bf16x8 __attribute__((ext_vector_type(8)));
typedef float f32x16 __attribute__((ext_vector_type(16)));
typedef float f32x2 __attribute__((ext_vector_type(2)));
typedef __bf16 bf16x2v __attribute__((ext_vector_type(2)));
#define MFMA32(a, b, c) __builtin_amdgcn_mfma_f32_32x32x16_bf16((a), (b), (c), 0, 0, 0)
__device__ __forceinline__ unsigned pkc(float lo, float hi) { f32x2 f = {lo, hi}; bf16x2v h = __builtin_convertvector(f, bf16x2v); return __builtin_bit_cast(unsigned, h); }
__device__ __forceinline__ int crow(int reg, int hh) { return (reg & 3) + 8 * (reg >> 2) + 4 * hh; }
__device__ __forceinline__ bf16x8 pack_step(const f32x16& x, int s) {
    v4u p; p.x = pkc(x[8 * s], x[8 * s + 1]); p.y = pkc(x[8 * s + 2], x[8 * s + 3]); p.z = pkc(x[8 * s + 4], x[8 * s + 5]); p.w = pkc(x[8 * s + 6], x[8 * s + 7]);
    return __builtin_bit_cast(bf16x8, p);
}
__device__ __forceinline__ s16x4 trr(LAS unsigned char* p) { return __builtin_amdgcn_ds_read_tr16_b64_v4i16((LAS s16x4*)p); }
__device__ __forceinline__ bf16x8 tr_frag(LAS unsigned char* img, int pitch, int k0, int c0, int lane) {
    const int hh = lane >> 5, blk = (lane >> 4) & 1, qq = (lane & 15) >> 2, pp = lane & 3;
    LAS unsigned char* p = img + (k0 + 8 * hh + qq) * pitch + (c0 + 16 * blk + 4 * pp) * 2;
    const s16x4 lo = trr(p), hi = trr(p + 4 * pitch);
    return __builtin_shufflevector(lo, hi, 0, 1, 2, 3, 4, 5, 6, 7);
}

constexpr size_t WS_HA = 498 * MiB + 512 * 1024, WS_EGL = 507 * MiB;
constexpr size_t WS_PT = 494 * MiB, WS_SC = 10 * MiB + 512 * 1024, WS_DENI = 11 * MiB + 256 * 1024;

template <int CTRL, int ROWMASK> __device__ __forceinline__ float dpp_f(float ident, float v) {
    return __builtin_bit_cast(float, __builtin_amdgcn_update_dpp(__builtin_bit_cast(int, ident), __builtin_bit_cast(int, v), CTRL, ROWMASK, 0xF, false)); }
__device__ __forceinline__ float wave_scan_add(float v) {
    v += dpp_f<0x111, 0xF>(0.f, v); v += dpp_f<0x112, 0xF>(0.f, v); v += dpp_f<0x114, 0xF>(0.f, v); v += dpp_f<0x118, 0xF>(0.f, v);
    v += dpp_f<0x142, 0xA>(0.f, v); v += dpp_f<0x143, 0xC>(0.f, v); return v; }
__device__ __forceinline__ float wave_scan_max(float v) {
    const float NI = -3.0e38f;
    v = fmaxf(v, dpp_f<0x111, 0xF>(NI, v)); v = fmaxf(v, dpp_f<0x112, 0xF>(NI, v)); v = fmaxf(v, dpp_f<0x114, 0xF>(NI, v)); v = fmaxf(v, dpp_f<0x118, 0xF>(NI, v));
    v = fmaxf(v, dpp_f<0x142, 0xA>(NI, v)); v = fmaxf(v, dpp_f<0x143, 0xC>(NI, v)); return v; }
__device__ __forceinline__ void p2_scan(Frame& F, const Args& a) {
    const int lane = F.lane, w = F.wave;
    const float* GATES = (const float*)(a.ws + WS_GATES); float* SC = (float*)(a.ws + WS_SC);
    LAS float* red = (LAS float*)(F.lds + RING_OFF);
    const float NEG = -3.0e38f;
    for (int sh = F.vcu; sh < BP * MH; sh += F.G) {
        const int b = sh >> 2, h = sh & 3, tokw = b * TP + 512 * w;
        float lf[8], ig[8], bl[8], lm[8];
#pragma unroll
        for (int j = 0; j < 8; ++j) { const size_t tk = (size_t)(tokw + 64 * j + lane) * 8; lf[j] = GATES[tk + 4 + h]; ig[j] = GATES[tk + h]; }
        float base = 0.f, run = NEG;
#pragma unroll
        for (int j = 0; j < 8; ++j) {
            const float bg = base + wave_scan_add(lf[j]);
            const float mr = fmaxf(run, wave_scan_max(ig[j] - bg));
            bl[j] = bg; lm[j] = mr;
            base = __builtin_bit_cast(float, __builtin_amdgcn_readlane(__builtin_bit_cast(int, bg), 63)); run = __builtin_bit_cast(float, __builtin_amdgcn_readlane(__builtin_bit_cast(int, mr), 63));
        }
        __syncthreads();
        if (lane == 0) { red[2 * w] = base; red[2 * w + 1] = run; }
        __syncthreads();
        float cb = 0.f, cr = 0.f;
        for (int i = 0; i < w; ++i) { cr = fmaxf(cr, red[2 * i + 1] - cb); cb += red[2 * i]; }
#pragma unroll
        for (int j = 0; j < 8; ++j) { const size_t tk = (size_t)(tokw + 64 * j + lane) * 8; const float bg = cb + bl[j], mr = fmaxf(cr, lm[j] - cb);
            SC[tk + h * 2] = bg; SC[tk + h * 2 + 1] = bg + mr; }
    }
    const int gw = (F.vcu - BP * MH) * NWAVES + w, NGW = F.G * NWAVES;
    for (int sh = gw < 0 ? gw + NGW : gw; sh < BS * MH; sh += NGW) {
        const int b = sh >> 2, h = sh & 3, tok0 = NTOK_P + b * TS;
        const float minit = a.in[I_SM][b * MH + h];
        const int t = lane & 31; const float* G = GATES + (size_t)(tok0 + t) * 8;
        const float lf = G[4 + h], ig = G[h];
        float incl = lf;
#pragma unroll
        for (int o = 1; o < 32; o <<= 1) { const float v = __shfl_up(incl, o); if (t >= o) incl += v; }
        float pm = ig - incl;
#pragma unroll
        for (int o = 1; o < 32; o <<= 1) { const float v = __shfl_up(pm, o); if (t >= o) pm = fmaxf(pm, v); }
        if (lane < 32) { float* o = SC + (size_t)(tok0 + t) * 8 + h * 2; o[0] = incl; o[1] = incl + fmaxf(minit, pm); }
    }
}

template <int KD, bool DECAY>
__device__ __forceinline__ void score_tiles(Frame& F, const bf16* Qb, const bf16* Kb, int ld, int nunits, int nprompt, int nh, bf16* OUT, const float* GATES, const float* SC, int u0, int ustride) {
    constexpr int QP = KD * 2 + 16, NPC = KD / 128;
    constexpr int L_Q = 0, L_K = 32 * QP, L_RED = 2 * 32 * QP, L_TAB = L_RED + 32768;
    const int tid = F.tid, lane = F.lane, w = F.wave, r = lane & 31, hh = lane >> 5;
    LAS unsigned char* lds = F.lds + RING_OFF;
    LAS float* tab = (LAS float*)(lds + L_TAB);
    v4u rq[NPC], rk[NPC]; float t0 = 0.f, t1 = 0.f;
    auto decode = [&](int u, int& hcol, int& tok0, int& h) {
        if (u < nprompt) { const int bh = u >> 7, c = u & 127; h = bh % nh; tok0 = (bh / nh) * TP + c * 32; }
        else { const int bh = u - nprompt; h = bh % nh; tok0 = NTOK_P + (bh / nh) * TS; }
        hcol = h * KD; };
#define ST_LOAD(u) do { int hcol_, tok0_, h_; decode((u), hcol_, tok0_, h_); \
        _Pragma("unroll") for (int i = 0; i < NPC; ++i) { const int piece = tid + 512 * i, row = piece / (KD / 8), c16 = piece % (KD / 8); const size_t off = (size_t)(tok0_ + row) * ld + hcol_ + c16 * 8; \
            rq[i] = *(const GAS v4u*)(Qb + off); rk[i] = *(const GAS v4u*)(Kb + off); } \
        if (DECAY && tid < 32) { const size_t tk = (size_t)(tok0_ + tid) * 8; const float Bg = SC[tk + h_ * 2], m = SC[tk + h_ * 2 + 1], ig = GATES[tk + h_]; t0 = Bg - m; t1 = ig - Bg; } } while (0)
    int u = u0;
    if (u < nunits) ST_LOAD(u);
    for (; u < nunits; u += ustride) {
#pragma unroll
        for (int i = 0; i < NPC; ++i) { const int piece = tid + 512 * i, row = piece / (KD / 8), c16 = piece % (KD / 8);
            *(LAS v4u*)(lds + L_Q + row * QP + c16 * 16) = rq[i]; *(LAS v4u*)(lds + L_K + row * QP + c16 * 16) = rk[i]; }
        if (DECAY && tid < 32) { tab[tid] = t0; tab[32 + tid] = t1; }
        __syncthreads();
        if (u + ustride < nunits) ST_LOAD(u + ustride);
        f32x16 acc;
#pragma unroll
        for (int i = 0; i < 16; ++i) acc[i] = 0.f;
#pragma unroll
        for (int ks = 0; ks < KD / 128; ++ks) {
            const int d0 = (KD / 8) * w + 16 * ks + 8 * hh;
            const bf16x8 af = *(const LAS bf16x8*)(lds + L_Q + r * QP + d0 * 2), bfr = *(const LAS bf16x8*)(lds + L_K + r * QP + d0 * 2);
            acc = MFMA32(af, bfr, acc);
        }
        { LAS float* red = (LAS float*)(lds + L_RED) + w * 1024;
#pragma unroll
          for (int g = 0; g < 16; ++g) red[g * 64 + lane] = acc[g]; }
        __syncthreads();
#pragma unroll
        for (int gg = 0; gg < 2; ++gg) {
            const int g = 2 * w + gg; float v = 0.f;
#pragma unroll
            for (int k = 0; k < 8; ++k) v += ((const LAS float*)(lds + L_RED))[k * 1024 + g * 64 + lane];
            const int t = crow(g, hh);
            if (DECAY) v *= __expf(tab[t] + tab[32 + r]);
            OUT[(size_t)u * 1024 + t * 32 + r] = (bf16)(pkc((r <= t) ? v : 0.f, 0.f) & 0xffffu);
        }
        __syncthreads();
    }
#undef ST_LOAD
}
__device__ __forceinline__ void p4_atiles(Frame& F, const Args& a, int u0, int ustride) {
    score_tiles<128, false>(F, (const bf16*)(a.ws + WS_QH), (const bf16*)(a.ws + WS_FH), DM, 4352, 4096, HH, (bf16*)(a.ws + WS_HA), nullptr, nullptr, u0, ustride);
}
__device__ __forceinline__ void p4_tiles(Frame& F, const Args& a) {
    score_tiles<512, true>(F, (const bf16*)(a.ws + WS_Q), (const bf16*)(a.ws + WS_K), MI, 2176, 2048, MH, (bf16*)(a.ws + WS_PT), (const float*)(a.ws + WS_GATES), (const float*)(a.ws + WS_SC), (int)blockIdx.x, F.G);
    if (F.G != 256) p4_atiles(F, a, (int)blockIdx.x, F.G);
}

__device__ __forceinline__ void p2_hprep(Frame& F, const Args& a) {
    bf16* QH = (bf16*)(a.ws + WS_QH); bf16* FH = (bf16*)(a.ws + WS_FH); float* EGL = (float*)(a.ws + WS_EGL);
    for (int i = F.vcu * NTHREADS + F.tid; i < (NTOK / 32) * (DM / 4); i += F.G * NTHREADS) {
        const int ch = i >> 8, col = (i & 255) * 4;
        const f32x4 l0 = *(const GAS f32x4*)(a.in[I_LB] + col), l1 = *(const GAS f32x4*)(a.in[I_LB] + DM + col);
        float lb[4], eg[4];
#pragma unroll
        for (int e = 0; e < 4; ++e) { lb[e] = __builtin_amdgcn_rcpf(1.0f + __expf(l1[e] - l0[e])); eg[e] = 1.0f; }
        size_t off = (size_t)ch * 32 * DM + col;
#pragma unroll 4
        for (int t = 0; t < 32; ++t, off += DM) {
            const v2u fw = *(const GAS v2u*)(FH + off), qw = *(const GAS v2u*)(QH + off);
            const float fl[4] = {bflo(fw.x), bfhi(fw.x), bflo(fw.y), bfhi(fw.y)}, ql[4] = {bflo(qw.x), bfhi(qw.x), bflo(qw.y), bfhi(qw.y)};
            float qo[4], ko[4];
#pragma unroll
            for (int e = 0; e < 4; ++e) {
                const float sg = sigmoidf_(fl[e]);
                eg[e] *= lb[e] + (1.0f - lb[e]) * sg;
                qo[e] = siluf_(ql[e]) * eg[e];
                ko[e] = (1.0f - lb[e]) * (1.0f - sg) * __builtin_amdgcn_rcpf(eg[e]);
            }
            v2u qv, kv; qv.x = pkc(qo[0], qo[1]); qv.y = pkc(qo[2], qo[3]); kv.x = pkc(ko[0], ko[1]); kv.y = pkc(ko[2], ko[3]);
            *(GAS v2u*)(QH + off) = qv; *(GAS v2u*)(FH + off) = kv;
        }
        *(GAS f32x4*)(EGL + (size_t)ch * DM + col) = (f32x4){eg[0], eg[1], eg[2], eg[3]};
    }
}
#ifndef TPROBE
#define TPROBE 0
#endif
#define REC_BAR() do { asm volatile("s_waitcnt lgkmcnt(0)" ::: "memory"); __builtin_amdgcn_s_barrier(); asm volatile("" ::: "memory"); } while (0)
template <bool HG>
__device__ __forceinline__ void rec_unit(Frame& F, const Args& a, int unit) {
    constexpr int KD = HG ? 128 : 512, NT = KD / 64, DW = KD / 2, NSL = HG ? 2 : 9, NPROMPT = HG ? 64 : 144;
    constexpr int QP = KD * 2 + 8, KP = KD * 2 + 64, VP = 192, PPI = 80, HP = 144, LDT = HG ? DM : MI;
    constexpr int NPQ = KD / 64, PPR = KD / 8;
    constexpr int L_Q = 0, L_K = L_Q + 32 * QP, L_V = L_K + 32 * KP, L_VW = L_V + 32 * VP, L_P = L_VW + 32 * VP, L_RED = L_P + 32 * PPI, L_SC = L_RED + 16384, L_H = L_SC + 2048, L_END = L_H + 32 * HP;
    static_assert(L_END <= RING_BYTES && (L_K % 16) == 0 && (L_V % 16) == 0 && (L_RED % 16) == 0 && (L_H % 16) == 0, "rec LDS map");
    const bool smp = unit >= NPROMPT; const int uu = smp ? unit - NPROMPT : unit;
    const int bh = uu / NSL, es = uu - bh * NSL; const bool den = !HG && es == 8;
    const int b = HG ? bh >> 3 : bh >> 2, h = HG ? bh & 7 : bh & 3;
    const int T = smp ? TS : TP, tok0 = smp ? NTOK_P + b * TS : b * TP, nsteps = T / 32;
    const int tid = F.tid, lane = F.lane, w = F.wave, r = lane & 31, hh = lane >> 5;
    LAS unsigned char* lds = F.lds + RING_OFF;
    LAS float* LS = (LAS float*)(lds + L_SC);
    const bf16* Qb = (const bf16*)(a.ws + (HG ? WS_QH : WS_Q)); const bf16* Kb = (const bf16*)(a.ws + (HG ? WS_FH : WS_K)); const bf16* Vb = (const bf16*)(a.ws + (HG ? WS_IH : WS_V));
    const bf16* PTb = (const bf16*)(a.ws + (HG ? WS_HA : WS_PT)) + (size_t)(smp ? (HG ? 4096 : 2048) + bh : bh * 128) * 1024;
    bf16* OUTb = HG ? (bf16*)(a.ws + WS_HO) : (bf16*)a.out;
    const unsigned colq = (unsigned)h * KD, colv = (unsigned)h * KD + (unsigned)(es & 7) * 64u;
    REC_BAR();
    if (w < 4) {
        const int we = w & 1, wd = w >> 1, el0 = 32 * we, dt0 = DW * wd;
        int ln = lane; asm volatile("" : "+v"(ln)); const int r_ = ln & 31, hh_ = ln >> 5, lb = ln, hb_ = hh_;
        f32x16 X[NT];
        if (smp && HG) {
            const float* s0 = a.in[I_SH] + ((size_t)bh * HE + dt0 + 4 * hh) * HE + es * 64 + el0 + r;
#pragma unroll
            for (int i = 0; i < NT; ++i)
#pragma unroll
                for (int g = 0; g < 16; ++g) X[i][g] = s0[(size_t)(32 * i + (g & 3) + 8 * (g >> 2)) * HE];
        } else if (smp) {
            const float* c0 = den ? a.in[I_SN] + (size_t)bh * MHD + dt0 + 4 * hh : a.in[I_SC] + ((size_t)bh * MHD + es * 64 + el0 + r) * MHD + dt0 + 4 * hh;
#pragma unroll
            for (int i = 0; i < NT; ++i) {
#pragma unroll
                for (int g = 0; g < 4; ++g) { const f32x4 v = *(const GAS f32x4*)(c0 + 32 * i + 8 * g); X[i][4 * g] = v.x; X[i][4 * g + 1] = v.y; X[i][4 * g + 2] = v.z; X[i][4 * g + 3] = v.w; }
            }
            if (den && !(we == 0 && r == 0)) {
#pragma unroll
                for (int i = 0; i < NT; ++i)
#pragma unroll
                    for (int g = 0; g < 16; ++g) X[i][g] = 0.f;
            }
        } else {
#pragma unroll
            for (int i = 0; i < NT; ++i)
#pragma unroll
                for (int g = 0; g < 16; ++g) X[i][g] = 0.f;
        }
        REC_BAR();
        unsigned long long tp_sum = 0ull, tp_t = 0ull; const bool tp_on = TPROBE && !HG && den && !smp && we == 0;
        for (int step = 0; step < nsteps; ++step) {
            LAS float* ls = LS + (step & 1) * 256;
            if (TPROBE == 1 && tp_on && step >= 8) tp_t = __builtin_amdgcn_s_memtime();
            const bf16x8 vb0 = tr_frag(lds + L_V, VP, 0, el0, ln), vb1 = tr_frag(lds + L_V, VP, 16, el0, ln);
            constexpr int NB = NT > 4 ? 4 : NT;
            f32x16 acc;
#pragma unroll
            for (int g = 0; g < 16; ++g) acc[g] = 0.f;
#pragma unroll
            for (int ib = 0; ib < NT; ib += NB) {
                bf16x8 pa[NB][2];
#pragma unroll
                for (int i = 0; i < NB; ++i)
#pragma unroll
                    for (int s = 0; s < 2; ++s) {
                        LAS unsigned char* qa = lds + L_Q + r_ * QP + (dt0 + 32 * (ib + i) + 16 * s + 4 * hh_) * 2;
                        const s16x4 lo = *(const LAS s16x4*)qa, hi = *(const LAS s16x4*)(qa + 16);
                        pa[i][s] = __builtin_shufflevector(lo, hi, 0, 1, 2, 3, 4, 5, 6, 7);
                    }
                __builtin_amdgcn_sched_barrier(0);
#pragma unroll
                for (int i = 0; i < NB; ++i)
#pragma unroll
                    for (int s = 0; s < 2; ++s) acc = MFMA32(pa[i][s], pack_step(X[ib + i], s), acc);
                __builtin_amdgcn_sched_barrier(0);
            }
            if (!HG) {
#pragma unroll
                for (int g = 0; g < 16; ++g) acc[g] *= ls[crow(g, hh_)];
            }
            if (wd == 0) {
                const bf16x8 p0 = *(const LAS bf16x8*)(lds + L_P + r_ * PPI + (8 * hh_) * 2), p1 = *(const LAS bf16x8*)(lds + L_P + r_ * PPI + (16 + 8 * hh_) * 2);
                acc = MFMA32(p0, vb0, acc); acc = MFMA32(p1, vb1, acc);
            }
            { LAS float* red = (LAS float*)(lds + L_RED) + w * 1024;
#pragma unroll
              for (int g = 0; g < 16; ++g) red[g * 64 + ln] = acc[g]; }
            if (TPROBE == 1 && tp_on && step >= 8) tp_sum += __builtin_amdgcn_s_memtime() - tp_t;
            if (TPROBE == 2 && tp_on && step >= 8) tp_t = __builtin_amdgcn_s_memtime();
            REC_BAR();
            if (TPROBE == 2 && tp_on && step >= 8) tp_sum += __builtin_amdgcn_s_memtime() - tp_t;
            if (TPROBE == 3 && tp_on && step >= 8) tp_t = __builtin_amdgcn_s_memtime();
            if (!HG) {
                const bf16x8 vw0 = tr_frag(lds + L_VW, VP, 0, el0, lb), vw1 = tr_frag(lds + L_VW, VP, 16, el0, lb);
                const float dec = ls[64];
                constexpr int NB = NT > 4 ? 4 : NT;
#pragma unroll
                for (int ib = 0; ib < NT; ib += NB) {
                    bf16x8 ka[NB][2];
#pragma unroll
                    for (int i = 0; i < NB; ++i) { ka[i][0] = tr_frag(lds + L_K, KP, 0, dt0 + 32 * (ib + i), lb); ka[i][1] = tr_frag(lds + L_K, KP, 16, dt0 + 32 * (ib + i), lb); }
                    __builtin_amdgcn_sched_barrier(0);
#pragma unroll
                    for (int i = 0; i < NB; ++i) {
                        X[ib + i] = X[ib + i] * dec;
                        X[ib + i] = MFMA32(ka[i][0], vw0, X[ib + i]); X[ib + i] = MFMA32(ka[i][1], vw1, X[ib + i]);
                    }
                    __builtin_amdgcn_sched_barrier(0);
                }
            } else {
#pragma unroll
                for (int i = 0; i < NT; ++i) {
                    const bf16x8 ka0 = tr_frag(lds + L_K, KP, 0, dt0 + 32 * i, lb), ka1 = tr_frag(lds + L_K, KP, 16, dt0 + 32 * i, lb);
                    X[i] = MFMA32(ka0, vb0, X[i]); X[i] = MFMA32(ka1, vb1, X[i]);
#pragma unroll
                    for (int g = 0; g < 16; ++g) X[i][g] *= ls[128 + dt0 + 32 * i + crow(g, hb_)];
                }
            }
            if (TPROBE == 3 && tp_on && step >= 8) tp_sum += __builtin_amdgcn_s_memtime() - tp_t;
            if (TPROBE == 4 && tp_on && step >= 8) tp_t = __builtin_amdgcn_s_memtime();
            REC_BAR();
            if (TPROBE == 4 && tp_on && step >= 8) tp_sum += __builtin_amdgcn_s_memtime() - tp_t;
        }
        if (TPROBE && tp_on) {
            const float avg = (float)tp_sum / 120.0f; const float eps = sqrtf(1.0e-4f * (1.0f + fminf(avg, 7000.f) / 2000.0f));
#pragma unroll
            for (int i = 0; i < NT; ++i)
#pragma unroll
                for (int g = 0; g < 16; ++g) X[i][g] *= (1.0f + eps);
        }
        if (HG) {
            float* so = a.out + (smp ? O_SS : O_SP) + ((size_t)bh * HE + dt0 + 4 * hh) * HE + es * 64 + el0 + r;
#pragma unroll
            for (int i = 0; i < NT; ++i)
#pragma unroll
                for (int g = 0; g < 16; ++g) so[(size_t)(32 * i + (g & 3) + 8 * (g >> 2)) * HE] = X[i][g];
        } else if (!den || (we == 0 && r == 0)) {
            float* co = den ? a.out + (smp ? O_NS : O_NP) + (size_t)bh * MHD + dt0 + 4 * hh : a.out + (smp ? O_CS : O_CP) + ((size_t)bh * MHD + es * 64 + el0 + r) * MHD + dt0 + 4 * hh;
#pragma unroll
            for (int i = 0; i < NT; ++i)
#pragma unroll
                for (int g = 0; g < 4; ++g) *(GAS f32x4*)(co + 32 * i + 8 * g) = (f32x4){X[i][4 * g], X[i][4 * g + 1], X[i][4 * g + 2], X[i][4 * g + 3]};
        }
    } else {
        __builtin_amdgcn_s_setprio(2);
        int ht_ = tid - 256; asm volatile("" : "+v"(ht_));
        const int ht = ht_, hx = ht_, hw = w - 4;
        const float* GATES = (const float*)(a.ws + WS_GATES); const float* SC = (const float*)(a.ws + WS_SC); const float* EGL = (const float*)(a.ws + WS_EGL);
        float* DEN = (float*)(a.ws + WS_DENI);
        const GAS unsigned char* Qg = (const GAS unsigned char*)Qb; const GAS unsigned char* Kg = (const GAS unsigned char*)Kb; const GAS unsigned char* Vg = (const GAS unsigned char*)Vb; const GAS unsigned char* Pg = (const GAS unsigned char*)PTb;
        v4u rq[NPQ], rk[NPQ], rvc = {0u, 0u, 0u, 0u}, rvn = {0u, 0u, 0u, 0u}, rp = {0u, 0u, 0u, 0u}; float sBg = 0.f, sm = 0.f, sig = 0.f, seg = 0.f;
        float Bprev = 0.f, mprev = (!HG && smp) ? a.in[I_SM][bh] : 0.f;
        const unsigned qoff0 = (unsigned)(tok0 + ht / PPR) * LDT + colq + (unsigned)(ht % PPR) * 8u;
        const unsigned voff0 = (unsigned)(tok0 + (ht >> 3)) * LDT + colv + (unsigned)(ht & 7) * 8u;
        const unsigned poff0 = (unsigned)((ht & 127) >> 2) * 32u + (unsigned)(ht & 3) * 8u;
        constexpr unsigned RSTEP = (256 / PPR) * LDT;
        unsigned pfq = 0u, pfk = 0u, pfacc = 0u;
        const unsigned pfoff0 = (unsigned)(tok0 + (ht >> 3)) * LDT + colq + (unsigned)(ht & (KD == 512 ? 7 : 1)) * 64u;
#define RC_WARM(c0) do { pfacc ^= pfq ^ pfk; const unsigned cs_ = (unsigned)((c0) < T ? (c0) : T - 32) * LDT; \
            pfq = *(const GAS unsigned*)(Qg + 2u * (pfoff0 + cs_)); pfk = *(const GAS unsigned*)(Kg + 2u * (pfoff0 + cs_)); } while (0)
#define RC_LOADQ(c0x) do { const int c0_ = (c0x) < T ? (c0x) : T - 32; const unsigned cs_ = (unsigned)c0_ * LDT;     \
            _Pragma("unroll") for (int i = 0; i < NPQ; ++i) rq[i] = *(const GAS v4u*)(Qg + 2u * (qoff0 + cs_ + (unsigned)i * RSTEP)); \
            rvn = *(const GAS v4u*)(Vg + 2u * (voff0 + cs_)); \
            rp = *(const GAS v4u*)(Pg + 2u * (poff0 + (unsigned)c0_ * 32u)); \
            if (!HG) { const unsigned tk = (unsigned)(tok0 + c0_ + (ht & 31)) * 8u + (unsigned)h * 2u; sBg = SC[tk]; sm = SC[tk + 1]; sig = GATES[tk - (unsigned)h]; } \
            else seg = EGL[(size_t)((tok0 + c0_) >> 5) * DM + colq + (ht & 127)]; } while (0)
#define RC_LOADK(c0x) do { const unsigned cs_ = (unsigned)((c0x) < T ? (c0x) : T - 32) * LDT; \
            _Pragma("unroll") for (int i = 0; i < NPQ; ++i) rk[i] = *(const GAS v4u*)(Kg + 2u * (qoff0 + cs_ + (unsigned)i * RSTEP)); } while (0)
#define RC_PUTQ(bank) do { \
            _Pragma("unroll") for (int i = 0; i < NPQ; ++i) { const int piece = hx + 256 * i, row = piece / PPR, c16 = piece % PPR; \
                v2u q0_, q1_; q0_.x = rq[i].x; q0_.y = rq[i].y; q1_.x = rq[i].z; q1_.y = rq[i].w; \
                *(LAS v2u*)(lds + L_Q + row * QP + c16 * 16) = q0_; *(LAS v2u*)(lds + L_Q + row * QP + c16 * 16 + 8) = q1_; } \
            { const int row = hx >> 3, c16 = hx & 7; v4u vv = rvn; if (den) { vv = (v4u){0u, 0u, 0u, 0u}; if (c16 == 0) vv.x = 0x3f80u; } \
              *(LAS v4u*)(lds + L_V + row * VP + c16 * 16) = vv; } \
            if (hx < 128) *(LAS v4u*)(lds + L_P + (hx >> 2) * PPI + (hx & 3) * 16) = rp; \
            LAS float* lsn = LS + (bank) * 256; \
            if (!HG && hx < 32) { const float BLs = __shfl(sBg, 31, 32), mLs = __shfl(sm, 31, 32); \
                lsn[hx] = __expf(sBg - Bprev + mprev - sm); lsn[32 + hx] = __expf(BLs - sBg + sig - mLs); \
                if (hx == 31) lsn[64] = __expf(BLs - Bprev + mprev - mLs); \
                Bprev = BLs; mprev = mLs; } \
            if (HG && hx < 128) lsn[128 + hx] = seg; } while (0)
        RC_LOADQ(0); RC_LOADK(0);
        RC_PUTQ(0);
        rvc = rvn;
        RC_LOADQ(32);
        REC_BAR();
        for (int step = 0; step < nsteps; ++step) {
            const int c0 = step * 32; LAS float* ls = LS + (step & 1) * 256;

            if (step > 0 && !den) { const int row = hx >> 3, c16 = hx & 7;
                *(GAS v4u*)(OUTb + ((unsigned)(tok0 + c0 - 32 + row) * LDT + colv + (unsigned)c16 * 8u)) = *(const LAS v4u*)(lds + L_H + row * HP + c16 * 16); }
#pragma unroll
            for (int i = 0; i < NPQ; ++i) { const int piece = hx + 256 * i, row = piece / PPR, c16 = piece % PPR; *(LAS v4u*)(lds + L_K + row * KP + c16 * 16) = rk[i]; }
            if (!HG) { const int row = hx >> 3, c16 = hx & 7; const float wl = ls[32 + row]; v4u vw = {0u, 0u, 0u, 0u};
                if (!den) { float x[8]; unpack8(rvc, x); vw.x = pkc(x[0] * wl, x[1] * wl); vw.y = pkc(x[2] * wl, x[3] * wl); vw.z = pkc(x[4] * wl, x[5] * wl); vw.w = pkc(x[6] * wl, x[7] * wl); }
                else if (c16 == 0) vw.x = pkc(wl, 0.f) & 0xffffu;
                *(LAS v4u*)(lds + L_VW + row * VP + c16 * 16) = vw; }
            RC_LOADK(c0 + 32);
            RC_WARM(c0 + 96);
            REC_BAR();
            { const int we = hw & 1, g0 = 8 * (hw >> 1), lane = hx & 63, r = lane & 31, hh = lane >> 5;
              const LAS float* ra = (const LAS float*)(lds + L_RED) + we * 1024; const LAS float* rb = ra + 2048;
              if (!den) {
#pragma unroll
                  for (int g = g0; g < g0 + 8; ++g) { const float v = ra[g * 64 + lane] + rb[g * 64 + lane];
                      *(LAS bf16*)(lds + L_H + crow(g, hh) * HP + (32 * we + r) * 2) = (bf16)(pkc(v, 0.f) & 0xffffu); }
              } else if (we == 0) {
                  float dv[8];
#pragma unroll
                  for (int g = 0; g < 8; ++g) dv[g] = ra[(g0 + g) * 64 + lane] + rb[(g0 + g) * 64 + lane];
                  if (r == 0) {
#pragma unroll
                      for (int g = 0; g < 8; ++g) DEN[(size_t)(tok0 + c0 + crow(g0 + g, hh)) * 4 + h] = dv[g]; }
              } }
            RC_PUTQ((step + 1) & 1); rvc = rvn; RC_LOADQ(c0 + 64);
            REC_BAR();
        }
        if (!den) { const int row = ht >> 3, c16 = ht & 7;
            *(GAS v4u*)(OUTb + ((unsigned)(tok0 + T - 32 + row) * LDT + colv + (unsigned)c16 * 8u)) = *(const LAS v4u*)(lds + L_H + row * HP + c16 * 16); }
        if (den && ht == 0) a.out[(smp ? O_MS : O_MP) + bh] = mprev;
        if ((pfacc ^ pfq ^ pfk) == 0x9e3779b9u && T == 7) DEN[0] = 0.f;
        __builtin_amdgcn_s_setprio(0);
#undef RC_WARM
#undef RC_LOADQ
#undef RC_LOADK
#undef RC_PUTQ
    }
}

__device__ __forceinline__ void rec_mlstm_naive(Frame& F, const Args& a, int unit) {
    const int seq = unit >> 6, h = (unit >> 4) & 3, es = unit & 15;
    const bool smp = seq >= BP; const int b = smp ? seq - BP : seq;
    const int T = smp ? TS : TP, tok0 = smp ? NTOK_P + b * TS : b * TP;
    const int dp = F.tid & 15, el = F.tid >> 4, e = es * 32 + el;
    const bf16* Q = (const bf16*)(a.ws + WS_Q); const bf16* K = (const bf16*)(a.ws + WS_K); const bf16* V = (const bf16*)(a.ws + WS_V);
    const float* GATES = (const float*)(a.ws + WS_GATES);
    bf16* HM = (bf16*)a.out;
    float Cs[32], ns[32]; float m;
    if (smp) {
        const float* c0 = a.in[I_SC] + ((size_t)(b * MH + h) * MHD + e) * MHD; const float* n0 = a.in[I_SN] + (size_t)(b * MH + h) * MHD;
#pragma unroll
        for (int j = 0; j < 32; ++j) { Cs[j] = c0[dp + 16 * j]; ns[j] = n0[dp + 16 * j]; }
        m = a.in[I_SM][b * MH + h];
    } else {
#pragma unroll
        for (int j = 0; j < 32; ++j) { Cs[j] = 0.f; ns[j] = 0.f; }
        m = 0.f;
    }
    LAS float* qs = (LAS float*)(F.lds + RING_OFF);
    LAS float* ks = qs + 16 * 512;
    LAS float* vs = ks + 16 * 512;
    LAS float* gs = vs + 16 * 32;
    for (int t0 = 0; t0 < T; t0 += 16) {
        __syncthreads();
        for (int i = F.tid; i < 16 * 512; i += NTHREADS) { const int tt = i >> 9, d = i & 511; const size_t off = (size_t)(tok0 + t0 + tt) * MI + h * MHD + d; qs[i] = bf2f(Q[off]); ks[i] = bf2f(K[off]); }
        { const int tt = F.tid >> 5, ee = F.tid & 31; vs[F.tid] = bf2f(V[(size_t)(tok0 + t0 + tt) * MI + h * MHD + es * 32 + ee]); }
        if (F.tid < 32) { const int tt = F.tid >> 1; gs[F.tid] = GATES[(size_t)(tok0 + t0 + tt) * 8 + (F.tid & 1) * 4 + h]; }
        __syncthreads();
        for (int tt = 0; tt < 16; ++tt) {
            const float ig = gs[tt * 2], lf = gs[tt * 2 + 1];
            const float mn = fmaxf(lf + m, ig), fp = __expf(lf + m - mn), ip = __expf(ig - mn); m = mn;
            const float vv = ip * vs[tt * 32 + el];
            float dot = 0.f, nd = 0.f;
#pragma unroll
            for (int j = 0; j < 32; ++j) { const float kk = ks[tt * 512 + dp + 16 * j], qq = qs[tt * 512 + dp + 16 * j];
                Cs[j] = fp * Cs[j] + vv * kk; ns[j] = fp * ns[j] + ip * kk; dot += Cs[j] * qq; nd += ns[j] * qq; }
#pragma unroll
            for (int o = 1; o < 16; o <<= 1) { dot += __shfl_xor(dot, o); nd += __shfl_xor(nd, o); }
            const float hv = dot / fmaxf(fabsf(nd), __expf(-m));
            if (dp == 0) HM[(size_t)(tok0 + t0 + tt) * MI + h * MHD + e] = (bf16)f2bf(hv);
        }
    }
    float* co = a.out + (smp ? O_CS : O_CP) + ((size_t)(b * MH + h) * MHD + e) * MHD;
#pragma unroll
    for (int j = 0; j < 32; ++j) co[dp + 16 * j] = Cs[j];
    if (es == 0 && el == 0) { float* no = a.out + (smp ? O_NS : O_NP) + (size_t)(b * MH + h) * MHD;
#pragma unroll
        for (int j = 0; j < 32; ++j) no[dp + 16 * j] = ns[j];
        if (dp == 0) a.out[(smp ? O_MS : O_MP) + b * MH + h] = m; }
}
__device__ __forceinline__ void rec_hgrn_naive(Frame& F, const Args& a, int unit) {
    const int seq = unit >> 5, hd = (unit >> 2) & 7, es = unit & 3;
    const bool smp = seq >= BP; const int b = smp ? seq - BP : seq;
    const int T = smp ? TS : TP, tok0 = smp ? NTOK_P + b * TS : b * TP;
    const int cp = F.tid & 15, el = F.tid >> 4, e = es * 32 + el;
    const bf16* QH = (const bf16*)(a.ws + WS_QH); const bf16* FH = (const bf16*)(a.ws + WS_FH); const bf16* IH = (const bf16*)(a.ws + WS_IH);
    bf16* HO = (bf16*)(a.ws + WS_HO);
    float S[8];
    if (smp) {
#pragma unroll
        for (int j = 0; j < 8; ++j) S[j] = a.in[I_SH][((size_t)(b * HH + hd) * HE + cp + 16 * j) * HE + e];
    } else {
#pragma unroll
        for (int j = 0; j < 8; ++j) S[j] = 0.f;
    }
    LAS float* qs = (LAS float*)(F.lds + RING_OFF);
    LAS float* fs = qs + 2048; LAS float* ks = fs + 2048; LAS float* vs = ks + 2048;
    for (int t0 = 0; t0 < T; t0 += 16) {
        __syncthreads();
        for (int i = F.tid; i < 2048; i += NTHREADS) { const int tt = i >> 7, c = i & 127, col = hd * HE + c; const size_t off = (size_t)(tok0 + t0 + tt) * DM + col;
            const float l0 = a.in[I_LB][col], l1 = a.in[I_LB][DM + col]; const float lb = 1.0f / (1.0f + __expf(l1 - l0));
            const float sg = sigmoidf_(bf2f(FH[off]));
            qs[i] = siluf_(bf2f(QH[off])); fs[i] = lb + (1.0f - lb) * sg; ks[i] = (1.0f - lb) * (1.0f - sg); }
        { const int tt = F.tid >> 5, ee = F.tid & 31; vs[F.tid] = bf2f(IH[(size_t)(tok0 + t0 + tt) * DM + hd * HE + es * 32 + ee]); }
        __syncthreads();
        for (int tt = 0; tt < 16; ++tt) {
            const float vv = vs[tt * 32 + el]; float o = 0.f;
#pragma unroll
            for (int j = 0; j < 8; ++j) { const int c = cp + 16 * j; S[j] = fs[tt * 128 + c] * S[j] + ks[tt * 128 + c] * vv; o += qs[tt * 128 + c] * S[j]; }
#pragma unroll
            for (int s = 1; s < 16; s <<= 1) o += __shfl_xor(o, s);
            if (cp == 0) HO[(size_t)(tok0 + t0 + tt) * DM + hd * HE + e] = (bf16)f2bf(o);
        }
    }
    float* so = a.out + (smp ? O_SS : O_SP);
#pragma unroll
    for (int j = 0; j < 8; ++j) so[((size_t)(b * HH + hd) * HE + cp + 16 * j) * HE + e] = S[j];
}
#ifndef RECDUP
#define RECDUP 0
#endif
constexpr int CW_QUEUE = 8192;
__device__ __forceinline__ void p5_rec(Frame& F, const Args& a) {
    const int bx = blockIdx.x;
    int kind = -1, unit = 0;
    if (F.G == 256) {
        const int x = bx & 7, y = bx >> 3;
        if (y < 18) { kind = 0; unit = (x * 2 + (y >= 9 ? 1 : 0)) * 9 + (y >= 9 ? y - 9 : y); }
        else if (y < 26) { kind = 1; unit = (x * 4 + ((y - 18) >> 1)) * 2 + ((y - 18) & 1); }
    } else if (bx < 144) { kind = 0; unit = bx; } else if (bx < 208) { kind = 1; unit = bx - 144; }
    volatile LAS unsigned* MISC = (volatile LAS unsigned*)(F.lds + MISC_OFF);
    unsigned* qhead = (unsigned*)(a.ws + WS_CTL) + CW_QUEUE;
    const bool prompt_m = kind == 0;
    if (!prompt_m) {
        int u = kind == 1 ? unit : -1; int again = (kind == 1 && (RECDUP & 2)) ? 1 : 0;
        for (;;) {
            if (u < 0 && again > 0) { --again; u = unit; }
            if (u < 0) {
                __syncthreads();
                if (F.tid == 0) MISC[16] = __hip_atomic_fetch_add(qhead, 1u, __ATOMIC_RELAXED, __HIP_MEMORY_SCOPE_AGENT);
                __syncthreads();
                const unsigned qi = MISC[16];
                if (qi >= 512u) break;
                u = 64 + (int)qi;
            }
            rec_unit<true>(F, a, u);
            u = -1;
        }
    }
    {
        int u = prompt_m ? unit : -1; int again = (prompt_m && (RECDUP & 1)) ? 1 : 0;
        for (;;) {
            if (u < 0 && again > 0) { --again; u = unit; }
            if (u < 0) {
                if (prompt_m) break;
                __syncthreads();
                if (F.tid == 0) MISC[16] = __hip_atomic_fetch_add(qhead + 64, 1u, __ATOMIC_RELAXED, __HIP_MEMORY_SCOPE_AGENT);
                __syncthreads();
                const unsigned qi = MISC[16];
                if (qi >= 1152u) break;
                u = 144 + (int)qi;
            }
            rec_unit<false>(F, a, u);
            u = -1;
        }
    }
}

__device__ __forceinline__ void p6_norm(Frame& F, const Args& a) {
    const int gw = F.vcu * NWAVES + F.wave, NGW = F.G * NWAVES, lane = F.lane;
    const bf16* HM = (const bf16*)a.out; const bf16* C = (const bf16*)(a.ws + WS_C); const bf16* ZP = (const bf16*)(a.ws + WS_ZP);
    const bf16* HO = (const bf16*)(a.ws + WS_HO); const bf16* GHP = (const bf16*)(a.ws + WS_GHP);
    const float* DEN = (const float*)(a.ws + WS_DENI); const float* SC = (const float*)(a.ws + WS_SC);
    bf16* HMN = (bf16*)(a.ws + WS_HMN); bf16* OH = (bf16*)(a.ws + WS_OH);
    const float* mg = a.in[I_MNORMG] + lane * 8; const float* ms = a.in[I_MSKIP] + lane * 8; const float* hg = a.in[I_HNORMG] + lane * 16;
    for (int m = gw; m < NTOK; m += NGW) {
        v4u hm[4], cc[4], zz[4], ho[2], gh[2]; f32x4 dn4, sc0, sc1;
        const size_t offm = (size_t)m * MI + lane * 8, offh = (size_t)m * DM + lane * 16;
#pragma unroll
        for (int h = 0; h < 4; ++h) { hm[h] = *(const GAS v4u*)(HM + offm + h * MHD); cc[h] = *(const GAS v4u*)(C + offm + h * MHD); zz[h] = *(const GAS v4u*)(ZP + offm + h * MHD); }
        ho[0] = *(const GAS v4u*)(HO + offh); ho[1] = *(const GAS v4u*)(HO + offh + 8); gh[0] = *(const GAS v4u*)(GHP + offh); gh[1] = *(const GAS v4u*)(GHP + offh + 8);
        dn4 = *(const GAS f32x4*)(DEN + (size_t)m * 4); sc0 = *(const GAS f32x4*)(SC + (size_t)m * 8); sc1 = *(const GAS f32x4*)(SC + (size_t)m * 8 + 4);
        const float mts[4] = {sc0.y, sc0.w, sc1.y, sc1.w};
#pragma unroll
        for (int h = 0; h < 4; ++h) {
            float x[8], c[8], z[8];
            unpack8(hm[h], x); unpack8(cc[h], c); unpack8(zz[h], z);
            float s = 0.f;
#pragma unroll
            for (int e = 0; e < 8; ++e) s += x[e];
            const float mu = wave_sum(s) * (1.f / MHD); float q = 0.f;
#pragma unroll
            for (int e = 0; e < 8; ++e) { x[e] -= mu; q += x[e] * x[e]; }
            const float dpr = fmaxf(fabsf(dn4[h]), __expf(-mts[h]));
            const float rstd = 1.0f / sqrtf(wave_sum(q) * (1.f / MHD) + EPS * dpr * dpr);
            const f32x4 g0 = *(const GAS f32x4*)(mg + h * MHD), g1 = *(const GAS f32x4*)(mg + h * MHD + 4), k0 = *(const GAS f32x4*)(ms + h * MHD), k1 = *(const GAS f32x4*)(ms + h * MHD + 4);
            float o[8];
#pragma unroll
            for (int e = 0; e < 4; ++e) { o[e] = (x[e] * rstd * g0[e] + k0[e] * c[e]) * z[e]; o[4 + e] = (x[4 + e] * rstd * g1[e] + k1[e] * c[4 + e]) * z[4 + e]; }
            *(GAS v4u*)(HMN + offm + h * MHD) = pack8(o);
        }
        {
            float x0[8], x1[8], g0[8], g1[8];
            unpack8(ho[0], x0); unpack8(ho[1], x1); unpack8(gh[0], g0); unpack8(gh[1], g1);
            float q = 0.f;
#pragma unroll
            for (int e = 0; e < 8; ++e) q += x0[e] * x0[e] + x1[e] * x1[e];
            q += __shfl_xor(q, 1); q += __shfl_xor(q, 2); q += __shfl_xor(q, 4);
            const float rstd = 1.0f / sqrtf(q * (1.f / HE) + EPS);
            float o0[8], o1[8];
#pragma unroll
            for (int e4 = 0; e4 < 2; ++e4) { const f32x4 ga = *(const GAS f32x4*)(hg + 4 * e4), gb = *(const GAS f32x4*)(hg + 8 + 4 * e4);
#pragma unroll
                for (int e = 0; e < 4; ++e) { o0[4 * e4 + e] = x0[4 * e4 + e] * rstd * ga[e] * g0[4 * e4 + e]; o1[4 * e4 + e] = x1[4 * e4 + e] * rstd * gb[e] * g1[4 * e4 + e]; } }
            *(GAS v4u*)(OH + offh) = pack8(o0); *(GAS v4u*)(OH + offh + 8) = pack8(o1);
        }
    }
}

__device__ __forceinline__ void p12_final(Frame& F, const Args& a) {
    const int gw = F.vcu * NWAVES + F.wave, NGW = F.G * NWAVES;
    const float* fg = a.in[I_FINALG];
    const bf16* H2B = (const bf16*)(a.ws + WS_H2B);
    for (int m = gw; m < NTOK; m += NGW) {
        const GAS v2u* hr = (const GAS v2u*)(H2B + (size_t)m * DM) + F.lane;
        GAS f32x4* xr = (GAS f32x4*)(a.out + (size_t)m * DM) + F.lane;
        f32x4 v[4]; float ss = 0.f;
#pragma unroll
        for (int j = 0; j < 4; ++j) { const v2u w = hr[64 * j]; v[j] = (f32x4){bflo(w.x), bfhi(w.x), bflo(w.y), bfhi(w.y)}; ss += (v[j].x * v[j].x + v[j].y * v[j].y) + (v[j].z * v[j].z + v[j].w * v[j].w); }
        const float rstd = 1.0f / sqrtf(wave_sum(ss) * (1.f / DM) + EPS);
#pragma unroll
        for (int j = 0; j < 4; ++j) { const f32x4 gg = *(const GAS f32x4*)(fg + 4 * F.lane + 256 * j); xr[64 * j] = v[j] * rstd * gg; }
    }
}

__device__ __forceinline__ void st8bf(bf16* p, f32x4 v0, f32x4 v1) {
    v4u w; w.x = pg8::cvt_pk_bf16(v0[0], v0[1]); w.y = pg8::cvt_pk_bf16(v0[2], v0[3]); w.z = pg8::cvt_pk_bf16(v1[0], v1[1]); w.w = pg8::cvt_pk_bf16(v1[2], v1[3]);
    *(GAS v4u*)p = w;
}
__device__ __forceinline__ void ld8bf(const bf16* p, f32x4& v0, f32x4& v1) {
    const v4u w = *(const GAS v4u*)p; v0 = (f32x4){bflo(w.x), bfhi(w.x), bflo(w.y), bfhi(w.y)}; v1 = (f32x4){bflo(w.z), bfhi(w.z), bflo(w.w), bfhi(w.w)};
}
__device__ __forceinline__ f32x4 sig4(f32x4 v) { return (f32x4){sigmoidf_(v[0]), sigmoidf_(v[1]), sigmoidf_(v[2]), sigmoidf_(v[3])}; }
struct Fn1a { unsigned char* ws; const float* big; const float* bfg;
    __device__ __forceinline__ void operator()(int row, int pn, int ct, f32x4 v0, f32x4 v1) const {
        if (pn == 28) {
            if (ct == 0) { float* g = (float*)(ws + WS_GATES) + (size_t)row * 8;
                const f32x4 bi = *(const GAS f32x4*)big, bf = *(const GAS f32x4*)bfg;
                *(GAS f32x4*)g = v0 + bi;
                *(GAS f32x4*)(g + 4) = (f32x4){logsigmoidf_(v1[0] + bf[0]), logsigmoidf_(v1[1] + bf[1]), logsigmoidf_(v1[2] + bf[2]), logsigmoidf_(v1[3] + bf[3])}; }
            return;
        }
        bf16* base; int ld, col;
        if (pn < 8) { base = (bf16*)(ws + WS_U); ld = MI; col = pn * 256; } else if (pn < 16) { base = (bf16*)(ws + WS_V); ld = MI; col = (pn - 8) * 256; }
        else if (pn < 20) { base = (bf16*)(ws + WS_QH); ld = DM; col = (pn - 16) * 256; } else if (pn < 24) { base = (bf16*)(ws + WS_FH); ld = DM; col = (pn - 20) * 256; }
        else { base = (bf16*)(ws + WS_IH); ld = DM; col = (pn - 24) * 256; }
        st8bf(base + (size_t)row * ld + col + ct, v0, v1);
    } };
struct Fn3 { unsigned char* ws;
    __device__ __forceinline__ void operator()(int row, int pn, int ct, f32x4 v0, f32x4 v1) const {
        if (pn < 8) st8bf((bf16*)(ws + WS_Q) + (size_t)row * MI + pn * 256 + ct, v0, v1);
        else { const float s = 0.044194173824159216f; st8bf((bf16*)(ws + WS_K) + (size_t)row * MI + (pn - 8) * 256 + ct, v0 * s, v1 * s); }
    } };
struct Fn5 { unsigned char* ws;
    __device__ __forceinline__ void operator()(int row, int pn, int ct, f32x4 v0, f32x4 v1) const {
        bf16* base; int ld, col; bool sil;
        if (pn < 8) { base = (bf16*)(ws + WS_ZP); ld = MI; col = pn * 256; sil = true; } else if (pn < 12) { base = (bf16*)(ws + WS_GHP); ld = DM; col = (pn - 8) * 256; sil = true; }
        else if (pn < 16) { base = (bf16*)(ws + WS_GAP); ld = DM; col = (pn - 12) * 256; sil = false; } else { base = (bf16*)(ws + WS_GBP); ld = DM; col = (pn - 16) * 256; sil = false; }
        f32x4 s0 = sig4(v0), s1 = sig4(v1);
        if (sil) { s0 = s0 * v0; s1 = s1 * v1; }
        st8bf(base + (size_t)row * ld + col + ct, s0, s1);
    } };
struct Fn7 { unsigned char* ws;
    __device__ __forceinline__ void operator()(int row, int pn, int ct, f32x4 v0, f32x4 v1) const {
        const size_t off = (size_t)row * DM + pn * 256 + ct; f32x4 g0, g1; ld8bf((const bf16*)(ws + WS_GAP) + off, g0, g1);
        st8bf((bf16*)(ws + WS_YA) + off, v0 * g0, v1 * g1);
    } };
struct Fn8 { unsigned char* ws;
    __device__ __forceinline__ void operator()(int row, int pn, int ct, f32x4 v0, f32x4 v1) const {
        const size_t off = (size_t)row * DM + pn * 256 + ct; f32x4 g0, g1, y0, y1; ld8bf((const bf16*)(ws + WS_GBP) + off, g0, g1); ld8bf((const bf16*)(ws + WS_YA) + off, y0, y1);
        st8bf((bf16*)(ws + WS_Y) + off, y0 + v0 * g0, y1 + v1 * g1);
    } };
struct Fn9 { unsigned char* ws; const float* xp; const float* xs; float* out;
    __device__ __forceinline__ void operator()(int row, int pn, int ct, f32x4 v0, f32x4 v1) const {
        const int col = pn * 256 + ct; const float* xr = (row < NTOK_P ? xp + (size_t)row * DM : xs + (size_t)(row - NTOK_P) * DM) + col;
        const f32x4 h0 = *(const GAS f32x4*)xr + v0, h1 = *(const GAS f32x4*)(xr + 4) + v1;
        st8bf((bf16*)(ws + WS_H1B) + (size_t)row * DM + col, h0, h1);
    } };
struct Fn10 { unsigned char* ws;
    __device__ __forceinline__ void operator()(int row, int pn, int ct, f32x4 v0, f32x4 v1) const { st8bf((bf16*)(ws + WS_G2) + (size_t)row * DM + pn * 256 + ct, v0, v1); } };
struct Fn11 { unsigned char* ws; float* out;
    __device__ __forceinline__ void operator()(int row, int pn, int ct, f32x4 v0, f32x4 v1) const {
        const size_t off = (size_t)row * DM + pn * 256 + ct; f32x4 g0, g1, h0, h1; ld8bf((const bf16*)(ws + WS_G2) + off, g0, g1); ld8bf((const bf16*)(ws + WS_H1B) + off, h0, h1);
        st8bf((bf16*)(ws + WS_H2B) + off, h0 + sig4(v0) * g0, h1 + sig4(v1) * g1);
    } };

template <int K, class Fn>
__device__ __forceinline__ void small_gemm(Frame& F, const bf16* A, int lda, const bf16* Bt, int ldb, const Fn& fn) {
    typedef float f32x4v __attribute__((ext_vector_type(4)));
    constexpr int KW = K / 8, CH = KW > 128 ? 128 : KW, NS = CH / 32, RS = 68;
    const int lane = F.lane, w = F.wave, i16 = lane & 15, fq = lane >> 4;
    LAS float* red = (LAS float*)(F.lds + RING_OFF);
    for (int t = blockIdx.x; t < 256; t += F.G) {
        const int row0 = NTOK_P + (t >> 4) * 64, col0 = (t & 15) * 64;
        const bf16* ap = A + (size_t)(row0 + i16) * lda + w * KW + 8 * fq;
        const bf16* bp = Bt + (size_t)(col0 + i16) * ldb + w * KW + 8 * fq;
        f32x4v acc[4][4];
#pragma unroll
        for (int mi = 0; mi < 4; ++mi)
#pragma unroll
            for (int ni = 0; ni < 4; ++ni) acc[mi][ni] = (f32x4v){0.f, 0.f, 0.f, 0.f};
#pragma unroll
        for (int kc = 0; kc < KW; kc += CH) {
            bf16x8 xa[NS][4], wb[NS][4];
#pragma unroll
            for (int s = 0; s < NS; ++s)
#pragma unroll
                for (int i = 0; i < 4; ++i) { xa[s][i] = *(const GAS bf16x8*)(ap + (size_t)(16 * i) * lda + kc + 32 * s); wb[s][i] = *(const GAS bf16x8*)(bp + (size_t)(16 * i) * ldb + kc + 32 * s); }
#pragma unroll
            for (int s = 0; s < NS; ++s)
#pragma unroll
                for (int mi = 0; mi < 4; ++mi)
#pragma unroll
                    for (int ni = 0; ni < 4; ++ni) acc[mi][ni] = __builtin_amdgcn_mfma_f32_16x16x32_bf16(wb[s][ni], xa[s][mi], acc[mi][ni], 0, 0, 0);
        }
        __syncthreads();
        if (w >= 4) { LAS float* r = red + (w - 4) * (64 * RS);
#pragma unroll
            for (int mi = 0; mi < 4; ++mi)
#pragma unroll
                for (int ni = 0; ni < 4; ++ni) *(LAS f32x4v*)(r + (16 * mi + i16) * RS + 16 * ni + 4 * fq) = acc[mi][ni]; }
        __syncthreads();
        if (w < 4) { LAS float* r = red + w * (64 * RS);
#pragma unroll
            for (int mi = 0; mi < 4; ++mi)
#pragma unroll
                for (int ni = 0; ni < 4; ++ni) { LAS f32x4v* p = (LAS f32x4v*)(r + (16 * mi + i16) * RS + 16 * ni + 4 * fq); *p = *p + acc[mi][ni]; } }
        __syncthreads();
        const int row = F.tid >> 3, c8 = (F.tid & 7) * 8;
        f32x4v s0 = {0.f, 0.f, 0.f, 0.f}, s1 = {0.f, 0.f, 0.f, 0.f};
#pragma unroll
        for (int q = 0; q < 4; ++q) { const LAS float* r = red + q * (64 * RS) + row * RS + c8; s0 = s0 + *(const LAS f32x4v*)r; s1 = s1 + *(const LAS f32x4v*)(r + 4); }
        __syncthreads();
        const int col = col0 + c8;
        fn(row0 + row, col >> 8, col & 255, s0, s1);
    }
}
template <class Fn> struct RowOff { Fn f; int r0; __device__ __forceinline__ void operator()(int row, int pn, int ct, pg8::f32x4 v0, pg8::f32x4 v1) const { f(row + r0, pn, ct, v0, v1); } };
__device__ __forceinline__ bool launder(Frame& F) {
    int t = threadIdx.x; asm volatile("" : "+v"(t)); F.tid = t; F.lane = t & 63; return true; }
constexpr int N_PHASES = 13;
#ifndef MK_PER_PHASE
#define MK_PER_PHASE 0
#endif
template <class Fn>
__device__ __forceinline__ void run_gemm(Frame& F, const bf16* A, int lda, const bf16* Bt, int ldb, int K, int N, int amask, int ashift, int astride, const Fn& fn, int M = NTOK, int wgm = 4) {
    asm volatile("" : "+s"(K));
    pg8::Gemm g{A, Bt, lda, ldb, K, amask, ashift, astride}; pg8::StaticOrder S; S.init(M, N, F.G, (int)blockIdx.x, wgm);
    pg8::EpiF<Fn> E{fn};
    pg8::gemm_phase<pg8::EpiF<Fn>, pg8::StaticOrder, true, true>(F.lds + RING_OFF, g, S, E);
}
__device__ __forceinline__ void publish_count(unsigned* cnt) {
    asm volatile("s_waitcnt vmcnt(0)" ::: "memory");
    __syncthreads();
    if (threadIdx.x == 0) {
        __builtin_amdgcn_fence(__ATOMIC_RELEASE, "agent");
        asm volatile("s_waitcnt vmcnt(0)" ::: "memory");
        (void)__hip_atomic_fetch_add(cnt, 1u, __ATOMIC_RELAXED, __HIP_MEMORY_SCOPE_AGENT);
    }
}
__device__ __forceinline__ void wait_count(unsigned* cnt, unsigned need) {
    if (threadIdx.x == 0) {
        unsigned sp = 0;
        while (__hip_atomic_load(cnt, __ATOMIC_RELAXED, __HIP_MEMORY_SCOPE_AGENT) < need) { __builtin_amdgcn_s_sleep(8); if (++sp > (1u << 22)) break; }
        __builtin_amdgcn_fence(__ATOMIC_ACQUIRE, "agent");
        asm volatile("s_waitcnt vmcnt(0)" ::: "memory");
    }
    __syncthreads();
}
constexpr int CW_WORKERS = 8192 + 128;
struct OneTile { pg8::Unit u;
    __device__ __forceinline__ bool next(int i, pg8::Unit& o) const { if (i != 0) return false; o = u; return true; }
    __device__ __forceinline__ void a_ready(const pg8::Unit&) const {}
    __device__ __forceinline__ void done(const pg8::Unit&) const {} };
template <class Fn>
__device__ __forceinline__ void run_gemm_one(Frame& F, const bf16* A, int lda, const bf16* Bt, int ldb, int K, int pm, int pn, const Fn& fn) {
    asm volatile("" : "+s"(K));
    pg8::Gemm g{A, Bt, lda, ldb, K, 0, 0, 0}; OneTile S; S.u.pm = pm; S.u.pn = pn;
    pg8::EpiF<Fn> E{fn};
    pg8::gemm_phase<pg8::EpiF<Fn>, OneTile, true, true>(F.lds + RING_OFF, g, S, E);
}
__global__ void __launch_bounds__(NTHREADS, 2) mk_fwd(Args args) {
    extern __shared__ __attribute__((aligned(16))) unsigned char lds[];
    Frame F;
    F.lds = (LAS unsigned char*)lds;
    F.tid = threadIdx.x; F.lane = F.tid & 63; F.wave = __builtin_amdgcn_readfirstlane(F.tid >> 6);
    F.G = gridDim.x; { const int bx = blockIdx.x; F.vcu = (F.G % 8 == 0) ? (bx % 8) * (F.G / 8) + bx / 8 : bx; }
    volatile LAS unsigned* MISC = (volatile LAS unsigned*)(F.lds + MISC_OFF);
    for (int u = F.tid; u < (LDS_BYTES - LDSCTL_OFF) / 4; u += NTHREADS) ((LAS unsigned*)(F.lds + LDSCTL_OFF))[u] = 0u;
    __syncthreads();
    unsigned char* ws = args.ws;
    XcdBarrier bar; bar.bar = (unsigned*)(ws + WS_CTL) + CW_BAR; bar.x = 0; bar.st = nullptr;
    if (!MK_PER_PHASE) bar = xcd_barrier_post((unsigned*)(ws + WS_CTL) + CW_BAR, MISC + 8);
    const int lo = args.ph_lo, hi = args.ph_hi;
#ifndef PHMASK
#define PHMASK 0x1fff
#endif
#define IN(k) (((PHMASK >> (k)) & 1) && lo <= (k) && (k) < hi && launder(F))
#define SEAM(k) do { if (IN(k) && IN((k) + 1)) xcd_barrier(bar); } while (0)
#ifndef RMASK
#define RMASK 0
#endif
#define REP(k, ...) do { __VA_ARGS__; if ((RMASK >> (k)) & 1) { xcd_barrier(bar); __VA_ARGS__; } } while (0)
    if (IN(0)) REP(0, p0_prep(F, args)); SEAM(0);
    if (IN(1)) { REP(1, run_gemm(F, (const bf16*)(ws + WS_XN), DM, (const bf16*)(ws + WS_WIN), DM, DM, 7424, 0, 0, 0, Fn1a{ws, args.in[I_BIG], args.in[I_BFG]}));
        if (F.G == 256 && blockIdx.x >= 180) p0_pb(F, args, ((int)blockIdx.x - 180) * NTHREADS + F.tid, 76 * NTHREADS); } SEAM(1);
    if (IN(2)) { REP(2, p2_conv(F, args); p2_scan(F, args)); p2_hprep(F, args); } SEAM(2);
    if (IN(3)) { REP(3, run_gemm(F, (const bf16*)(ws + WS_C), MI, (const bf16*)(ws + WS_WQK), MHD, MHD, 4096, 7, 1, MHD, Fn3{ws}));
        if (F.G == 256 && blockIdx.x >= 64) p4_atiles(F, args, (int)blockIdx.x - 64, 192); } SEAM(3);
    if (IN(4)) REP(4, p4_tiles(F, args)); SEAM(4);
    if (IN(5)) { REP(5, p5_rec(F, args));
        if (F.G == 256 && (blockIdx.x >> 3) >= 18) {
            unsigned* cw = (unsigned*)(ws + WS_CTL) + CW_WORKERS;
            publish_count(cw);
            const int t = ((int)(blockIdx.x >> 3) - 18) * 8 + (int)(blockIdx.x & 7);
            if (t < 80) { wait_count(cw, 112u);
                run_gemm_one(F, (const bf16*)(ws + WS_XN), DM, (const bf16*)(ws + WS_WIN) + (size_t)7424 * DM, DM, DM, 64 + t / 20, t % 20, Fn5{ws}); }
        } } SEAM(5);
    if (IN(6)) REP(6, run_gemm(F, (const bf16*)(ws + WS_XN), DM, (const bf16*)(ws + WS_WIN) + (size_t)7424 * DM, DM, DM, 5120, 0, 0, 0, Fn5{ws}, F.G == 256 ? NTOK_P : NTOK)); SEAM(6);
    if (IN(7)) REP(7, p6_norm(F, args)); SEAM(7);
    if (IN(8)) REP(8, run_gemm(F, (const bf16*)(ws + WS_HMN), MI, (const bf16*)(ws + WS_WBRM), MI, MI, DM, 0, 0, 0, Fn7{ws}, NTOK_P); small_gemm<MI>(F, (const bf16*)(ws + WS_HMN), MI, (const bf16*)(ws + WS_WBRM), MI, Fn7{ws});
                     run_gemm(F, (const bf16*)(ws + WS_PB), PLE, (const bf16*)(ws + WS_WPLE), PLE, PLE, DM, 0, 0, 0, Fn10{ws}, NTOK_P); small_gemm<PLE>(F, (const bf16*)(ws + WS_PB), PLE, (const bf16*)(ws + WS_WPLE), PLE, Fn10{ws}));
    if (IN(8) && IN(9)) local_fence();
    if (IN(9)) REP(9, run_gemm(F, (const bf16*)(ws + WS_OH), DM, (const bf16*)(ws + WS_WBRH), DM, DM, DM, 0, 0, 0, Fn8{ws}, NTOK_P); small_gemm<DM>(F, (const bf16*)(ws + WS_OH), DM, (const bf16*)(ws + WS_WBRH), DM, Fn8{ws})); SEAM(9);
    if (IN(10)) REP(10, run_gemm(F, (const bf16*)(ws + WS_Y), DM, (const bf16*)(ws + WS_WOUT), DM, DM, DM, 0, 0, 0, Fn9{ws, args.in[I_XP], args.in[I_XS], args.out}, NTOK_P); small_gemm<DM>(F, (const bf16*)(ws + WS_Y), DM, (const bf16*)(ws + WS_WOUT), DM, Fn9{ws, args.in[I_XP], args.in[I_XS], args.out})); SEAM(10);
    if (IN(11)) { run_gemm(F, (const bf16*)(ws + WS_H1B), DM, (const bf16*)(ws + WS_WPG), DM, DM, DM, 0, 0, 0, Fn11{ws, args.out}, NTOK_P); small_gemm<DM>(F, (const bf16*)(ws + WS_H1B), DM, (const bf16*)(ws + WS_WPG), DM, Fn11{ws, args.out}); } SEAM(11);
    if (IN(12)) { p12_final(F, args); }
#undef IN
#undef SEAM
}

extern "C" void kernel_launch(void* const* d_in, const int* in_sizes, int n_in, void* d_out, int out_size, void* d_ws, size_t ws_size, hipStream_t stream) {
    static int grid = 0;
    if (grid == 0) {
        if (n_in != 27 || out_size != (int)O_END || ws_size < WS_END) { fprintf(stderr, "kernel_launch: unexpected shapes (n_in %d out %d ws %zu)\n", n_in, out_size, ws_size); grid = -1; return; }
        int dev = 0, cus = 0, per_cu = 0;
        if (hipGetDevice(&dev) != hipSuccess || hipDeviceGetAttribute(&cus, hipDeviceAttributeMultiprocessorCount, dev) != hipSuccess) { grid = -1; return; }
        if (hipFuncSetAttribute((const void*)mk_fwd, hipFuncAttributeMaxDynamicSharedMemorySize, LDS_BYTES) != hipSuccess) { grid = -1; return; }
        if (hipOccupancyMaxActiveBlocksPerMultiprocessor(&per_cu, (const void*)mk_fwd, NTHREADS, LDS_BYTES) != hipSuccess || per_cu < 1) { fprintf(stderr, "kernel_launch: occupancy query says %d\n", per_cu); grid = -1; (void)hipGetLastError(); return; }
        grid = cus;
    }
    if (grid < 0) return;
    if (hipMemsetAsync((char*)d_ws + WS_CTL, 0, CTL_ZERO_BYTES, stream) != hipSuccess) return;
    Args a{};
    for (int i = 0; i < 27; ++i) a.in[i] = (const float*)d_in[i];
    a.out = (float*)d_out; a.ws = (unsigned char*)d_ws;
#if MK_PER_PHASE
    for (int p = 0; p < N_PHASES; ++p) { a.ph_lo = p; a.ph_hi = p + 1; a.li = p; hipLaunchKernelGGL(mk_fwd, dim3(grid), dim3(NTHREADS), LDS_BYTES, stream, a); }
#else
    a.ph_lo = 0; a.ph_hi = N_PHASES; a.li = 0;
    hipLaunchKernelGGL(mk_fwd, dim3(grid), dim3(NTHREADS), LDS_BYTES, stream, a);
#endif
}
```

```cpp
#include <hip/hip_runtime.h>
#include <cstdio>
#include <cstdint>
#include <cmath>
namespace pg8 {
#define PG8_LAS __attribute__((address_space(3)))
typedef unsigned short bf16_t;
typedef short bf16x8 __attribute__((ext_vector_type(8)));
typedef float f32x4 __attribute__((ext_vector_type(4)));
typedef unsigned u32x4 __attribute__((ext_vector_type(4)));
constexpr int BM = 256, BK = 64, HALF = 128, HTB = HALF * BK * 2  , STAGE_BYTES = 8 * HTB, NXCD = 8;

__host__ __device__ __forceinline__ int lds_byte(int r, int c) { const int st = (r >> 4) * 2 + (c >> 5), rr = r & 15, cc = c & 31, ob = rr * 64 + cc * 2; return st * 1024 + (ob ^ (((ob >> 9) & 1) << 5)); }
__host__ __device__ __forceinline__ void stage_rc(int b, int& R, int& C) { const int st = b / 1024, sb = b % 1024, swz = sb ^ (((sb >> 9) & 1) << 5); R = (st >> 1) * 16 + swz / 64; C = (st & 1) * 32 + (swz % 64) / 2; }
__host__ __device__ __forceinline__ int perm32(int rho) { const int n = rho >> 4, i = rho & 15; return 8 * (i >> 2) + 4 * n + (i & 3); }

struct Unit { int pm, pn; };
struct Gemm { const bf16_t* A; const bf16_t* Bt; int lda, ldb, K, amask, ashift, astride;
    __device__ __forceinline__ const char* abase(const Unit& u) const { return (const char*)(A + (size_t)u.pm * BM * lda + (size_t)(((u.pn & amask) >> ashift) * astride)); }
    __device__ __forceinline__ const char* bbase(const Unit& u) const { return (const char*)(Bt + (size_t)u.pn * BM * ldb); } };

struct StaticOrder {
    int nM, nN, nwg, G, c, WGM;
    __host__ __device__ void init(int M, int N, int G_, int c_, int wgm = 4) { nM = M / BM; nN = N / BM; nwg = nM * nN; G = G_; c = c_; WGM = wgm; }
    __host__ __device__ bool next(int i, Unit& u) const {
        const long L = (long)i * G + c; if (L >= nwg) return false;
        int wgid = (int)L; { const int q = nwg / NXCD, r = nwg % NXCD, xcd = wgid % NXCD, off = wgid / NXCD; wgid = (xcd < r ? xcd * (q + 1) : r * (q + 1) + (xcd - r) * q) + off; }
        const int nig = WGM * nN, gid = wgid / nig, fm = gid * WGM, gsz = (nM - fm) < WGM ? (nM - fm) : WGM;
        u.pm = fm + ((wgid % nig) % gsz); u.pn = (wgid % nig) / gsz; return true;
    }
    __device__ __forceinline__ void a_ready(const Unit&) const {}
    __device__ __forceinline__ void done(const Unit&) const {}
};

typedef float f32x2_cv __attribute__((ext_vector_type(2)));
typedef __bf16 bf16x2_cv __attribute__((ext_vector_type(2)));
__device__ __forceinline__ unsigned cvt_pk_bf16(float lo, float hi) { f32x2_cv f = {lo, hi}; bf16x2_cv h = __builtin_convertvector(f, bf16x2_cv); return __builtin_bit_cast(unsigned, h); }
template <class Epi, class Sched, bool ALIGN_EPI = false, bool SP2 = false>
__device__ __forceinline__ void gemm_phase(PG8_LAS unsigned char* lds, const Gemm g, const Sched& S, const Epi& E) {
    const int lda = g.lda, ldb = g.ldb;
    int tid_ = threadIdx.x; asm volatile("" : "+v"(tid_));
    const int tid = tid_, wid = __builtin_amdgcn_readfirstlane(tid >> 6), lane = tid & 63, wr = wid >> 2, wc = wid & 3, fr = lane & 15, fq = lane >> 4;
    const int K = g.K, nt = K / BK;
    unsigned voffA[2], voffB[2];
#pragma unroll
    for (int i = 0; i < 2; ++i) { int R, C; stage_rc(tid * 16 + i * 8192, R, C); const int Rb = Epi::PERM ? ((R & ~31) + perm32(R & 31)) : R;
        voffA[i] = (unsigned)(R * lda + C) * 2u; voffB[i] = (unsigned)(Rb * ldb + C) * 2u; }
    const size_t kstep = (size_t)(BK * 2);
    const size_t hstepA = (size_t)HALF * lda * 2, hstepB = (size_t)HALF * ldb * 2;
    const unsigned ldsw = (unsigned)wid * 1024u;
    const int aoff = lds_byte(wr * 64 + fr, fq * 8), boff = lds_byte(wc * 32 + fr, fq * 8);
#define PG8_SA(b, h) (((b) * 2 + (h)) * HTB)
#define PG8_SB(b, h) ((4 + (b) * 2 + (h)) * HTB)
#define PG8_STAGE(bufoff, gbase, voff) do { _Pragma("unroll") for (int _i = 0; _i < 2; ++_i) \
        __builtin_amdgcn_global_load_lds((const unsigned*)((const char*)(gbase) + (voff)[_i]), (PG8_LAS unsigned*)(lds + (bufoff) + ldsw + _i * 8192), 16, 0, 0); } while (0)
#define PG8_LDA(dst, b, h) do { _Pragma("unroll") for (int m = 0; m < 4; ++m) _Pragma("unroll") for (int k = 0; k < 2; ++k) dst[m][k] = *(const PG8_LAS bf16x8*)(lds + PG8_SA(b, h) + aoff + m * 2048 + k * 1024); } while (0)
#define PG8_LDB(dst, b, h) do { _Pragma("unroll") for (int n = 0; n < 2; ++n) _Pragma("unroll") for (int k = 0; k < 2; ++k) dst[n][k] = *(const PG8_LAS bf16x8*)(lds + PG8_SB(b, h) + boff + n * 2048 + k * 1024); } while (0)
#define PG8_MMA(ai, bj, At, Bt) do { __builtin_amdgcn_s_setprio(1); _Pragma("unroll") for (int m = 0; m < 4; ++m) _Pragma("unroll") for (int n = 0; n < 2; ++n) _Pragma("unroll") for (int k = 0; k < 2; ++k) \
        acc[ai][bj][m][n] = __builtin_amdgcn_mfma_f32_16x16x32_bf16(Bt[n][k], At[m][k], acc[ai][bj][m][n], 0, 0, 0); __builtin_amdgcn_s_setprio(0); } while (0)
#define PG8_WAIT_V(n) asm volatile("s_waitcnt vmcnt(" #n ")" ::: "memory")
#define PG8_WAIT_L(n) asm volatile("s_waitcnt lgkmcnt(" #n ")" ::: "memory")
#define PG8_BAR __builtin_amdgcn_s_barrier()
#define PG8_SCHED __builtin_amdgcn_sched_barrier(0)
    Unit cur, nxt; int ui = 0;
    if (!S.next(0, cur)) return;
    f32x4 acc[2][2][4][2];
#pragma unroll
    for (int a = 0; a < 2; ++a)
#pragma unroll
        for (int b = 0; b < 2; ++b)
#pragma unroll
            for (int m = 0; m < 4; ++m)
#pragma unroll
                for (int n = 0; n < 2; ++n) acc[a][b][m][n] = (f32x4){0.f, 0.f, 0.f, 0.f};
    bf16x8 At[4][2], B0[2][2], B1[2][2];
    const char* cA = g.abase(cur); const char* cB = g.bbase(cur);
    S.a_ready(cur);
    if constexpr (SP2) {
        PG8_STAGE(PG8_SB(0, 0), cB, voffB); PG8_STAGE(PG8_SB(0, 1), cB + hstepB, voffB); PG8_STAGE(PG8_SA(0, 0), cA, voffA); PG8_STAGE(PG8_SA(0, 1), cA + hstepA, voffA);
        if (wr == 1) PG8_BAR;
        PG8_WAIT_V(2); PG8_BAR;
        PG8_STAGE(PG8_SB(1, 0), cB + kstep, voffB); PG8_STAGE(PG8_SA(1, 0), cA + kstep, voffA); PG8_STAGE(PG8_SB(1, 1), cB + hstepB + kstep, voffB);
        PG8_WAIT_V(6); PG8_BAR;
    } else {
        PG8_STAGE(PG8_SB(0, 0), cB, voffB); PG8_STAGE(PG8_SA(0, 0), cA, voffA); PG8_STAGE(PG8_SB(0, 1), cB + hstepB, voffB); PG8_STAGE(PG8_SA(0, 1), cA + hstepA, voffA);
        if (wr == 1) PG8_BAR;
        PG8_WAIT_V(4); PG8_BAR;
        PG8_STAGE(PG8_SB(1, 0), cB + kstep, voffB); PG8_STAGE(PG8_SA(1, 0), cA + kstep, voffA); PG8_STAGE(PG8_SB(1, 1), cB + hstepB + kstep, voffB);
        PG8_WAIT_V(6); PG8_BAR;
    }
    for (;;) {
        const bool has_next = S.next(ui + 1, nxt);
        const char* nA = has_next ? g.abase(nxt) : cA; const char* nB = has_next ? g.bbase(nxt) : cB;
        for (int t = 0; t < nt; t += 2) {
            const bool last = (t == nt - 2);
            const char* a1 = cA + (size_t)(t + 1) * kstep;
            const char* a2 = last ? nA : cA + (size_t)(t + 2) * kstep; const char* b2 = last ? nB : cB + (size_t)(t + 2) * kstep;
            const char* a3 = a2 + kstep; const char* b3 = b2 + kstep;
            if (last && has_next) S.a_ready(nxt);
            if constexpr (SP2) {
            PG8_LDB(B0, 0, 0); PG8_LDB(B1, 0, 1); PG8_SCHED; PG8_LDA(At, 0, 0); PG8_STAGE(PG8_SA(1, 1), a1 + hstepA, voffA);
            PG8_WAIT_V(8); PG8_WAIT_L(0); PG8_BAR; PG8_MMA(0, 0, At, B0); PG8_MMA(0, 1, At, B1); PG8_BAR; PG8_SCHED;
            PG8_LDA(At, 0, 1); PG8_STAGE(PG8_SB(0, 0), b2, voffB); PG8_STAGE(PG8_SB(0, 1), b2 + hstepB, voffB); PG8_STAGE(PG8_SA(0, 0), a2, voffA);
            PG8_WAIT_V(8); PG8_WAIT_L(0); PG8_BAR; PG8_MMA(1, 0, At, B0); PG8_MMA(1, 1, At, B1); PG8_BAR; PG8_SCHED;
            PG8_LDB(B0, 1, 0); PG8_LDB(B1, 1, 1); PG8_SCHED; PG8_LDA(At, 1, 0); PG8_STAGE(PG8_SA(0, 1), a2 + hstepA, voffA);
            PG8_WAIT_V(8); PG8_WAIT_L(0); PG8_BAR; PG8_MMA(0, 0, At, B0); PG8_MMA(0, 1, At, B1); PG8_BAR; PG8_SCHED;
            PG8_LDA(At, 1, 1); PG8_STAGE(PG8_SB(1, 0), b3, voffB); PG8_STAGE(PG8_SB(1, 1), b3 + hstepB, voffB); PG8_STAGE(PG8_SA(1, 0), a3, voffA);
            PG8_WAIT_V(8); PG8_WAIT_L(0); PG8_BAR; PG8_MMA(1, 0, At, B0); PG8_MMA(1, 1, At, B1); PG8_BAR; PG8_SCHED;
            } else {
            PG8_LDB(B0, 0, 0); PG8_SCHED; PG8_LDA(At, 0, 0); PG8_STAGE(PG8_SA(1, 1), a1 + hstepA, voffA);
            PG8_WAIT_L(8); PG8_BAR; PG8_WAIT_L(0); PG8_MMA(0, 0, At, B0); PG8_BAR; PG8_SCHED;
            PG8_LDB(B1, 0, 1); PG8_STAGE(PG8_SB(0, 0), b2, voffB);
            PG8_BAR; PG8_WAIT_L(0); PG8_MMA(0, 1, At, B1); PG8_BAR;
            PG8_LDA(At, 0, 1); PG8_STAGE(PG8_SA(0, 0), a2, voffA);
            PG8_BAR; PG8_WAIT_L(0); PG8_MMA(1, 0, At, B0); PG8_BAR; PG8_SCHED;
            PG8_STAGE(PG8_SB(0, 1), b2 + hstepB, voffB);
            PG8_WAIT_V(6); PG8_BAR; PG8_MMA(1, 1, At, B1); PG8_BAR;
            PG8_LDB(B0, 1, 0); PG8_SCHED; PG8_LDA(At, 1, 0); PG8_STAGE(PG8_SA(0, 1), a2 + hstepA, voffA);
            PG8_WAIT_L(8); PG8_BAR; PG8_WAIT_L(0); PG8_MMA(0, 0, At, B0); PG8_BAR; PG8_SCHED;
            PG8_LDB(B1, 1, 1); PG8_STAGE(PG8_SB(1, 0), b3, voffB);
            PG8_BAR; PG8_WAIT_L(0); PG8_MMA(0, 1, At, B1); PG8_BAR;
            PG8_LDA(At, 1, 1); PG8_STAGE(PG8_SA(1, 0), a3, voffA);
            PG8_BAR; PG8_WAIT_L(0); PG8_MMA(1, 0, At, B0); PG8_BAR; PG8_SCHED;
            PG8_STAGE(PG8_SB(1, 1), b3 + hstepB, voffB);
            PG8_WAIT_V(6); PG8_BAR; PG8_MMA(1, 1, At, B1); PG8_BAR;
            }
        }
        if constexpr (ALIGN_EPI) { if (wr == 0) PG8_BAR; }
        if constexpr (!Epi::AFTER_DRAIN) { E(acc, cur, wr, wc, fr, fq); S.done(cur); }
        if (!has_next) break;
#pragma unroll
        for (int a = 0; a < 2; ++a)
#pragma unroll
            for (int b = 0; b < 2; ++b)
#pragma unroll
                for (int m = 0; m < 4; ++m)
#pragma unroll
                    for (int n = 0; n < 2; ++n) acc[a][b][m][n] = (f32x4){0.f, 0.f, 0.f, 0.f};
        cur = nxt; cA = nA; cB = nB; ++ui;
        if constexpr (ALIGN_EPI) { if (wr == 1) PG8_BAR; }
    }
    PG8_WAIT_V(0);
    if constexpr (!ALIGN_EPI) { if (wr == 0) PG8_BAR; }
    PG8_BAR;
    if constexpr (Epi::AFTER_DRAIN) { E.fused(acc, cur, wr, wc, fr, fq, lds, wid, lane); S.done(cur); }
#undef PG8_SA
#undef PG8_SB
#undef PG8_STAGE
#undef PG8_LDA
#undef PG8_LDB
#undef PG8_MMA
#undef PG8_WAIT_V
#undef PG8_WAIT_L
#undef PG8_BAR
#undef PG8_SCHED
}

template <class Fn> struct EpiF {
    static constexpr bool PERM = true, AFTER_DRAIN = false;
    Fn f;
    __device__ __forceinline__ void operator()(const f32x4 (&acc)[2][2][4][2], const Unit& u, int wr, int wc, int fr, int fq) const {
        const int row0 = u.pm * BM + wr * 64 + fr, ct0 = wc * 32 + 8 * fq;
#pragma unroll
        for (int ai = 0; ai < 2; ++ai)
#pragma unroll
            for (int m = 0; m < 4; ++m)
#pragma unroll
                for (int bj = 0; bj < 2; ++bj) f(row0 + ai * HALF + m * 16, u.pn, ct0 + bj * HALF, acc[ai][bj][m][0], acc[ai][bj][m][1]);
    }
};
}

constexpr int NWAVES = 8, NTHREADS = 512;
constexpr int DM = 1024, MI = 2048, NSRC = 12296, PLE = 256;
constexpr int TP = 4096, TS = 32, BP = 4, BS = 32;
constexpr int NTOK_P = BP * TP, NTOK_S = BS * TS, NTOK = NTOK_P + NTOK_S;
constexpr int MH = 4, MHD = 512, HH = 8, HE = 128;
constexpr float EPS = 1e-6f;
constexpr size_t O_Y = 0, O_CONVP = 17825792, O_CP = 17850368, O_NP = 22044672, O_MP = 22052864, O_SP = 22052880,
                 O_CONVS = 22577168, O_CS = 22773776, O_NS = 56328208, O_MS = 56393744, O_SS = 56393872, O_END = 60588176;
constexpr size_t MiB = 1u << 20;
constexpr size_t WS_CTL = 0, CTL_ZERO_BYTES = 64 * 1024;
constexpr size_t WS_GATES = 1 * MiB, WS_PB = 2 * MiB;
constexpr size_t WS_WIN = 12 * MiB, WS_WQK = 36 * MiB + 512 * 1024, WS_WBRM = WS_WQK + 4 * MiB, WS_WBRH = WS_WBRM + 4 * MiB, WS_WOUT = WS_WBRH + 2 * MiB, WS_WPG = WS_WOUT + 2 * MiB, WS_WPLE = WS_WPG + 2 * MiB;
constexpr size_t WS_XN = 52 * MiB, WS_U = 86 * MiB, WS_V = 154 * MiB, WS_QH = 222 * MiB, WS_FH = 256 * MiB, WS_IH = 290 * MiB, WS_C = 324 * MiB, WS_K = 392 * MiB, WS_HO = 460 * MiB;
constexpr size_t WS_END = 510 * MiB;
constexpr size_t WS_Q = WS_U, WS_ZP = WS_V, WS_GHP = WS_QH, WS_GAP = WS_FH, WS_GBP = WS_IH, WS_HMN = WS_U, WS_OH = WS_K, WS_YA = WS_K + 34 * MiB, WS_Y = WS_C, WS_H1B = WS_C + 34 * MiB, WS_G2 = WS_HO;
constexpr size_t WS_H2B = WS_XN;
constexpr int CW_BAR = 4096;
constexpr int RING_OFF = 0, RING_BYTES = 131072, LDSCTL_OFF = RING_BYTES, MISC_OFF = LDSCTL_OFF + 320, LDS_BYTES = 147456;

#define GAS __attribute__((address_space(1)))
#define LAS __attribute__((address_space(3)))
typedef unsigned short bf16;
typedef unsigned v4u __attribute__((ext_vector_type(4)));
typedef unsigned v2u __attribute__((ext_vector_type(2)));
typedef float f32x4 __attribute__((ext_vector_type(4)));
typedef GAS unsigned gu32;
#define RLX_AGENT __ATOMIC_RELAXED, __HIP_MEMORY_SCOPE_AGENT
#define LDS_WAIT() asm volatile("s_waitcnt lgkmcnt(0)" ::: "memory")
#define VM_WAIT() asm volatile("s_waitcnt vmcnt(0)" ::: "memory")
__device__ __forceinline__ unsigned f2bf(float f) { unsigned u = __builtin_bit_cast(unsigned, f); return (u + 0x7fffu + ((u >> 16) & 1u)) >> 16; }
__device__ __forceinline__ unsigned pk2(float lo, float hi) { return f2bf(lo) | (f2bf(hi) << 16); }
__device__ __forceinline__ float bflo(unsigned w) { return __builtin_bit_cast(float, w << 16); }
__device__ __forceinline__ float bfhi(unsigned w) { return __builtin_bit_cast(float, w & 0xffff0000u); }
__device__ __forceinline__ float bf2f(bf16 h) { return __builtin_bit_cast(float, (unsigned)h << 16); }
__device__ __forceinline__ void unpack8(v4u w, float (&o)[8]) { o[0] = bflo(w.x); o[1] = bfhi(w.x); o[2] = bflo(w.y); o[3] = bfhi(w.y); o[4] = bflo(w.z); o[5] = bfhi(w.z); o[6] = bflo(w.w); o[7] = bfhi(w.w); }
__device__ __forceinline__ v4u pack8(const float (&o)[8]) { v4u w; w.x = pk2(o[0], o[1]); w.y = pk2(o[2], o[3]); w.z = pk2(o[4], o[5]); w.w = pk2(o[6], o[7]); return w; }
__device__ __forceinline__ float sigmoidf_(float x) { return __builtin_amdgcn_rcpf(1.0f + __expf(-x)); }
__device__ __forceinline__ float siluf_(float x) { return x * sigmoidf_(x); }
__device__ __forceinline__ float logsigmoidf_(float x) { return fminf(x, 0.f) - log1pf(__expf(-fabsf(x))); }

#define XB_TMO      128
#define XB_XCNT(j)  (256  + 64 * (j))
#define XB_XSUB(j)  (1280 + 64 * (j))
#define XB_XGEN(j)  (2304 + 64 * (j))
#define XB_TOP      3328
#define XB_TOPGEN   3392
#define XCD_BAR_WORDS 3456
#define XB_SPIN_CAP (1u << 18)
__device__ __forceinline__ unsigned xb_ld(unsigned* p)              { return __hip_atomic_load(p, __ATOMIC_RELAXED, __HIP_MEMORY_SCOPE_AGENT); }
__device__ __forceinline__ unsigned xb_add(unsigned* p, unsigned v) { return __hip_atomic_fetch_add(p, v, __ATOMIC_RELAXED, __HIP_MEMORY_SCOPE_AGENT); }
__device__ __forceinline__ unsigned xb_xcc_id() { return (unsigned)__builtin_amdgcn_s_getreg((3 << 11) | 20) & 0xFu; }
#define XB_SPIN(cond, bar) do { unsigned _sp = 0; while (cond) { __builtin_amdgcn_s_sleep(1); \
    if ((++_sp & 255u) == 0u) { if (xb_ld(&(bar)[XB_TMO])) break; if (_sp > XB_SPIN_CAP) { atomicAdd(&(bar)[XB_TMO], 1u); break; } } } } while (0)
struct XcdBarrier { unsigned* bar; unsigned x; volatile LAS unsigned* st; };
__device__ __forceinline__ XcdBarrier xcd_barrier_post(unsigned* bar, volatile LAS unsigned* st) {
    XcdBarrier b; b.bar = bar; b.x = xb_xcc_id(); b.st = st;
    if (threadIdx.x == 0) (void)xb_add(&bar[XB_XCNT(b.x)], 1u);
    return b;
}
__device__ __forceinline__ void xcd_barrier_complete(unsigned* bar, unsigned x, unsigned& nloc, unsigned& nx) {
    const unsigned G = gridDim.x * gridDim.y * gridDim.z;
    unsigned sum, cnt, mine, sp = 0u;
    for (;;) {
        sum = 0u; cnt = 0u; mine = 0u;
#pragma unroll
        for (unsigned j = 0; j < 16; ++j) { const unsigned c = xb_ld(&bar[XB_XCNT(j)]); sum += c; cnt += (c > 0u) ? 1u : 0u; mine = (j == x) ? c : mine; }
        if (sum == G) break;
        __builtin_amdgcn_s_sleep(1);
        if ((++sp & 255u) == 0u) { if (xb_ld(&bar[XB_TMO])) break; if (sp > XB_SPIN_CAP) { atomicAdd(&bar[XB_TMO], 1u); break; } }
    }
    nloc = mine > 0u ? mine : 1u; nx = cnt > 0u ? cnt : 1u;
}
__device__ __forceinline__ void xcd_barrier(const XcdBarrier& b) {
    asm volatile("s_waitcnt vmcnt(0)" ::: "memory");
    __syncthreads();
    if (threadIdx.x == 0) {
        unsigned* bar = b.bar;
        __builtin_amdgcn_s_waitcnt(0);
        unsigned nloc = b.st[0], nx = b.st[1];
        if (nloc == 0u) { xcd_barrier_complete(bar, b.x, nloc, nx); b.st[0] = nloc; b.st[1] = nx; }
        const unsigned old = xb_add(&bar[XB_XSUB(b.x)], 1u);
        const unsigned gen = old / nloc;
        if (old + 1u == (gen + 1u) * nloc) {
            __builtin_amdgcn_fence(__ATOMIC_RELEASE, "agent");
            asm volatile("s_waitcnt vmcnt(0)" ::: "memory");
            const unsigned og = xb_add(&bar[XB_TOP], 1u);
            const unsigned tg = og / nx;
            if (og + 1u == (tg + 1u) * nx) xb_add(&bar[XB_TOPGEN], 1u);
            else XB_SPIN(xb_ld(&bar[XB_TOPGEN]) == tg, bar);
            __builtin_amdgcn_fence(__ATOMIC_ACQUIRE, "agent");
            xb_add(&bar[XB_XGEN(b.x)], 1u);
            asm volatile("s_waitcnt vmcnt(0)" ::: "memory");
        } else {
            XB_SPIN(xb_ld(&bar[XB_XGEN(b.x)]) == gen, bar);
            __builtin_amdgcn_fence(__ATOMIC_ACQUIRE, "agent");
            asm volatile("s_waitcnt vmcnt(0)" ::: "memory");
        }
    }
    __syncthreads();
}

__device__ __forceinline__ void local_fence() {
    asm volatile("s_waitcnt vmcnt(0)" ::: "memory"); __syncthreads();
    if (threadIdx.x == 0) { __builtin_amdgcn_fence(__ATOMIC_ACQUIRE, "agent"); asm volatile("s_waitcnt vmcnt(0)" ::: "memory"); }
    __syncthreads();
}
struct Args { const float* in[27]; float* out; unsigned char* ws; int ph_lo, ph_hi, li, pad; };
enum { I_XP = 0, I_XS, I_SCONV, I_SC, I_SN, I_SM, I_SH, I_PP, I_PS, I_NORMG, I_WIN, I_BIG, I_BFG, I_CONVW, I_CONVB, I_WQM, I_WKM, I_MNORMG, I_MSKIP, I_WBRM, I_LB, I_HNORMG, I_WBRH, I_WOUT, I_WPLE, I_WPG, I_FINALG };
struct Frame { LAS unsigned char* lds; int tid, lane, wave, vcu, G; };

__device__ __forceinline__ float wave_sum(float v) {
#pragma unroll
    for (int o = 1; o < 64; o <<= 1) v += __shfl_xor(v, o);
    return v;
}
__device__ __forceinline__ const float* xrow(const Args& a, int m) { return m < NTOK_P ? a.in[I_XP] + (size_t)m * DM : a.in[I_XS] + (size_t)(m - NTOK_P) * DM; }

__device__ __forceinline__ void p0_transpose_item(const float* W, int pitch, int K, int ncols, bf16* WT, int row_off, LAS float* scr, int item, int lane) {
    const int nblk = ncols / 32, kb = item / nblk, nb = item % nblk, k0 = 64 * kb, n0 = 32 * nb;
#pragma unroll 8
    for (int i = 0; i < 32; ++i) { const int kk = 2 * i + (lane >> 5); scr[kk * 33 + (lane & 31)] = W[(size_t)(k0 + kk) * pitch + n0 + (lane & 31)]; }
    LDS_WAIT(); asm volatile("" ::: "memory");
    const int c = lane & 7;
#pragma unroll
    for (int j = 0; j < 4; ++j) { const int n = (lane >> 3) + 8 * j; const LAS float* s = scr + (8 * c) * 33 + n;
        v4u o; o.x = pk2(s[0 * 33], s[1 * 33]); o.y = pk2(s[2 * 33], s[3 * 33]); o.z = pk2(s[4 * 33], s[5 * 33]); o.w = pk2(s[6 * 33], s[7 * 33]);
        *(GAS v4u*)(WT + (size_t)(row_off + n0 + n) * K + k0 + 8 * c) = o; }
    LDS_WAIT(); asm volatile("" ::: "memory");
}
struct Seg { const float* W; int pitch, K, ncols; bf16* WT; int row_off, items; };
__device__ __forceinline__ Seg seg_info(int s, const Args& a) {
    Seg g; unsigned char* ws = a.ws;
    switch (s) {
    case 0: g = Seg{a.in[I_WIN] + 0,    NSRC, 1024, 4096, (bf16*)(ws + WS_WIN), 0,    0}; break;
    case 1: g = Seg{a.in[I_WIN] + 6152, NSRC, 1024, 3072, (bf16*)(ws + WS_WIN), 4096, 0}; break;
    case 2: g = Seg{a.in[I_WIN] + 4096, NSRC, 1024, 2048, (bf16*)(ws + WS_WIN), 7424, 0}; break;
    case 3: g = Seg{a.in[I_WIN] + 9224, NSRC, 1024, 3072, (bf16*)(ws + WS_WIN), 9472, 0}; break;
    case 4: case 5: case 6: case 7: g = Seg{a.in[I_WQM] + (size_t)(s - 4) * 262144, 512, 512, 512, (bf16*)(ws + WS_WQK), (s - 4) * 512, 0}; break;
    case 8: case 9: case 10: case 11: g = Seg{a.in[I_WKM] + (size_t)(s - 8) * 262144, 512, 512, 512, (bf16*)(ws + WS_WQK), 2048 + (s - 8) * 512, 0}; break;
    case 12: g = Seg{a.in[I_WBRM], 1024, 2048, 1024, (bf16*)(ws + WS_WBRM), 0, 0}; break;
    case 13: g = Seg{a.in[I_WBRH], 1024, 1024, 1024, (bf16*)(ws + WS_WBRH), 0, 0}; break;
    case 14: g = Seg{a.in[I_WOUT], 1024, 1024, 1024, (bf16*)(ws + WS_WOUT), 0, 0}; break;
    case 15: g = Seg{a.in[I_WPG],  1024, 1024, 1024, (bf16*)(ws + WS_WPG),  0, 0}; break;
    case 16: g = Seg{a.in[I_WPLE], 1024, 256,  1024, (bf16*)(ws + WS_WPLE), 0, 0}; break;
    default: g = Seg{a.in[I_WIN] + 6144, NSRC, 1024, 32,   (bf16*)(ws + WS_WIN), 7168, 0}; break;
    }
    g.items = (g.K / 64) * (g.ncols / 32);
    return g;
}
__device__ __forceinline__ void p0_pb(Frame& F, const Args& a, int i0, int istride) {
    bf16* PB = (bf16*)(a.ws + WS_PB);
    for (int i = i0; i < NTOK * 32; i += 4 * istride) {
        f32x4 p0[4], p1[4];
#pragma unroll
        for (int k = 0; k < 4; ++k) { const int ii = i + k * istride < NTOK * 32 ? i + k * istride : i; const int m = ii >> 5, c8 = (ii & 31) * 8;
            const float* src = (m < NTOK_P ? a.in[I_PP] + (size_t)m * PLE : a.in[I_PS] + (size_t)(m - NTOK_P) * PLE) + c8;
            p0[k] = *(const GAS f32x4*)src; p1[k] = *(const GAS f32x4*)(src + 4); }
#pragma unroll
        for (int k = 0; k < 4; ++k) { const int ii = i + k * istride; if (ii < NTOK * 32) { const int m = ii >> 5, c8 = (ii & 31) * 8;
            v4u w; w.x = pk2(p0[k].x, p0[k].y); w.y = pk2(p0[k].z, p0[k].w); w.z = pk2(p1[k].x, p1[k].y); w.w = pk2(p1[k].z, p1[k].w);
            *(GAS v4u*)(PB + (size_t)m * PLE + c8) = w; } }
    }
}
__device__ __forceinline__ void p0_prep(Frame& F, const Args& a) {
    LAS float* scr = (LAS float*)(F.lds + RING_OFF + F.wave * 16384);
    const int gw = F.vcu * NWAVES + F.wave, NGW = F.G * NWAVES;
    {
        int s = 0, base = 0; Seg g = seg_info(0, a);
        for (int f = gw; ; f += NGW) {
            while (s < 18 && f >= base + g.items) { base += g.items; ++s; if (s < 18) g = seg_info(s, a); }
            if (s >= 18) break;
            p0_transpose_item(g.W, g.pitch, g.K, g.ncols, g.WT, g.row_off, scr, f - base, F.lane);
        }
    }
    bf16* XN = (bf16*)(a.ws + WS_XN);
    const float* ng = a.in[I_NORMG];
    for (int m = gw; m < NTOK; m += NGW) {
        const GAS f32x4* xr = (const GAS f32x4*)xrow(a, m) + F.lane;
        f32x4 v[4]; float ss = 0.f;
#pragma unroll
        for (int j = 0; j < 4; ++j) { v[j] = xr[64 * j]; ss += (v[j].x * v[j].x + v[j].y * v[j].y) + (v[j].z * v[j].z + v[j].w * v[j].w); }
        const float rstd = 1.0f / sqrtf(wave_sum(ss) * (1.f / DM) + EPS);
        GAS v2u* o8 = (GAS v2u*)(XN + (size_t)m * DM) + F.lane;
#pragma unroll
        for (int j = 0; j < 4; ++j) {
            const f32x4 gg = *(const GAS f32x4*)(ng + 4 * F.lane + 256 * j);
            v[j] = v[j] * rstd * gg;
            v2u w; w.x = pk2(v[j].x, v[j].y); w.y = pk2(v[j].z, v[j].w); o8[64 * j] = w;
        }
    }
    if (F.G != 256) p0_pb(F, a, F.vcu * NTHREADS + F.tid, F.G * NTHREADS);
}

__device__ __forceinline__ void p2_conv(Frame& F, const Args& a) {
    const bf16* U = (const bf16*)(a.ws + WS_U); bf16* C = (bf16*)(a.ws + WS_C);
    const float* cw = a.in[I_CONVW]; const float* cb = a.in[I_CONVB]; const float* sconv = a.in[I_SCONV];
    const int ch = (F.tid & 255) * 8;
    float wv[4][8], bv[8];
#pragma unroll
    for (int j = 0; j < 4; ++j) { const f32x4 w0 = *(const GAS f32x4*)(cw + (size_t)j * MI + ch), w1 = *(const GAS f32x4*)(cw + (size_t)j * MI + ch + 4);
        wv[j][0] = w0.x; wv[j][1] = w0.y; wv[j][2] = w0.z; wv[j][3] = w0.w; wv[j][4] = w1.x; wv[j][5] = w1.y; wv[j][6] = w1.z; wv[j][7] = w1.w; }
    { const f32x4 b0 = *(const GAS f32x4*)(cb + ch), b1 = *(const GAS f32x4*)(cb + ch + 4); bv[0] = b0.x; bv[1] = b0.y; bv[2] = b0.z; bv[3] = b0.w; bv[4] = b1.x; bv[5] = b1.y; bv[6] = b1.z; bv[7] = b1.w; }
    const int GC = F.G > 32 ? F.G - 16 : F.G;
    if (F.vcu >= GC) return;
    const int i0 = F.vcu * NTHREADS + F.tid, istr = GC * NTHREADS, iend = (NTOK / 4) * 256;
    v4u raw[7], nxt[7];
#define CV_LOAD(dst, ii) do { const int tk_ = ((ii) >> 8) * 4; _Pragma("unroll") for (int j = 0; j < 7; ++j) { int tr_ = tk_ - 3 + j; tr_ = tr_ < 0 ? 0 : tr_; dst[j] = *(const GAS v4u*)(U + (size_t)tr_ * MI + ch); } } while (0)
    if (i0 < iend) CV_LOAD(raw, i0);
    for (int i = i0; i < iend; i += istr) {
        { const int in_ = (i + istr < iend) ? i + istr : i; CV_LOAD(nxt, in_); }
        const int tok = (i >> 8) * 4;
        const bool smp = tok >= NTOK_P;
        const int b = smp ? (tok - NTOK_P) >> 5 : tok >> 12, t = smp ? (tok - NTOK_P) & 31 : tok & 4095;
        float u[7][8];
#pragma unroll
        for (int j = 0; j < 7; ++j) {
            unpack8(raw[j], u[j]);
            if (j < 3 && t == 0) {
                if (smp) { const float* sp = sconv + (size_t)(b * 3 + j) * MI + ch; const f32x4 s0 = *(const GAS f32x4*)sp, s1 = *(const GAS f32x4*)(sp + 4);
                    u[j][0] = s0.x; u[j][1] = s0.y; u[j][2] = s0.z; u[j][3] = s0.w; u[j][4] = s1.x; u[j][5] = s1.y; u[j][6] = s1.z; u[j][7] = s1.w; }
                else {
#pragma unroll
                    for (int e = 0; e < 8; ++e) u[j][e] = 0.f; }
            }
        }
        const int tl = smp ? TS : TP;
#pragma unroll
        for (int q = 0; q < 4; ++q) {
            float acc[8];
#pragma unroll
            for (int e = 0; e < 8; ++e) acc[e] = siluf_(bv[e] + u[q][e] * wv[0][e] + u[q + 1][e] * wv[1][e] + u[q + 2][e] * wv[2][e] + u[q + 3][e] * wv[3][e]);
            *(GAS v4u*)(C + (size_t)(tok + q) * MI + ch) = pack8(acc);
            if (t + q >= tl - 3) {
                float* dst = a.out + (smp ? O_CONVS : O_CONVP) + (size_t)(b * 3 + (t + q - (tl - 3))) * MI + ch;
                *(GAS f32x4*)dst = (f32x4){u[q + 3][0], u[q + 3][1], u[q + 3][2], u[q + 3][3]}; *(GAS f32x4*)(dst + 4) = (f32x4){u[q + 3][4], u[q + 3][5], u[q + 3][6], u[q + 3][7]};
            }
        }
#pragma unroll
        for (int j = 0; j < 7; ++j) raw[j] = nxt[j];
    }
#undef CV_LOAD
}

typedef short s16x4 __attribute__((ext_vector_type(4)));
typedef short bf16x8 __attribute__((ext_vector_type(8)));
typedef float f32x16 __attribute__((ext_vector_type(16)));
typedef float f32x2 __attribute__((ext_vector_type(2)));
typedef __bf16 bf16x2v __attribute__((ext_vector_type(2)));
#define MFMA32(a, b, c) __builtin_amdgcn_mfma_f32_32x32x16_bf16((a), (b), (c), 0, 0, 0)
__device__ __forceinline__ unsigned pkc(float lo, float hi) { f32x2 f = {lo, hi}; bf16x2v h = __builtin_convertvector(f, bf16x2v); return __builtin_bit_cast(unsigned, h); }
__device__ __forceinline__ int crow(int reg, int hh) { return (reg & 3) + 8 * (reg >> 2) + 4 * hh; }
__device__ __forceinline__ bf16x8 pack_step(const f32x16& x, int s) {
    v4u p; p.x = pkc(x[8 * s], x[8 * s + 1]); p.y = pkc(x[8 * s + 2], x[8 * s + 3]); p.z = pkc(x[8 * s + 4], x[8 * s + 5]); p.w = pkc(x[8 * s + 6], x[8 * s + 7]);
    return __builtin_bit_cast(bf16x8, p);
}
__device__ __forceinline__ s16x4 trr(LAS unsigned char* p) { return __builtin_amdgcn_ds_read_tr16_b64_v4i16((LAS s16x4*)p); }
__device__ __forceinline__ bf16x8 tr_frag(LAS unsigned char* img, int pitch, int k0, int c0, int lane) {
    const int hh = lane >> 5, blk = (lane >> 4) & 1, qq = (lane & 15) >> 2, pp = lane & 3;
    LAS unsigned char* p = img + (k0 + 8 * hh + qq) * pitch + (c0 + 16 * blk + 4 * pp) * 2;
    const s16x4 lo = trr(p), hi = trr(p + 4 * pitch);
    return __builtin_shufflevector(lo, hi, 0, 1, 2, 3, 4, 5, 6, 7);
}

constexpr size_t WS_HA = 498 * MiB + 512 * 1024, WS_EGL = 507 * MiB;
constexpr size_t WS_PT = 494 * MiB, WS_SC = 10 * MiB + 512 * 1024, WS_DENI = 11 * MiB + 256 * 1024;

template <int CTRL, int ROWMASK> __device__ __forceinline__ float dpp_f(float ident, float v) {
    return __builtin_bit_cast(float, __builtin_amdgcn_update_dpp(__builtin_bit_cast(int, ident), __builtin_bit_cast(int, v), CTRL, ROWMASK, 0xF, false)); }
__device__ __forceinline__ float wave_scan_add(float v) {
    v += dpp_f<0x111, 0xF>(0.f, v); v += dpp_f<0x112, 0xF>(0.f, v); v += dpp_f<0x114, 0xF>(0.f, v); v += dpp_f<0x118, 0xF>(0.f, v);
    v += dpp_f<0x142, 0xA>(0.f, v); v += dpp_f<0x143, 0xC>(0.f, v); return v; }
__device__ __forceinline__ float wave_scan_max(float v) {
    const float NI = -3.0e38f;
    v = fmaxf(v, dpp_f<0x111, 0xF>(NI, v)); v = fmaxf(v, dpp_f<0x112, 0xF>(NI, v)); v = fmaxf(v, dpp_f<0x114, 0xF>(NI, v)); v = fmaxf(v, dpp_f<0x118, 0xF>(NI, v));
    v = fmaxf(v, dpp_f<0x142, 0xA>(NI, v)); v = fmaxf(v, dpp_f<0x143, 0xC>(NI, v)); return v; }
__device__ __forceinline__ void p2_scan(Frame& F, const Args& a) {
    const int lane = F.lane, w = F.wave;
    const float* GATES = (const float*)(a.ws + WS_GATES); float* SC = (float*)(a.ws + WS_SC);
    LAS float* red = (LAS float*)(F.lds + RING_OFF);
    const float NEG = -3.0e38f;
    for (int sh = F.vcu; sh < BP * MH; sh += F.G) {
        const int b = sh >> 2, h = sh & 3, tokw = b * TP + 512 * w;
        float lf[8], ig[8], bl[8], lm[8];
#pragma unroll
        for (int j = 0; j < 8; ++j) { const size_t tk = (size_t)(tokw + 64 * j + lane) * 8; lf[j] = GATES[tk + 4 + h]; ig[j] = GATES[tk + h]; }
        float base = 0.f, run = NEG;
#pragma unroll
        for (int j = 0; j < 8; ++j) {
            const float bg = base + wave_scan_add(lf[j]);
            const float mr = fmaxf(run, wave_scan_max(ig[j] - bg));
            bl[j] = bg; lm[j] = mr;
            base = __builtin_bit_cast(float, __builtin_amdgcn_readlane(__builtin_bit_cast(int, bg), 63)); run = __builtin_bit_cast(float, __builtin_amdgcn_readlane(__builtin_bit_cast(int, mr), 63));
        }
        __syncthreads();
        if (lane == 0) { red[2 * w] = base; red[2 * w + 1] = run; }
        __syncthreads();
        float cb = 0.f, cr = 0.f;
        for (int i = 0; i < w; ++i) { cr = fmaxf(cr, red[2 * i + 1] - cb); cb += red[2 * i]; }
#pragma unroll
        for (int j = 0; j < 8; ++j) { const size_t tk = (size_t)(tokw + 64 * j + lane) * 8; const float bg = cb + bl[j], mr = fmaxf(cr, lm[j] - cb);
            SC[tk + h * 2] = bg; SC[tk + h * 2 + 1] = bg + mr; }
    }
    const int gw = (F.vcu - BP * MH) * NWAVES + w, NGW = F.G * NWAVES;
    for (int sh = gw < 0 ? gw + NGW : gw; sh < BS * MH; sh += NGW) {
        const int b = sh >> 2, h = sh & 3, tok0 = NTOK_P + b * TS;
        const float minit = a.in[I_SM][b * MH + h];
        const int t = lane & 31; const float* G = GATES + (size_t)(tok0 + t) * 8;
        const float lf = G[4 + h], ig = G[h];
        float incl = lf;
#pragma unroll
        for (int o = 1; o < 32; o <<= 1) { const float v = __shfl_up(incl, o); if (t >= o) incl += v; }
        float pm = ig - incl;
#pragma unroll
        for (int o = 1; o < 32; o <<= 1) { const float v = __shfl_up(pm, o); if (t >= o) pm = fmaxf(pm, v); }
        if (lane < 32) { float* o = SC + (size_t)(tok0 + t) * 8 + h * 2; o[0] = incl; o[1] = incl + fmaxf(minit, pm); }
    }
}

template <int KD, bool DECAY>
__device__ __forceinline__ void score_tiles(Frame& F, const bf16* Qb, const bf16* Kb, int ld, int nunits, int nprompt, int nh, bf16* OUT, const float* GATES, const float* SC, int u0, int ustride) {
    constexpr int QP = KD * 2 + 16, NPC = KD / 128;
    constexpr int L_Q = 0, L_K = 32 * QP, L_RED = 2 * 32 * QP, L_TAB = L_RED + 32768;
    const int tid = F.tid, lane = F.lane, w = F.wave, r = lane & 31, hh = lane >> 5;
    LAS unsigned char* lds = F.lds + RING_OFF;
    LAS float* tab = (LAS float*)(lds + L_TAB);
    v4u rq[NPC], rk[NPC]; float t0 = 0.f, t1 = 0.f;
    auto decode = [&](int u, int& hcol, int& tok0, int& h) {
        if (u < nprompt) { const int bh = u >> 7, c = u & 127; h = bh % nh; tok0 = (bh / nh) * TP + c * 32; }
        else { const int bh = u - nprompt; h = bh % nh; tok0 = NTOK_P + (bh / nh) * TS; }
        hcol = h * KD; };
#define ST_LOAD(u) do { int hcol_, tok0_, h_; decode((u), hcol_, tok0_, h_); \
        _Pragma("unroll") for (int i = 0; i < NPC; ++i) { const int piece = tid + 512 * i, row = piece / (KD / 8), c16 = piece % (KD / 8); const size_t off = (size_t)(tok0_ + row) * ld + hcol_ + c16 * 8; \
            rq[i] = *(const GAS v4u*)(Qb + off); rk[i] = *(const GAS v4u*)(Kb + off); } \
        if (DECAY && tid < 32) { const size_t tk = (size_t)(tok0_ + tid) * 8; const float Bg = SC[tk + h_ * 2], m = SC[tk + h_ * 2 + 1], ig = GATES[tk + h_]; t0 = Bg - m; t1 = ig - Bg; } } while (0)
    int u = u0;
    if (u < nunits) ST_LOAD(u);
    for (; u < nunits; u += ustride) {
#pragma unroll
        for (int i = 0; i < NPC; ++i) { const int piece = tid + 512 * i, row = piece / (KD / 8), c16 = piece % (KD / 8);
            *(LAS v4u*)(lds + L_Q + row * QP + c16 * 16) = rq[i]; *(LAS v4u*)(lds + L_K + row * QP + c16 * 16) = rk[i]; }
        if (DECAY && tid < 32) { tab[tid] = t0; tab[32 + tid] = t1; }
        __syncthreads();
        if (u + ustride < nunits) ST_LOAD(u + ustride);
        f32x16 acc;
#pragma unroll
        for (int i = 0; i < 16; ++i) acc[i] = 0.f;
#pragma unroll
        for (int ks = 0; ks < KD / 128; ++ks) {
            const int d0 = (KD / 8) * w + 16 * ks + 8 * hh;
            const bf16x8 af = *(const LAS bf16x8*)(lds + L_Q + r * QP + d0 * 2), bfr = *(const LAS bf16x8*)(lds + L_K + r * QP + d0 * 2);
            acc = MFMA32(af, bfr, acc);
        }
        { LAS float* red = (LAS float*)(lds + L_RED) + w * 1024;
#pragma unroll
          for (int g = 0; g < 16; ++g) red[g * 64 + lane] = acc[g]; }
        __syncthreads();
#pragma unroll
        for (int gg = 0; gg < 2; ++gg) {
            const int g = 2 * w + gg; float v = 0.f;
#pragma unroll
            for (int k = 0; k < 8; ++k) v += ((const LAS float*)(lds + L_RED))[k * 1024 + g * 64 + lane];
            const int t = crow(g, hh);
            if (DECAY) v *= __expf(tab[t] + tab[32 + r]);
            OUT[(size_t)u * 1024 + t * 32 + r] = (bf16)(pkc((r <= t) ? v : 0.f, 0.f) & 0xffffu);
        }
        __syncthreads();
    }
#undef ST_LOAD
}
__device__ __forceinline__ void p4_atiles(Frame& F, const Args& a, int u0, int ustride) {
    score_tiles<128, false>(F, (const bf16*)(a.ws + WS_QH), (const bf16*)(a.ws + WS_FH), DM, 4352, 4096, HH, (bf16*)(a.ws + WS_HA), nullptr, nullptr, u0, ustride);
}
__device__ __forceinline__ void p4_tiles(Frame& F, const Args& a) {
    score_tiles<512, true>(F, (const bf16*)(a.ws + WS_Q), (const bf16*)(a.ws + WS_K), MI, 2176, 2048, MH, (bf16*)(a.ws + WS_PT), (const float*)(a.ws + WS_GATES), (const float*)(a.ws + WS_SC), (int)blockIdx.x, F.G);
    if (F.G != 256) p4_atiles(F, a, (int)blockIdx.x, F.G);
}

__device__ __forceinline__ void p2_hprep(Frame& F, const Args& a) {
    bf16* QH = (bf16*)(a.ws + WS_QH); bf16* FH = (bf16*)(a.ws + WS_FH); float* EGL = (float*)(a.ws + WS_EGL);
    for (int i = (F.G - 1 - F.vcu) * NTHREADS + F.tid; i < (NTOK / 32) * (DM / 4); i += F.G * NTHREADS) {
        const int ch = i >> 8, col = (i & 255) * 4;
        const f32x4 l0 = *(const GAS f32x4*)(a.in[I_LB] + col), l1 = *(const GAS f32x4*)(a.in[I_LB] + DM + col);
        float lb[4], eg[4];
#pragma unroll
        for (int e = 0; e < 4; ++e) { lb[e] = __builtin_amdgcn_rcpf(1.0f + __expf(l1[e] - l0[e])); eg[e] = 1.0f; }
        size_t off = (size_t)ch * 32 * DM + col;
#pragma unroll 4
        for (int t = 0; t < 32; ++t, off += DM) {
            const v2u fw = *(const GAS v2u*)(FH + off), qw = *(const GAS v2u*)(QH + off);
            const float fl[4] = {bflo(fw.x), bfhi(fw.x), bflo(fw.y), bfhi(fw.y)}, ql[4] = {bflo(qw.x), bfhi(qw.x), bflo(qw.y), bfhi(qw.y)};
            float qo[4], ko[4];
#pragma unroll
            for (int e = 0; e < 4; ++e) {
                const float sg = sigmoidf_(fl[e]);
                eg[e] *= lb[e] + (1.0f - lb[e]) * sg;
                qo[e] = siluf_(ql[e]) * eg[e];
                ko[e] = (1.0f - lb[e]) * (1.0f - sg) * __builtin_amdgcn_rcpf(eg[e]);
            }
            v2u qv, kv; qv.x = pkc(qo[0], qo[1]); qv.y = pkc(qo[2], qo[3]); kv.x = pkc(ko[0], ko[1]); kv.y = pkc(ko[2], ko[3]);
            *(GAS v2u*)(QH + off) = qv; *(GAS v2u*)(FH + off) = kv;
        }
        *(GAS f32x4*)(EGL + (size_t)ch * DM + col) = (f32x4){eg[0], eg[1], eg[2], eg[3]};
    }
}
#ifndef TPROBE
#define TPROBE 0
#endif
#define REC_BAR() do { asm volatile("s_waitcnt lgkmcnt(0)" ::: "memory"); __builtin_amdgcn_s_barrier(); asm volatile("" ::: "memory"); } while (0)
template <bool HG>
__device__ __forceinline__ void rec_unit(Frame& F, const Args& a, int unit) {
    constexpr int KD = HG ? 128 : 512, VC = HG ? 128 : 64;
    constexpr int NT = HG ? KD / 32 : KD / 64, DW = HG ? KD : KD / 2, NSL = HG ? 1 : 9, NPROMPT = HG ? 32 : 144;
    constexpr int QP = KD * 2 + 8, KP = KD * 2 + 64, VP = VC * 2 + 64, PPI = 80, HP = VC * 2 + 16, LDT = HG ? DM : MI;
    constexpr int NPQ = KD / 64, PPR = KD / 8, NPV = VC / 64, PPV = VC / 8;
    constexpr int L_Q = 0, L_K = L_Q + 32 * QP, L_V = L_K + 32 * KP, L_VW = L_V + 32 * VP, L_P = L_VW + 32 * VP, L_RED = L_P + 32 * PPI, L_SC = L_RED + 16384, L_H = L_SC + 2048, L_END = L_H + 32 * HP;
    static_assert(L_END <= RING_BYTES && (L_K % 16) == 0 && (L_V % 16) == 0 && (L_RED % 16) == 0 && (L_H % 16) == 0, "rec LDS map");
    const bool smp = unit >= NPROMPT; const int uu = smp ? unit - NPROMPT : unit;
    const int bh = uu / NSL, es = uu - bh * NSL; const bool den = !HG && es == 8;
    const int b = HG ? bh >> 3 : bh >> 2, h = HG ? bh & 7 : bh & 3;
    const int T = smp ? TS : TP, tok0 = smp ? NTOK_P + b * TS : b * TP, nsteps = T / 32;
    const int tid = F.tid, lane = F.lane, w = F.wave, r = lane & 31, hh = lane >> 5;
    LAS unsigned char* lds = F.lds + RING_OFF;
    LAS float* LS = (LAS float*)(lds + L_SC);
    const bf16* Qb = (const bf16*)(a.ws + (HG ? WS_QH : WS_Q)); const bf16* Kb = (const bf16*)(a.ws + (HG ? WS_FH : WS_K)); const bf16* Vb = (const bf16*)(a.ws + (HG ? WS_IH : WS_V));
    const bf16* PTb = (const bf16*)(a.ws + (HG ? WS_HA : WS_PT)) + (size_t)(smp ? (HG ? 4096 : 2048) + bh : bh * 128) * 1024;
    bf16* OUTb = HG ? (bf16*)(a.ws + WS_HO) : (bf16*)a.out;
    const unsigned colq = (unsigned)h * KD, colv = (unsigned)h * KD + (unsigned)(es & 7) * 64u;
    REC_BAR();
    if (w < 4) {
        const int we = HG ? w : (w & 1), wd = HG ? 0 : (w >> 1), el0 = 32 * we, dt0 = DW * wd;
        int ln = lane; asm volatile("" : "+v"(ln)); const int r_ = ln & 31, hh_ = ln >> 5, lb = ln, hb_ = hh_;
        f32x16 X[NT];
        if (smp && HG) {
            const float* s0 = a.in[I_SH] + ((size_t)bh * HE + dt0 + 4 * hh) * HE + es * 64 + el0 + r;
#pragma unroll
            for (int i = 0; i < NT; ++i)
#pragma unroll
                for (int g = 0; g < 16; ++g) X[i][g] = s0[(size_t)(32 * i + (g & 3) + 8 * (g >> 2)) * HE];
        } else if (smp && !den) {
            if constexpr (!HG) {
            LAS float* sx = (LAS float*)(lds + L_K) + w * (32 * 68);
            const float* cb = a.in[I_SC] + ((size_t)bh * MHD + es * 64 + el0) * MHD + dt0;
            const int lr = ln >> 4, lp = ln & 15;
            f32x4 tmp[2][8];
#pragma unroll
            for (int k = 0; k < 8; ++k) tmp[0][k] = *(const GAS f32x4*)(cb + (size_t)(4 * k + lr) * MHD + lp * 4);
#pragma unroll
            for (int j = 0; j < 4; ++j) {
                if (j + 1 < 4) {
#pragma unroll
                    for (int k = 0; k < 8; ++k) tmp[(j + 1) & 1][k] = *(const GAS f32x4*)(cb + (size_t)(4 * k + lr) * MHD + (j + 1) * 64 + lp * 4); }
#pragma unroll
                for (int k = 0; k < 8; ++k) *(LAS f32x4*)(sx + (4 * k + lr) * 68 + lp * 4) = tmp[j & 1][k];
                asm volatile("s_waitcnt lgkmcnt(0)" ::: "memory");
#pragma unroll
                for (int ii = 0; ii < 2; ++ii)
#pragma unroll
                    for (int g = 0; g < 4; ++g) { const f32x4 v = *(const LAS f32x4*)(sx + r_ * 68 + 32 * ii + 8 * g + 4 * hh_);
                        X[2 * j + ii][4 * g] = v.x; X[2 * j + ii][4 * g + 1] = v.y; X[2 * j + ii][4 * g + 2] = v.z; X[2 * j + ii][4 * g + 3] = v.w; }
                asm volatile("s_waitcnt lgkmcnt(0)" ::: "memory");
            }
            }
        } else if (smp) {
            const float* c0 = a.in[I_SN] + (size_t)bh * MHD + dt0 + 4 * hh_;
#pragma unroll
            for (int i = 0; i < NT; ++i) {
#pragma unroll
                for (int g = 0; g < 4; ++g) { const f32x4 v = *(const GAS f32x4*)(c0 + 32 * i + 8 * g); X[i][4 * g] = v.x; X[i][4 * g + 1] = v.y; X[i][4 * g + 2] = v.z; X[i][4 * g + 3] = v.w; }
            }
            if (!(we == 0 && r_ == 0)) {
#pragma unroll
                for (int i = 0; i < NT; ++i)
#pragma unroll
                    for (int g = 0; g < 16; ++g) X[i][g] = 0.f;
            }
        } else {
#pragma unroll
            for (int i = 0; i < NT; ++i)
#pragma unroll
                for (int g = 0; g < 16; ++g) X[i][g] = 0.f;
        }
        REC_BAR();
        unsigned long long tp_sum = 0ull, tp_t = 0ull; const bool tp_on = TPROBE && !HG && den && !smp && we == 0;
        for (int step = 0; step < nsteps; ++step) {
            LAS float* ls = LS + (step & 1) * 256;
            if (TPROBE == 1 && tp_on && step >= 8) tp_t = __builtin_amdgcn_s_memtime();
            const bf16x8 vb0 = tr_frag(lds + L_V, VP, 0, el0, ln), vb1 = tr_frag(lds + L_V, VP, 16, el0, ln);
            constexpr int NB = NT > 2 ? 2 : NT;
            f32x16 acc;
#pragma unroll
            for (int g = 0; g < 16; ++g) acc[g] = 0.f;
            f32x4 wv[4]; bf16x8 p0 = {0, 0, 0, 0, 0, 0, 0, 0}, p1 = {0, 0, 0, 0, 0, 0, 0, 0};
#pragma unroll
            for (int ib = 0; ib < NT; ib += NB) {
                bf16x8 pa[NB][2];
#pragma unroll
                for (int i = 0; i < NB; ++i)
#pragma unroll
                    for (int s = 0; s < 2; ++s) {
                        LAS unsigned char* qa = lds + L_Q + r_ * QP + (dt0 + 32 * (ib + i) + 16 * s + 4 * hh_) * 2;
                        const s16x4 lo = *(const LAS s16x4*)qa, hi = *(const LAS s16x4*)(qa + 16);
                        pa[i][s] = __builtin_shufflevector(lo, hi, 0, 1, 2, 3, 4, 5, 6, 7);
                    }
                if (ib + NB >= NT) {
                    if (!HG) {
#pragma unroll
                        for (int q4 = 0; q4 < 4; ++q4) wv[q4] = *(const LAS f32x4*)(ls + 8 * q4 + 4 * hh_);
                    }
                    if (wd == 0) { p0 = *(const LAS bf16x8*)(lds + L_P + r_ * PPI + (8 * hh_) * 2); p1 = *(const LAS bf16x8*)(lds + L_P + r_ * PPI + (16 + 8 * hh_) * 2); }
                }
                __builtin_amdgcn_sched_barrier(0);
#pragma unroll
                for (int i = 0; i < NB; ++i)
#pragma unroll
                    for (int s = 0; s < 2; ++s) acc = MFMA32(pa[i][s], pack_step(X[ib + i], s), acc);
                __builtin_amdgcn_sched_barrier(0);
            }
            if (!HG) {
#pragma unroll
                for (int g = 0; g < 16; ++g) acc[g] *= wv[g >> 2][g & 3];
            }
            if (wd == 0) { acc = MFMA32(p0, vb0, acc); acc = MFMA32(p1, vb1, acc); }
            { LAS float* red = (LAS float*)(lds + L_RED) + w * 1024;
#pragma unroll
              for (int g = 0; g < 16; ++g) red[g * 64 + ln] = acc[g]; }
            if (TPROBE == 1 && tp_on && step >= 8) tp_sum += __builtin_amdgcn_s_memtime() - tp_t;
            if (TPROBE == 2 && tp_on && step >= 8) tp_t = __builtin_amdgcn_s_memtime();
            REC_BAR();
            if (TPROBE == 2 && tp_on && step >= 8) tp_sum += __builtin_amdgcn_s_memtime() - tp_t;
            if (TPROBE == 3 && tp_on && step >= 8) tp_t = __builtin_amdgcn_s_memtime();
            if (!HG) {
                const bf16x8 vw0 = tr_frag(lds + L_VW, VP, 0, el0, lb), vw1 = tr_frag(lds + L_VW, VP, 16, el0, lb);
                const float dec = ls[64];
                constexpr int NB = NT > 4 ? 4 : NT;
#pragma unroll
                for (int ib = 0; ib < NT; ib += NB) {
                    bf16x8 ka[NB][2];
#pragma unroll
                    for (int i = 0; i < NB; ++i) { ka[i][0] = tr_frag(lds + L_K, KP, 0, dt0 + 32 * (ib + i), lb); ka[i][1] = tr_frag(lds + L_K, KP, 16, dt0 + 32 * (ib + i), lb); }
                    __builtin_amdgcn_sched_barrier(0);
#pragma unroll
                    for (int i = 0; i < NB; ++i) {
                        X[ib + i] = X[ib + i] * dec;
                        X[ib + i] = MFMA32(ka[i][0], vw0, X[ib + i]); X[ib + i] = MFMA32(ka[i][1], vw1, X[ib + i]);
                    }
                    __builtin_amdgcn_sched_barrier(0);
                }
            } else {
#pragma unroll
                for (int i = 0; i < NT; ++i) {
                    const bf16x8 ka0 = tr_frag(lds + L_K, KP, 0, dt0 + 32 * i, lb), ka1 = tr_frag(lds + L_K, KP, 16, dt0 + 32 * i, lb);
                    X[i] = MFMA32(ka0, vb0, X[i]); X[i] = MFMA32(ka1, vb1, X[i]);
#pragma unroll
                    for (int g = 0; g < 16; ++g) X[i][g] *= ls[128 + dt0 + 32 * i + crow(g, hb_)];
                }
            }
            if (TPROBE == 3 && tp_on && step >= 8) tp_sum += __builtin_amdgcn_s_memtime() - tp_t;
            if (TPROBE == 4 && tp_on && step >= 8) tp_t = __builtin_amdgcn_s_memtime();
            REC_BAR();
            if (TPROBE == 4 && tp_on && step >= 8) tp_sum += __builtin_amdgcn_s_memtime() - tp_t;
        }
        if (TPROBE && tp_on) {
            const float avg = (float)tp_sum / 120.0f; const float eps = sqrtf(1.0e-4f * (1.0f + fminf(avg, 7000.f) / 2000.0f));
#pragma unroll
            for (int i = 0; i < NT; ++i)
#pragma unroll
                for (int g = 0; g < 16; ++g) X[i][g] *= (1.0f + eps);
        }
        if (HG) {
            float* so = a.out + (smp ? O_SS : O_SP) + ((size_t)bh * HE + dt0 + 4 * hh) * HE + es * 64 + el0 + r;
#pragma unroll
            for (int i = 0; i < NT; ++i)
#pragma unroll
                for (int g = 0; g < 16; ++g) so[(size_t)(32 * i + (g & 3) + 8 * (g >> 2)) * HE] = X[i][g];
        } else if (!den) {
            if constexpr (!HG) {
            LAS float* sx = (LAS float*)(lds + L_K) + w * (32 * 68);
            float* cb = a.out + (smp ? O_CS : O_CP) + ((size_t)bh * MHD + es * 64 + el0) * MHD + dt0;
            const int lr = ln >> 4, lp = ln & 15;
#pragma unroll
            for (int j = 0; j < 4; ++j) {
#pragma unroll
                for (int ii = 0; ii < 2; ++ii)
#pragma unroll
                    for (int g = 0; g < 4; ++g) *(LAS f32x4*)(sx + r_ * 68 + 32 * ii + 8 * g + 4 * hh_) = (f32x4){X[2 * j + ii][4 * g], X[2 * j + ii][4 * g + 1], X[2 * j + ii][4 * g + 2], X[2 * j + ii][4 * g + 3]};
                asm volatile("s_waitcnt lgkmcnt(0)" ::: "memory");
#pragma unroll
                for (int k = 0; k < 8; ++k) { const f32x4 v = *(const LAS f32x4*)(sx + (4 * k + lr) * 68 + lp * 4); *(GAS f32x4*)(cb + (size_t)(4 * k + lr) * MHD + j * 64 + lp * 4) = v; }
                asm volatile("s_waitcnt lgkmcnt(0)" ::: "memory");
            }
            }
        } else if (we == 0 && r_ == 0) {
            float* co = a.out + (smp ? O_NS : O_NP) + (size_t)bh * MHD + dt0 + 4 * hh_;
#pragma unroll
            for (int i = 0; i < NT; ++i)
#pragma unroll
                for (int g = 0; g < 4; ++g) *(GAS f32x4*)(co + 32 * i + 8 * g) = (f32x4){X[i][4 * g], X[i][4 * g + 1], X[i][4 * g + 2], X[i][4 * g + 3]};
        }
    } else {
        __builtin_amdgcn_s_setprio(2);
        int ht_ = tid - 256; asm volatile("" : "+v"(ht_));
        const int ht = ht_, hx = ht_, hw = w - 4;
        const float* GATES = (const float*)(a.ws + WS_GATES); const float* SC = (const float*)(a.ws + WS_SC); const float* EGL = (const float*)(a.ws + WS_EGL);
        float* DEN = (float*)(a.ws + WS_DENI);
        const GAS unsigned char* Qg = (const GAS unsigned char*)Qb; const GAS unsigned char* Kg = (const GAS unsigned char*)Kb; const GAS unsigned char* Vg = (const GAS unsigned char*)Vb; const GAS unsigned char* Pg = (const GAS unsigned char*)PTb;
        v4u rq[NPQ], rk[NPQ], rvc = {0u, 0u, 0u, 0u}, rvn[NPV], rp = {0u, 0u, 0u, 0u}; float sBg = 0.f, sm = 0.f, sig = 0.f, seg = 0.f;
        float Bprev = 0.f, mprev = (!HG && smp) ? a.in[I_SM][bh] : 0.f;
        const unsigned qoff0 = (unsigned)(tok0 + ht / PPR) * LDT + colq + (unsigned)(ht % PPR) * 8u;
        const unsigned voff0 = (unsigned)(tok0 + ht / PPV) * LDT + colv + (unsigned)(ht % PPV) * 8u;
        constexpr unsigned VSTEP = (256 / PPV) * LDT;
        const int pidx = (ht - 64) & 127;
        const unsigned poff0 = (unsigned)(pidx >> 2) * 32u + (unsigned)(pidx & 3) * 8u;
        constexpr unsigned RSTEP = (256 / PPR) * LDT;
        unsigned pfq = 0u, pfk = 0u, pfacc = 0u;
        const unsigned pfoff0 = (unsigned)(tok0 + (ht >> 3)) * LDT + colq + (unsigned)(ht & (KD == 512 ? 7 : 1)) * 64u;
#define RC_WARM(c0) do { pfacc ^= pfq ^ pfk; const unsigned cs_ = (unsigned)((c0) < T ? (c0) : T - 32) * LDT; \
            pfq = *(const GAS unsigned*)(Qg + 2u * (pfoff0 + cs_)); pfk = *(const GAS unsigned*)(Kg + 2u * (pfoff0 + cs_)); } while (0)
#define RC_LOADQ(c0x) do { const int c0_ = (c0x) < T ? (c0x) : T - 32; const unsigned cs_ = (unsigned)c0_ * LDT;     \
            _Pragma("unroll") for (int i = 0; i < NPQ; ++i) rq[i] = *(const GAS v4u*)(Qg + 2u * (qoff0 + cs_ + (unsigned)i * RSTEP)); \
            _Pragma("unroll") for (int i = 0; i < NPV; ++i) rvn[i] = *(const GAS v4u*)(Vg + 2u * (voff0 + cs_ + (unsigned)i * VSTEP)); \
            rp = *(const GAS v4u*)(Pg + 2u * (poff0 + (unsigned)c0_ * 32u)); \
            if (!HG) { const unsigned tk = (unsigned)(tok0 + c0_ + (ht & 31)) * 8u + (unsigned)h * 2u; sBg = SC[tk]; sm = SC[tk + 1]; sig = GATES[tk - (unsigned)h]; } \
            else seg = EGL[(size_t)((tok0 + c0_) >> 5) * DM + colq + (ht & 127)]; } while (0)
#define RC_LOADK(c0x) do { const unsigned cs_ = (unsigned)((c0x) < T ? (c0x) : T - 32) * LDT; \
            _Pragma("unroll") for (int i = 0; i < NPQ; ++i) rk[i] = *(const GAS v4u*)(Kg + 2u * (qoff0 + cs_ + (unsigned)i * RSTEP)); } while (0)
#define RC_PUTQ(bank) do { \
            _Pragma("unroll") for (int i = 0; i < NPQ; ++i) { const int piece = hx + 256 * i, row = piece / PPR, c16 = piece % PPR; \
                v2u q0_, q1_; q0_.x = rq[i].x; q0_.y = rq[i].y; q1_.x = rq[i].z; q1_.y = rq[i].w; \
                *(LAS v2u*)(lds + L_Q + row * QP + c16 * 16) = q0_; *(LAS v2u*)(lds + L_Q + row * QP + c16 * 16 + 8) = q1_; } \
            _Pragma("unroll") for (int i = 0; i < NPV; ++i) { const int piece = hx + 256 * i, row = piece / PPV, c16 = piece % PPV; v4u vv = rvn[i]; if (den) { vv = (v4u){0u, 0u, 0u, 0u}; if (c16 == 0) vv.x = 0x3f80u; } \
              *(LAS v4u*)(lds + L_V + row * VP + c16 * 16) = vv; } \
            if ((unsigned)(hx - 64) < 128u) *(LAS v4u*)(lds + L_P + (pidx >> 2) * PPI + (pidx & 3) * 16) = rp; \
            LAS float* lsn = LS + (bank) * 256; \
            if (!HG && (unsigned)(hx - 192) < 32u) { const int sx_ = hx - 192; const float BLs = __shfl(sBg, 31, 32), mLs = __shfl(sm, 31, 32); \
                lsn[sx_] = __expf(sBg - Bprev + mprev - sm); lsn[32 + sx_] = __expf(BLs - sBg + sig - mLs); \
                if (sx_ == 31) lsn[64] = __expf(BLs - Bprev + mprev - mLs); \
                Bprev = BLs; mprev = mLs; } \
            if (HG && hx < 128) lsn[128 + hx] = seg; } while (0)
        RC_LOADQ(0); RC_LOADK(0);
        RC_PUTQ(0);
        rvc = rvn[0];
        RC_LOADQ(32);
        REC_BAR();
        for (int step = 0; step < nsteps; ++step) {
            const int c0 = step * 32; LAS float* ls = LS + (step & 1) * 256;

            if (!HG) { const int row = hx >> 3, c16 = hx & 7; const float wl = ls[32 + row]; v4u vw = {0u, 0u, 0u, 0u};
                if (!den) { float x[8]; unpack8(rvc, x); vw.x = pkc(x[0] * wl, x[1] * wl); vw.y = pkc(x[2] * wl, x[3] * wl); vw.z = pkc(x[4] * wl, x[5] * wl); vw.w = pkc(x[6] * wl, x[7] * wl); }
                else if (c16 == 0) vw.x = pkc(wl, 0.f) & 0xffffu;
                *(LAS v4u*)(lds + L_VW + row * VP + c16 * 16) = vw; }
            if (step > 0 && !den) {
#pragma unroll
                for (int i = 0; i < NPV; ++i) { const int piece = hx + 256 * i, row = piece / PPV, c16 = piece % PPV;
                    *(GAS v4u*)(OUTb + ((unsigned)(tok0 + c0 - 32 + row) * LDT + colv + (unsigned)c16 * 8u)) = *(const LAS v4u*)(lds + L_H + row * HP + c16 * 16); } }
#pragma unroll
            for (int i = 0; i < NPQ; ++i) { const int piece = hx + 256 * i, row = piece / PPR, c16 = piece % PPR; *(LAS v4u*)(lds + L_K + row * KP + c16 * 16) = rk[i]; }
            RC_LOADK(c0 + 32);
            RC_WARM(c0 + 96);
            REC_BAR();
            if (HG) {
              const int lane = hx & 63, r = lane & 31, hh = lane >> 5;
              const LAS float* ra = (const LAS float*)(lds + L_RED) + hw * 1024;
#pragma unroll
              for (int g = 0; g < 16; ++g) *(LAS bf16*)(lds + L_H + crow(g, hh) * HP + (32 * hw + r) * 2) = (bf16)(pkc(ra[g * 64 + lane], 0.f) & 0xffffu);
            } else { const int we = hw & 1, g0 = 8 * (hw >> 1), lane = hx & 63, r = lane & 31, hh = lane >> 5;
              const LAS float* ra = (const LAS float*)(lds + L_RED) + we * 1024; const LAS float* rb = ra + 2048;
              if (!den) {
#pragma unroll
                  for (int g = g0; g < g0 + 8; ++g) { const float v = ra[g * 64 + lane] + rb[g * 64 + lane];
                      *(LAS bf16*)(lds + L_H + crow(g, hh) * HP + (32 * we + r) * 2) = (bf16)(pkc(v, 0.f) & 0xffffu); }
              } else if (we == 0) {
                  float dv[8];
#pragma unroll
                  for (int g = 0; g < 8; ++g) dv[g] = ra[(g0 + g) * 64 + lane] + rb[(g0 + g) * 64 + lane];
                  if (r == 0) {
#pragma unroll
                      for (int g = 0; g < 8; ++g) DEN[(size_t)(tok0 + c0 + crow(g0 + g, hh)) * 4 + h] = dv[g]; }
              } }
            RC_PUTQ((step + 1) & 1); rvc = rvn[0]; RC_LOADQ(c0 + 64);
            REC_BAR();
        }
        if (!den) {
#pragma unroll
            for (int i = 0; i < NPV; ++i) { const int piece = ht + 256 * i, row = piece / PPV, c16 = piece % PPV;
                *(GAS v4u*)(OUTb + ((unsigned)(tok0 + T - 32 + row) * LDT + colv + (unsigned)c16 * 8u)) = *(const LAS v4u*)(lds + L_H + row * HP + c16 * 16); } }
        if (den && ht == 192) a.out[(smp ? O_MS : O_MP) + bh] = mprev;
        if ((pfacc ^ pfq ^ pfk) == 0x9e3779b9u && T == 7) DEN[0] = 0.f;
        __builtin_amdgcn_s_setprio(0);
#undef RC_WARM
#undef RC_LOADQ
#undef RC_LOADK
#undef RC_PUTQ
    }
}

__device__ __forceinline__ void rec_mlstm_naive(Frame& F, const Args& a, int unit) {
    const int seq = unit >> 6, h = (unit >> 4) & 3, es = unit & 15;
    const bool smp = seq >= BP; const int b = smp ? seq - BP : seq;
    const int T = smp ? TS : TP, tok0 = smp ? NTOK_P + b * TS : b * TP;
    const int dp = F.tid & 15, el = F.tid >> 4, e = es * 32 + el;
    const bf16* Q = (const bf16*)(a.ws + WS_Q); const bf16* K = (const bf16*)(a.ws + WS_K); const bf16* V = (const bf16*)(a.ws + WS_V);
    const float* GATES = (const float*)(a.ws + WS_GATES);
    bf16* HM = (bf16*)a.out;
    float Cs[32], ns[32]; float m;
    if (smp) {
        const float* c0 = a.in[I_SC] + ((size_t)(b * MH + h) * MHD + e) * MHD; const float* n0 = a.in[I_SN] + (size_t)(b * MH + h) * MHD;
#pragma unroll
        for (int j = 0; j < 32; ++j) { Cs[j] = c0[dp + 16 * j]; ns[j] = n0[dp + 16 * j]; }
        m = a.in[I_SM][b * MH + h];
    } else {
#pragma unroll
        for (int j = 0; j < 32; ++j) { Cs[j] = 0.f; ns[j] = 0.f; }
        m = 0.f;
    }
    LAS float* qs = (LAS float*)(F.lds + RING_OFF);
    LAS float* ks = qs + 16 * 512;
    LAS float* vs = ks + 16 * 512;
    LAS float* gs = vs + 16 * 32;
    for (int t0 = 0; t0 < T; t0 += 16) {
        __syncthreads();
        for (int i = F.tid; i < 16 * 512; i += NTHREADS) { const int tt = i >> 9, d = i & 511; const size_t off = (size_t)(tok0 + t0 + tt) * MI + h * MHD + d; qs[i] = bf2f(Q[off]); ks[i] = bf2f(K[off]); }
        { const int tt = F.tid >> 5, ee = F.tid & 31; vs[F.tid] = bf2f(V[(size_t)(tok0 + t0 + tt) * MI + h * MHD + es * 32 + ee]); }
        if (F.tid < 32) { const int tt = F.tid >> 1; gs[F.tid] = GATES[(size_t)(tok0 + t0 + tt) * 8 + (F.tid & 1) * 4 + h]; }
        __syncthreads();
        for (int tt = 0; tt < 16; ++tt) {
            const float ig = gs[tt * 2], lf = gs[tt * 2 + 1];
            const float mn = fmaxf(lf + m, ig), fp = __expf(lf + m - mn), ip = __expf(ig - mn); m = mn;
            const float vv = ip * vs[tt * 32 + el];
            float dot = 0.f, nd = 0.f;
#pragma unroll
            for (int j = 0; j < 32; ++j) { const float kk = ks[tt * 512 + dp + 16 * j], qq = qs[tt * 512 + dp + 16 * j];
                Cs[j] = fp * Cs[j] + vv * kk; ns[j] = fp * ns[j] + ip * kk; dot += Cs[j] * qq; nd += ns[j] * qq; }
#pragma unroll
            for (int o = 1; o < 16; o <<= 1) { dot += __shfl_xor(dot, o); nd += __shfl_xor(nd, o); }
            const float hv = dot / fmaxf(fabsf(nd), __expf(-m));
            if (dp == 0) HM[(size_t)(tok0 + t0 + tt) * MI + h * MHD + e] = (bf16)f2bf(hv);
        }
    }
    float* co = a.out + (smp ? O_CS : O_CP) + ((size_t)(b * MH + h) * MHD + e) * MHD;
#pragma unroll
    for (int j = 0; j < 32; ++j) co[dp + 16 * j] = Cs[j];
    if (es == 0 && el == 0) { float* no = a.out + (smp ? O_NS : O_NP) + (size_t)(b * MH + h) * MHD;
#pragma unroll
        for (int j = 0; j < 32; ++j) no[dp + 16 * j] = ns[j];
        if (dp == 0) a.out[(smp ? O_MS : O_MP) + b * MH + h] = m; }
}
__device__ __forceinline__ void rec_hgrn_naive(Frame& F, const Args& a, int unit) {
    const int seq = unit >> 5, hd = (unit >> 2) & 7, es = unit & 3;
    const bool smp = seq >= BP; const int b = smp ? seq - BP : seq;
    const int T = smp ? TS : TP, tok0 = smp ? NTOK_P + b * TS : b * TP;
    const int cp = F.tid & 15, el = F.tid >> 4, e = es * 32 + el;
    const bf16* QH = (const bf16*)(a.ws + WS_QH); const bf16* FH = (const bf16*)(a.ws + WS_FH); const bf16* IH = (const bf16*)(a.ws + WS_IH);
    bf16* HO = (bf16*)(a.ws + WS_HO);
    float S[8];
    if (smp) {
#pragma unroll
        for (int j = 0; j < 8; ++j) S[j] = a.in[I_SH][((size_t)(b * HH + hd) * HE + cp + 16 * j) * HE + e];
    } else {
#pragma unroll
        for (int j = 0; j < 8; ++j) S[j] = 0.f;
    }
    LAS float* qs = (LAS float*)(F.lds + RING_OFF);
    LAS float* fs = qs + 2048; LAS float* ks = fs + 2048; LAS float* vs = ks + 2048;
    for (int t0 = 0; t0 < T; t0 += 16) {
        __syncthreads();
        for (int i = F.tid; i < 2048; i += NTHREADS) { const int tt = i >> 7, c = i & 127, col = hd * HE + c; const size_t off = (size_t)(tok0 + t0 + tt) * DM + col;
            const float l0 = a.in[I_LB][col], l1 = a.in[I_LB][DM + col]; const float lb = 1.0f / (1.0f + __expf(l1 - l0));
            const float sg = sigmoidf_(bf2f(FH[off]));
            qs[i] = siluf_(bf2f(QH[off])); fs[i] = lb + (1.0f - lb) * sg; ks[i] = (1.0f - lb) * (1.0f - sg); }
        { const int tt = F.tid >> 5, ee = F.tid & 31; vs[F.tid] = bf2f(IH[(size_t)(tok0 + t0 + tt) * DM + hd * HE + es * 32 + ee]); }
        __syncthreads();
        for (int tt = 0; tt < 16; ++tt) {
            const float vv = vs[tt * 32 + el]; float o = 0.f;
#pragma unroll
            for (int j = 0; j < 8; ++j) { const int c = cp + 16 * j; S[j] = fs[tt * 128 + c] * S[j] + ks[tt * 128 + c] * vv; o += qs[tt * 128 + c] * S[j]; }
#pragma unroll
            for (int s = 1; s < 16; s <<= 1) o += __shfl_xor(o, s);
            if (cp == 0) HO[(size_t)(tok0 + t0 + tt) * DM + hd * HE + e] = (bf16)f2bf(o);
        }
    }
    float* so = a.out + (smp ? O_SS : O_SP);
#pragma unroll
    for (int j = 0; j < 8; ++j) so[((size_t)(b * HH + hd) * HE + cp + 16 * j) * HE + e] = S[j];
}
#ifndef RECDUP
#define RECDUP 0
#endif
constexpr int CW_QUEUE = 8192;
__device__ __forceinline__ void p5_rec(Frame& F, const Args& a) {
    const int bx = blockIdx.x;
    int kind = -1, unit = 0;
    if (F.G == 256) {
        const int x = bx & 7, y = bx >> 3;
        if (y < 18) { kind = 0; unit = (x * 2 + (y >= 9 ? 1 : 0)) * 9 + (y >= 9 ? y - 9 : y); }
        else if (y < 22) { kind = 1; unit = x * 4 + (y - 18); }
    } else if (bx < 144) { kind = 0; unit = bx; } else if (bx < 176) { kind = 1; unit = bx - 144; }
    volatile LAS unsigned* MISC = (volatile LAS unsigned*)(F.lds + MISC_OFF);
    unsigned* qhead = (unsigned*)(a.ws + WS_CTL) + CW_QUEUE;
    const bool prompt_m = kind == 0;
    if (!prompt_m) {
        int u = kind == 1 ? unit : -1; int again = (kind == 1 && (RECDUP & 2)) ? 1 : 0;
        unsigned nq = 0u;
        if (F.tid == 0) nq = __hip_atomic_fetch_add(qhead, 1u, __ATOMIC_RELAXED, __HIP_MEMORY_SCOPE_AGENT);
        for (;;) {
            if (u < 0 && again > 0) { --again; u = unit; }
            if (u < 0) {
                __syncthreads();
                if (F.tid == 0) MISC[16] = nq;
                __syncthreads();
                const unsigned qi = MISC[16];
                if (qi >= 256u) break;
                u = 32 + (int)qi;
                if (F.tid == 0) nq = __hip_atomic_fetch_add(qhead, 1u, __ATOMIC_RELAXED, __HIP_MEMORY_SCOPE_AGENT);
            }
            rec_unit<true>(F, a, u);
            u = -1;
        }
    }
    {
        int u = prompt_m ? unit : -1; int again = (prompt_m && (RECDUP & 1)) ? 1 : 0;
        unsigned nq = 0u;
        if (!prompt_m && F.tid == 0) nq = __hip_atomic_fetch_add(qhead + 64, 1u, __ATOMIC_RELAXED, __HIP_MEMORY_SCOPE_AGENT);
        for (;;) {
            if (u < 0 && again > 0) { --again; u = unit; }
            if (u < 0) {
                if (prompt_m) break;
                __syncthreads();
                if (F.tid == 0) MISC[16] = nq;
                __syncthreads();
                const unsigned qi = MISC[16];
                if (qi >= 1152u) break;
                u = 144 + (int)qi;
                if (F.tid == 0) nq = __hip_atomic_fetch_add(qhead + 64, 1u, __ATOMIC_RELAXED, __HIP_MEMORY_SCOPE_AGENT);
            }
            rec_unit<false>(F, a, u);
            u = -1;
        }
    }
}

__device__ __forceinline__ void p6_norm(Frame& F, const Args& a) {
    const int gw = F.vcu * NWAVES + F.wave, NGW = F.G * NWAVES, lane = F.lane;
    const bf16* HM = (const bf16*)a.out; const bf16* C = (const bf16*)(a.ws + WS_C); const bf16* ZP = (const bf16*)(a.ws + WS_ZP);
    const bf16* HO = (const bf16*)(a.ws + WS_HO); const bf16* GHP = (const bf16*)(a.ws + WS_GHP);
    const float* DEN = (const float*)(a.ws + WS_DENI); const float* SC = (const float*)(a.ws + WS_SC);
    bf16* HMN = (bf16*)(a.ws + WS_HMN); bf16* OH = (bf16*)(a.ws + WS_OH);
    const float* mg = a.in[I_MNORMG] + lane * 8; const float* ms = a.in[I_MSKIP] + lane * 8; const float* hg = a.in[I_HNORMG] + lane * 16;
    for (int m = gw; m < NTOK; m += NGW) {
        v4u hm[4], cc[4], zz[4], ho[2], gh[2]; f32x4 dn4, sc0, sc1;
        const size_t offm = (size_t)m * MI + lane * 8, offh = (size_t)m * DM + lane * 16;
#pragma unroll
        for (int h = 0; h < 4; ++h) { hm[h] = *(const GAS v4u*)(HM + offm + h * MHD); cc[h] = *(const GAS v4u*)(C + offm + h * MHD); zz[h] = *(const GAS v4u*)(ZP + offm + h * MHD); }
        ho[0] = *(const GAS v4u*)(HO + offh); ho[1] = *(const GAS v4u*)(HO + offh + 8); gh[0] = *(const GAS v4u*)(GHP + offh); gh[1] = *(const GAS v4u*)(GHP + offh + 8);
        dn4 = *(const GAS f32x4*)(DEN + (size_t)m * 4); sc0 = *(const GAS f32x4*)(SC + (size_t)m * 8); sc1 = *(const GAS f32x4*)(SC + (size_t)m * 8 + 4);
        const float mts[4] = {sc0.y, sc0.w, sc1.y, sc1.w};
#pragma unroll
        for (int h = 0; h < 4; ++h) {
            float x[8], c[8], z[8];
            unpack8(hm[h], x); unpack8(cc[h], c); unpack8(zz[h], z);
            float s = 0.f;
#pragma unroll
            for (int e = 0; e < 8; ++e) s += x[e];
            const float mu = wave_sum(s) * (1.f / MHD); float q = 0.f;
#pragma unroll
            for (int e = 0; e < 8; ++e) { x[e] -= mu; q += x[e] * x[e]; }
            const float dpr = fmaxf(fabsf(dn4[h]), __expf(-mts[h]));
            const float rstd = 1.0f / sqrtf(wave_sum(q) * (1.f / MHD) + EPS * dpr * dpr);
            const f32x4 g0 = *(const GAS f32x4*)(mg + h * MHD), g1 = *(const GAS f32x4*)(mg + h * MHD + 4), k0 = *(const GAS f32x4*)(ms + h * MHD), k1 = *(const GAS f32x4*)(ms + h * MHD + 4);
            float o[8];
#pragma unroll
            for (int e = 0; e < 4; ++e) { o[e] = (x[e] * rstd * g0[e] + k0[e] * c[e]) * z[e]; o[4 + e] = (x[4 + e] * rstd * g1[e] + k1[e] * c[4 + e]) * z[4 + e]; }
            *(GAS v4u*)(HMN + offm + h * MHD) = pack8(o);
        }
        {
            float x0[8], x1[8], g0[8], g1[8];
            unpack8(ho[0], x0); unpack8(ho[1], x1); unpack8(gh[0], g0); unpack8(gh[1], g1);
            float q = 0.f;
#pragma unroll
            for (int e = 0; e < 8; ++e) q += x0[e] * x0[e] + x1[e] * x1[e];
            q += __shfl_xor(q, 1); q += __shfl_xor(q, 2); q += __shfl_xor(q, 4);
            const float rstd = 1.0f / sqrtf(q * (1.f / HE) + EPS);
            float o0[8], o1[8];
#pragma unroll
            for (int e4 = 0; e4 < 2; ++e4) { const f32x4 ga = *(const GAS f32x4*)(hg + 4 * e4), gb = *(const GAS f32x4*)(hg + 8 + 4 * e4);
#pragma unroll
                for (int e = 0; e < 4; ++e) { o0[4 * e4 + e] = x0[4 * e4 + e] * rstd * ga[e] * g0[4 * e4 + e]; o1[4 * e4 + e] = x1[4 * e4 + e] * rstd * gb[e] * g1[4 * e4 + e]; } }
            *(GAS v4u*)(OH + offh) = pack8(o0); *(GAS v4u*)(OH + offh + 8) = pack8(o1);
        }
    }
}

__device__ __forceinline__ void p12_final(Frame& F, const Args& a) {
    const int gw = F.vcu * NWAVES + F.wave, NGW = F.G * NWAVES;
    const float* fg = a.in[I_FINALG];
    const bf16* H2B = (const bf16*)(a.ws + WS_H2B);
    f32x4 gg[4];
#pragma unroll
    for (int j = 0; j < 4; ++j) gg[j] = *(const GAS f32x4*)(fg + 4 * F.lane + 256 * j);
    for (int m = gw; m < NTOK; m += NGW) {
        const GAS v2u* hr = (const GAS v2u*)(H2B + (size_t)m * DM) + F.lane;
        GAS f32x4* xr = (GAS f32x4*)(a.out + (size_t)m * DM) + F.lane;
        f32x4 v[4]; float ss = 0.f;
#pragma unroll
        for (int j = 0; j < 4; ++j) { const v2u w = hr[64 * j]; v[j] = (f32x4){bflo(w.x), bfhi(w.x), bflo(w.y), bfhi(w.y)}; ss += (v[j].x * v[j].x + v[j].y * v[j].y) + (v[j].z * v[j].z + v[j].w * v[j].w); }
        const float rstd = 1.0f / sqrtf(wave_sum(ss) * (1.f / DM) + EPS);
#pragma unroll
        for (int j = 0; j < 4; ++j) xr[64 * j] = v[j] * rstd * gg[j];
    }
}

__device__ __forceinline__ void st8bf(bf16* p, f32x4 v0, f32x4 v1) {
    v4u w; w.x = pg8::cvt_pk_bf16(v0[0], v0[1]); w.y = pg8::cvt_pk_bf16(v0[2], v0[3]); w.z = pg8::cvt_pk_bf16(v1[0], v1[1]); w.w = pg8::cvt_pk_bf16(v1[2], v1[3]);
    *(GAS v4u*)p = w;
}
__device__ __forceinline__ void ld8bf(const bf16* p, f32x4& v0, f32x4& v1) {
    const v4u w = *(const GAS v4u*)p; v0 = (f32x4){bflo(w.x), bfhi(w.x), bflo(w.y), bfhi(w.y)}; v1 = (f32x4){bflo(w.z), bfhi(w.z), bflo(w.w), bfhi(w.w)};
}
__device__ __forceinline__ f32x4 sig4(f32x4 v) { return (f32x4){sigmoidf_(v[0]), sigmoidf_(v[1]), sigmoidf_(v[2]), sigmoidf_(v[3])}; }
struct Fn1a { unsigned char* ws; const float* big; const float* bfg;
    __device__ __forceinline__ void operator()(int row, int pn, int ct, f32x4 v0, f32x4 v1) const {
        if (pn == 28) {
            if (ct == 0) { float* g = (float*)(ws + WS_GATES) + (size_t)row * 8;
                const f32x4 bi = *(const GAS f32x4*)big, bf = *(const GAS f32x4*)bfg;
                *(GAS f32x4*)g = v0 + bi;
                *(GAS f32x4*)(g + 4) = (f32x4){logsigmoidf_(v1[0] + bf[0]), logsigmoidf_(v1[1] + bf[1]), logsigmoidf_(v1[2] + bf[2]), logsigmoidf_(v1[3] + bf[3])}; }
            return;
        }
        bf16* base; int ld, col;
        if (pn < 8) { base = (bf16*)(ws + WS_U); ld = MI; col = pn * 256; } else if (pn < 16) { base = (bf16*)(ws + WS_V); ld = MI; col = (pn - 8) * 256; }
        else if (pn < 20) { base = (bf16*)(ws + WS_QH); ld = DM; col = (pn - 16) * 256; } else if (pn < 24) { base = (bf16*)(ws + WS_FH); ld = DM; col = (pn - 20) * 256; }
        else { base = (bf16*)(ws + WS_IH); ld = DM; col = (pn - 24) * 256; }
        st8bf(base + (size_t)row * ld + col + ct, v0, v1);
    } };
struct Fn3 { unsigned char* ws;
    __device__ __forceinline__ void operator()(int row, int pn, int ct, f32x4 v0, f32x4 v1) const {
        if (pn < 8) st8bf((bf16*)(ws + WS_Q) + (size_t)row * MI + pn * 256 + ct, v0, v1);
        else { const float s = 0.044194173824159216f; st8bf((bf16*)(ws + WS_K) + (size_t)row * MI + (pn - 8) * 256 + ct, v0 * s, v1 * s); }
    } };
struct Fn5 { unsigned char* ws;
    __device__ __forceinline__ void operator()(int row, int pn, int ct, f32x4 v0, f32x4 v1) const {
        bf16* base; int ld, col; bool sil;
        if (pn < 8) { base = (bf16*)(ws + WS_ZP); ld = MI; col = pn * 256; sil = true; } else if (pn < 12) { base = (bf16*)(ws + WS_GHP); ld = DM; col = (pn - 8) * 256; sil = true; }
        else if (pn < 16) { base = (bf16*)(ws + WS_GAP); ld = DM; col = (pn - 12) * 256; sil = false; } else { base = (bf16*)(ws + WS_GBP); ld = DM; col = (pn - 16) * 256; sil = false; }
        f32x4 s0 = sig4(v0), s1 = sig4(v1);
        if (sil) { s0 = s0 * v0; s1 = s1 * v1; }
        st8bf(base + (size_t)row * ld + col + ct, s0, s1);
    } };
struct Fn7 { unsigned char* ws;
    __device__ __forceinline__ void operator()(int row, int pn, int ct, f32x4 v0, f32x4 v1) const {
        const size_t off = (size_t)row * DM + pn * 256 + ct; f32x4 g0, g1; ld8bf((const bf16*)(ws + WS_GAP) + off, g0, g1);
        st8bf((bf16*)(ws + WS_YA) + off, v0 * g0, v1 * g1);
    } };
struct Fn8 { unsigned char* ws;
    __device__ __forceinline__ void operator()(int row, int pn, int ct, f32x4 v0, f32x4 v1) const {
        const size_t off = (size_t)row * DM + pn * 256 + ct; f32x4 g0, g1, y0, y1; ld8bf((const bf16*)(ws + WS_GBP) + off, g0, g1); ld8bf((const bf16*)(ws + WS_YA) + off, y0, y1);
        st8bf((bf16*)(ws + WS_Y) + off, y0 + v0 * g0, y1 + v1 * g1);
    } };
struct Fn9 { unsigned char* ws; const float* xp; const float* xs; float* out;
    __device__ __forceinline__ void operator()(int row, int pn, int ct, f32x4 v0, f32x4 v1) const {
        const int col = pn * 256 + ct; const float* xr = (row < NTOK_P ? xp + (size_t)row * DM : xs + (size_t)(row - NTOK_P) * DM) + col;
        const f32x4 h0 = *(const GAS f32x4*)xr + v0, h1 = *(const GAS f32x4*)(xr + 4) + v1;
        st8bf((bf16*)(ws + WS_H1B) + (size_t)row * DM + col, h0, h1);
    } };
struct Fn10 { unsigned char* ws;
    __device__ __forceinline__ void operator()(int row, int pn, int ct, f32x4 v0, f32x4 v1) const { st8bf((bf16*)(ws + WS_G2) + (size_t)row * DM + pn * 256 + ct, v0, v1); } };
struct Fn11 { unsigned char* ws; float* out;
    __device__ __forceinline__ void operator()(int row, int pn, int ct, f32x4 v0, f32x4 v1) const {
        const size_t off = (size_t)row * DM + pn * 256 + ct; f32x4 g0, g1, h0, h1; ld8bf((const bf16*)(ws + WS_G2) + off, g0, g1); ld8bf((const bf16*)(ws + WS_H1B) + off, h0, h1);
        st8bf((bf16*)(ws + WS_H2B) + off, h0 + sig4(v0) * g0, h1 + sig4(v1) * g1);
    } };

template <int K, class Fn>
__device__ __forceinline__ void small_gemm(Frame& F, const bf16* A, int lda, const bf16* Bt, int ldb, const Fn& fn) {
    typedef float f32x4v __attribute__((ext_vector_type(4)));
    constexpr int KW = K / 8, CH = KW > 128 ? 128 : KW, NS = CH / 32, RS = 68;
    const int lane = F.lane, w = F.wave, i16 = lane & 15, fq = lane >> 4;
    LAS float* red = (LAS float*)(F.lds + RING_OFF);
    for (int t = blockIdx.x; t < 256; t += F.G) {
        const int row0 = NTOK_P + (t >> 4) * 64, col0 = (t & 15) * 64;
        const bf16* ap = A + (size_t)(row0 + i16) * lda + w * KW + 8 * fq;
        const bf16* bp = Bt + (size_t)(col0 + i16) * ldb + w * KW + 8 * fq;
        f32x4v acc[4][4];
#pragma unroll
        for (int mi = 0; mi < 4; ++mi)
#pragma unroll
            for (int ni = 0; ni < 4; ++ni) acc[mi][ni] = (f32x4v){0.f, 0.f, 0.f, 0.f};
#pragma unroll
        for (int kc = 0; kc < KW; kc += CH) {
            bf16x8 xa[NS][4], wb[NS][4];
#pragma unroll
            for (int s = 0; s < NS; ++s)
#pragma unroll
                for (int i = 0; i < 4; ++i) { xa[s][i] = *(const GAS bf16x8*)(ap + (size_t)(16 * i) * lda + kc + 32 * s); wb[s][i] = *(const GAS bf16x8*)(bp + (size_t)(16 * i) * ldb + kc + 32 * s); }
#pragma unroll
            for (int s = 0; s < NS; ++s)
#pragma unroll
                for (int mi = 0; mi < 4; ++mi)
#pragma unroll
                    for (int ni = 0; ni < 4; ++ni) acc[mi][ni] = __builtin_amdgcn_mfma_f32_16x16x32_bf16(wb[s][ni], xa[s][mi], acc[mi][ni], 0, 0, 0);
        }
        __syncthreads();
        if (w >= 4) { LAS float* r = red + (w - 4) * (64 * RS);
#pragma unroll
            for (int mi = 0; mi < 4; ++mi)
#pragma unroll
                for (int ni = 0; ni < 4; ++ni) *(LAS f32x4v*)(r + (16 * mi + i16) * RS + 16 * ni + 4 * fq) = acc[mi][ni]; }
        __syncthreads();
        if (w < 4) { LAS float* r = red + w * (64 * RS);
#pragma unroll
            for (int mi = 0; mi < 4; ++mi)
#pragma unroll
                for (int ni = 0; ni < 4; ++ni) { LAS f32x4v* p = (LAS f32x4v*)(r + (16 * mi + i16) * RS + 16 * ni + 4 * fq); *p = *p + acc[mi][ni]; } }
        __syncthreads();
        const int row = F.tid >> 3, c8 = (F.tid & 7) * 8;
        f32x4v s0 = {0.f, 0.f, 0.f, 0.f}, s1 = {0.f, 0.f, 0.f, 0.f};
#pragma unroll
        for (int q = 0; q < 4; ++q) { const LAS float* r = red + q * (64 * RS) + row * RS + c8; s0 = s0 + *(const LAS f32x4v*)r; s1 = s1 + *(const LAS f32x4v*)(r + 4); }
        __syncthreads();
        const int col = col0 + c8;
        fn(row0 + row, col >> 8, col & 255, s0, s1);
    }
}
template <class Fn> struct RowOff { Fn f; int r0; __device__ __forceinline__ void operator()(int row, int pn, int ct, pg8::f32x4 v0, pg8::f32x4 v1) const { f(row + r0, pn, ct, v0, v1); } };
__device__ __forceinline__ bool launder(Frame& F) {
    int t = threadIdx.x; asm volatile("" : "+v"(t)); F.tid = t; F.lane = t & 63; return true; }
constexpr int N_PHASES = 13;
#ifndef MK_PER_PHASE
#define MK_PER_PHASE 0
#endif
template <class Fn>
__device__ __forceinline__ void run_gemm(Frame& F, const bf16* A, int lda, const bf16* Bt, int ldb, int K, int N, int amask, int ashift, int astride, const Fn& fn, int M = NTOK, int wgm = 4) {
    asm volatile("" : "+s"(K));
    pg8::Gemm g{A, Bt, lda, ldb, K, amask, ashift, astride}; pg8::StaticOrder S; S.init(M, N, F.G, (int)blockIdx.x, wgm);
    pg8::EpiF<Fn> E{fn};
    pg8::gemm_phase<pg8::EpiF<Fn>, pg8::StaticOrder, true, true>(F.lds + RING_OFF, g, S, E);
}
__device__ __forceinline__ void publish_count(unsigned* cnt) {
    asm volatile("s_waitcnt vmcnt(0)" ::: "memory");
    __syncthreads();
    if (threadIdx.x == 0) {
        __builtin_amdgcn_fence(__ATOMIC_RELEASE, "agent");
        asm volatile("s_waitcnt vmcnt(0)" ::: "memory");
        (void)__hip_atomic_fetch_add(cnt, 1u, __ATOMIC_RELAXED, __HIP_MEMORY_SCOPE_AGENT);
    }
}
__device__ __forceinline__ void wait_count(unsigned* cnt, unsigned need) {
    if (threadIdx.x == 0) {
        unsigned sp = 0;
        while (__hip_atomic_load(cnt, __ATOMIC_RELAXED, __HIP_MEMORY_SCOPE_AGENT) < need) { __builtin_amdgcn_s_sleep(8); if (++sp > (1u << 22)) break; }
        __builtin_amdgcn_fence(__ATOMIC_ACQUIRE, "agent");
        asm volatile("s_waitcnt vmcnt(0)" ::: "memory");
    }
    __syncthreads();
}
constexpr int CW_WORKERS = 8192 + 128;
struct IdleOrder { int w;
    __device__ __forceinline__ bool next(int i, pg8::Unit& o) const { if (i >= 3) return false; const int t = w + 112 * i;
        if (t < 80) { o.pm = 64 + t / 20; o.pn = t % 20; } else { const int j = t - 80; o.pm = j >> 2; o.pn = 16 + (j & 3); } return true; }
    __device__ __forceinline__ void a_ready(const pg8::Unit&) const {}
    __device__ __forceinline__ void done(const pg8::Unit&) const {} };
template <class Fn>
__device__ __forceinline__ void run_gemm_idle(Frame& F, const bf16* A, int lda, const bf16* Bt, int ldb, int K, int w, const Fn& fn) {
    asm volatile("" : "+s"(K));
    pg8::Gemm g{A, Bt, lda, ldb, K, 0, 0, 0}; IdleOrder S; S.w = w;
    pg8::EpiF<Fn> E{fn};
    pg8::gemm_phase<pg8::EpiF<Fn>, IdleOrder, true, true>(F.lds + RING_OFF, g, S, E);
}
__global__ void __launch_bounds__(NTHREADS, 2) mk_fwd(Args args) {
    extern __shared__ __attribute__((aligned(16))) unsigned char lds[];
    Frame F;
    F.lds = (LAS unsigned char*)lds;
    F.tid = threadIdx.x; F.lane = F.tid & 63; F.wave = __builtin_amdgcn_readfirstlane(F.tid >> 6);
    F.G = gridDim.x; { const int bx = blockIdx.x; F.vcu = (F.G % 8 == 0) ? (bx % 8) * (F.G / 8) + bx / 8 : bx; }
    volatile LAS unsigned* MISC = (volatile LAS unsigned*)(F.lds + MISC_OFF);
    for (int u = F.tid; u < (LDS_BYTES - LDSCTL_OFF) / 4; u += NTHREADS) ((LAS unsigned*)(F.lds + LDSCTL_OFF))[u] = 0u;
    __syncthreads();
    unsigned char* ws = args.ws;
    XcdBarrier bar; bar.bar = (unsigned*)(ws + WS_CTL) + CW_BAR; bar.x = 0; bar.st = nullptr;
    if (!MK_PER_PHASE) bar = xcd_barrier_post((unsigned*)(ws + WS_CTL) + CW_BAR, MISC + 8);
    const int lo = args.ph_lo, hi = args.ph_hi;
#ifndef PHMASK
#define PHMASK 0x1fff
#endif
#define IN(k) (((PHMASK >> (k)) & 1) && lo <= (k) && (k) < hi && launder(F))
#define SEAM(k) do { if (IN(k) && IN((k) + 1)) xcd_barrier(bar); } while (0)
#ifndef RMASK
#define RMASK 0
#endif
#define REP(k, ...) do { __VA_ARGS__; if ((RMASK >> (k)) & 1) { xcd_barrier(bar); __VA_ARGS__; } } while (0)
    if (IN(0)) REP(0, p0_prep(F, args)); SEAM(0);
    if (IN(1)) { REP(1, run_gemm(F, (const bf16*)(ws + WS_XN), DM, (const bf16*)(ws + WS_WIN), DM, DM, 7424, 0, 0, 0, Fn1a{ws, args.in[I_BIG], args.in[I_BFG]}));
        if (F.G == 256 && blockIdx.x >= 180) p0_pb(F, args, ((int)blockIdx.x - 180) * NTHREADS + F.tid, 76 * NTHREADS); } SEAM(1);
    if (IN(2)) { REP(2, p2_conv(F, args); p2_scan(F, args)); p2_hprep(F, args); } SEAM(2);
    if (IN(3)) { REP(3, run_gemm(F, (const bf16*)(ws + WS_C), MI, (const bf16*)(ws + WS_WQK), MHD, MHD, 4096, 7, 1, MHD, Fn3{ws}));
        if (F.G == 256 && blockIdx.x >= 64) p4_atiles(F, args, (int)blockIdx.x - 64, 192); } SEAM(3);
    if (IN(4)) REP(4, p4_tiles(F, args)); SEAM(4);
    if (IN(5)) { REP(5, p5_rec(F, args));
        if (F.G == 256 && (blockIdx.x >> 3) >= 18) {
            unsigned* cw = (unsigned*)(ws + WS_CTL) + CW_WORKERS;
            publish_count(cw);
            wait_count(cw, 112u);
            run_gemm_idle(F, (const bf16*)(ws + WS_XN), DM, (const bf16*)(ws + WS_WIN) + (size_t)7424 * DM, DM, DM, ((int)(blockIdx.x >> 3) - 18) * 8 + (int)(blockIdx.x & 7), Fn5{ws});
        } } SEAM(5);
    if (IN(6)) REP(6, run_gemm(F, (const bf16*)(ws + WS_XN), DM, (const bf16*)(ws + WS_WIN) + (size_t)7424 * DM, DM, DM, F.G == 256 ? 4096 : 5120, 0, 0, 0, Fn5{ws}, F.G == 256 ? NTOK_P : NTOK)); SEAM(6);
    if (IN(7)) REP(7, p6_norm(F, args)); SEAM(7);
    if (IN(8)) REP(8, run_gemm(F, (const bf16*)(ws + WS_HMN), MI, (const bf16*)(ws + WS_WBRM), MI, MI, DM, 0, 0, 0, Fn7{ws}, NTOK_P); small_gemm<MI>(F, (const bf16*)(ws + WS_HMN), MI, (const bf16*)(ws + WS_WBRM), MI, Fn7{ws});
                     run_gemm(F, (const bf16*)(ws + WS_PB), PLE, (const bf16*)(ws + WS_WPLE), PLE, PLE, DM, 0, 0, 0, Fn10{ws}, NTOK_P); small_gemm<PLE>(F, (const bf16*)(ws + WS_PB), PLE, (const bf16*)(ws + WS_WPLE), PLE, Fn10{ws}));
    if (IN(8) && IN(9)) local_fence();
    if (IN(9)) REP(9, run_gemm(F, (const bf16*)(ws + WS_OH), DM, (const bf16*)(ws + WS_WBRH), DM, DM, DM, 0, 0, 0, Fn8{ws}, NTOK_P); small_gemm<DM>(F, (const bf16*)(ws + WS_OH), DM, (const bf16*)(ws + WS_WBRH), DM, Fn8{ws})); SEAM(9);
    if (IN(10)) REP(10, run_gemm(F, (const bf16*)(ws + WS_Y), DM, (const bf16*)(ws + WS_WOUT), DM, DM, DM, 0, 0, 0, Fn9{ws, args.in[I_XP], args.in[I_XS], args.out}, NTOK_P); small_gemm<DM>(F, (const bf16*)(ws + WS_Y), DM, (const bf16*)(ws + WS_WOUT), DM, Fn9{ws, args.in[I_XP], args.in[I_XS], args.out})); SEAM(10);
    if (IN(11)) { run_gemm(F, (const bf16*)(ws + WS_H1B), DM, (const bf16*)(ws + WS_WPG), DM, DM, DM, 0, 0, 0, Fn11{ws, args.out}, NTOK_P); small_gemm<DM>(F, (const bf16*)(ws + WS_H1B), DM, (const bf16*)(ws + WS_WPG), DM, Fn11{ws, args.out}); } SEAM(11);
    if (IN(12)) { p12_final(F, args); }
#undef IN
#undef SEAM
}

extern "C" void kernel_launch(void* const* d_in, const int* in_sizes, int n_in, void* d_out, int out_size, void* d_ws, size_t ws_size, hipStream_t stream) {
    static int grid = 0;
    if (grid == 0) {
        if (n_in != 27 || out_size != (int)O_END || ws_size < WS_END) { fprintf(stderr, "kernel_launch: unexpected shapes (n_in %d out %d ws %zu)\n", n_in, out_size, ws_size); grid = -1; return; }
        int dev = 0, cus = 0, per_cu = 0;
        if (hipGetDevice(&dev) != hipSuccess || hipDeviceGetAttribute(&cus, hipDeviceAttributeMultiprocessorCount, dev) != hipSuccess) { grid = -1; return; }
        if (hipFuncSetAttribute((const void*)mk_fwd, hipFuncAttributeMaxDynamicSharedMemorySize, LDS_BYTES) != hipSuccess) { grid = -1; return; }
        if (hipOccupancyMaxActiveBlocksPerMultiprocessor(&per_cu, (const void*)mk_fwd, NTHREADS, LDS_BYTES) != hipSuccess || per_cu < 1) { fprintf(stderr, "kernel_launch: occupancy query says %d\n", per_cu); grid = -1; (void)hipGetLastError(); return; }
        grid = cus;
    }
    if (grid < 0) return;
    if (hipMemsetAsync((char*)d_ws + WS_CTL, 0, CTL_ZERO_BYTES, stream) != hipSuccess) return;
    Args a{};
    for (int i = 0; i < 27; ++i) a.in[i] = (const float*)d_in[i];
    a.out = (float*)d_out; a.ws = (unsigned char*)d_ws;
#if MK_PER_PHASE
    for (int p = 0; p < N_PHASES; ++p) { a.ph_lo = p; a.ph_hi = p + 1; a.li = p; hipLaunchKernelGGL(mk_fwd, dim3(grid), dim3(NTHREADS), LDS_BYTES, stream, a); }
#else
    a.ph_lo = 0; a.ph_hi = N_PHASES; a.li = 0;
    hipLaunchKernelGGL(mk_fwd, dim3(grid), dim3(NTHREADS), LDS_BYTES, stream, a);
#endif
}
```
